# Optimizing an MI355X kernel written in HIP

```python
import jax, jax.numpy as jnp
from jax import lax
import numpy as np

D_MODEL = 1024
BATCH = 16
SEQ = 4096
DEPTH = 1

CHUNK = 64
N_PAST_CHUNKS = 8
BAND_CHUNKS = N_PAST_CHUNKS + 1
D_RNN = 1024
RNN_BLOCKS = 8
RNN_BLOCK_DIM = D_RNN // RNN_BLOCKS
CONV_WIDTH = 4
LRU_C = 8.0
ATT_HEADS = 8
ATT_HEAD_DIM = 128
D_ATT = ATT_HEADS * ATT_HEAD_DIM
MAX_REL = 256
MEM_TOKENS = 256
MEM_HEADS = 4
MEM_HEAD_DIM = 256
D_MEM = MEM_HEADS * MEM_HEAD_DIM
N_BRANCHES = 3
D_IN = 2 * D_RNN + 4 * D_ATT + 2 * D_MEM + N_BRANCHES * D_MODEL
EPS = 1e-6
NEG_INF = -1e30

kernel_name = "hybrid_rglru_chunkattn_memxattn_gated"


def _rmsnorm(x, g):
    xf = x.astype(jnp.float32)
    y = xf * lax.rsqrt(jnp.mean(xf * xf, axis=-1, keepdims=True) + EPS)
    return (y * g.astype(jnp.float32)).astype(x.dtype)


def _split_columns(u):
    sizes = (D_RNN, D_RNN, D_ATT, D_ATT, D_ATT, D_ATT, D_MEM, D_MEM, N_BRANCHES * D_MODEL)
    points = [int(p) for p in np.cumsum(sizes)[:-1]]
    return jnp.split(u, points, axis=-1)


def _rglru_branch(xr, conv_w, conv_b, wa, ba, wx, bx, lam):
    B, S, _ = xr.shape
    xc = lax.conv_general_dilated(
        xr, conv_w[:, None, :], window_strides=(1,), padding=[(CONV_WIDTH - 1, 0)],
        dimension_numbers=("NWC", "WIO", "NWC"), feature_group_count=D_RNN) + conv_b
    xb = xc.reshape(B, S, RNN_BLOCKS, RNN_BLOCK_DIM)
    r = jax.nn.sigmoid(jnp.einsum("bsni,nij->bsnj", xb, wa).reshape(B, S, D_RNN) + ba)
    i = jax.nn.sigmoid(jnp.einsum("bsni,nij->bsnj", xb, wx).reshape(B, S, D_RNN) + bx)
    log_a = -LRU_C * r.astype(jnp.float32) * jax.nn.softplus(-lam.astype(jnp.float32))
    a = jnp.exp(log_a)
    b = jnp.sqrt(-jnp.expm1(2.0 * log_a)) * (i * xc).astype(jnp.float32)

    def combine(left, right):
        a1, b1 = left
        a2, b2 = right
        return a1 * a2, a2 * b1 + b2

    _, h = lax.associative_scan(combine, (a, b), axis=1)
    return h.astype(xr.dtype)


def _chunk_band_attention(q, k, v, q_norm_g, k_norm_g, rel_bias):
    B, S, _ = q.shape
    n_chunks = S // CHUNK
    past = N_PAST_CHUNKS * CHUNK
    band = BAND_CHUNKS * CHUNK
    q = _rmsnorm(q.reshape(B, S, ATT_HEADS, ATT_HEAD_DIM), q_norm_g)
    k = _rmsnorm(k.reshape(B, S, ATT_HEADS, ATT_HEAD_DIM), k_norm_g)
    v = v.reshape(B, S, ATT_HEADS, ATT_HEAD_DIM)
    kp = jnp.pad(k, ((0, 0), (past, 0), (0, 0), (0, 0)))
    vp = jnp.pad(v, ((0, 0), (past, 0), (0, 0), (0, 0)))
    dist = jnp.arange(CHUNK)[:, None] + past - jnp.arange(band)[None, :]
    bias = rel_bias[:, jnp.clip(dist, -MAX_REL, MAX_REL) + MAX_REL].astype(jnp.float32)
    scale = ATT_HEAD_DIM ** -0.5

    def one_chunk(c):
        start = c * CHUNK
        qc = lax.dynamic_slice_in_dim(q, start, CHUNK, axis=1)
        kc = lax.dynamic_slice_in_dim(kp, start, band, axis=1)
        vc = lax.dynamic_slice_in_dim(vp, start, band, axis=1)
        s = jnp.einsum("bqhd,bkhd->bhqk", qc, kc).astype(jnp.float32) * scale + bias
        kpos = start - past + jnp.arange(band)
        s = jnp.where(kpos[None, None, None, :] >= 0, s, NEG_INF)
        p = jax.nn.softmax(s, axis=-1).astype(vc.dtype)
        return jnp.einsum("bhqk,bkhd->bqhd", p, vc)

    o = lax.map(one_chunk, jnp.arange(n_chunks))
    return o.transpose(1, 0, 2, 3, 4).reshape(B, S, D_ATT)


def _memory_attention(qm, mem_n, w_mem_kv, q_norm_g, k_norm_g):
    B, S, _ = qm.shape
    M = mem_n.shape[1]
    q = _rmsnorm(qm.reshape(B, S, MEM_HEADS, MEM_HEAD_DIM), q_norm_g)
    km, vm = jnp.split(mem_n @ w_mem_kv, 2, axis=-1)
    k = _rmsnorm(km.reshape(B, M, MEM_HEADS, MEM_HEAD_DIM), k_norm_g)
    v = vm.reshape(B, M, MEM_HEADS, MEM_HEAD_DIM)
    s = jnp.einsum("bshd,bmhd->bhsm", q, k).astype(jnp.float32) * (MEM_HEAD_DIM ** -0.5)
    p = jax.nn.softmax(s, axis=-1).astype(v.dtype)
    return jnp.einsum("bhsm,bmhd->bshd", p, v).reshape(B, S, D_MEM)


def _layer(x, mem, norm_g, mem_norm_g, w_in, b_merge, conv_w, conv_b, lru_wa, lru_ba,
           lru_wx, lru_bx, lru_lambda, q_norm_g, k_norm_g, rel_bias, w_mem_kv,
           mem_q_norm_g, mem_k_norm_g, w_proj_rnn, w_proj_att, w_proj_mem, w_out):
    B, S, _ = x.shape
    h = _rmsnorm(x, norm_g)
    xr, gr, q, k, v, ga, qm, gm, gmerge = _split_columns(h @ w_in)
    y_rnn = (_rglru_branch(xr, conv_w, conv_b, lru_wa, lru_ba, lru_wx, lru_bx, lru_lambda)
             * jax.nn.silu(gr)) @ w_proj_rnn
    y_att = (_chunk_band_attention(q, k, v, q_norm_g, k_norm_g, rel_bias)
             * jax.nn.silu(ga)) @ w_proj_att
    y_mem = (_memory_attention(qm, _rmsnorm(mem, mem_norm_g), w_mem_kv, mem_q_norm_g, mem_k_norm_g)
             * jax.nn.silu(gm)) @ w_proj_mem
    g = jax.nn.sigmoid(gmerge + b_merge).reshape(B, S, N_BRANCHES, D_MODEL)
    y = g[:, :, 0] * y_rnn + g[:, :, 1] * y_att + g[:, :, 2] * y_mem
    return x + y @ w_out


def setup_inputs(seed: int = 0) -> dict:
    key = jax.random.key(seed)
    ks = jax.random.split(key, 24)
    f32 = jnp.float32

    def nrm(k, shape, scale):
        return jax.random.normal(k, (DEPTH,) + shape, f32) * scale

    a8 = jax.random.uniform(ks[12], (DEPTH, D_RNN), f32, 0.9, 0.999)
    a = a8 ** (1.0 / LRU_C)
    lru_lambda = jnp.log(a) - jnp.log1p(-a)
    return {
        "x": jax.random.normal(ks[0], (BATCH, SEQ, D_MODEL), f32),
        "mem": jax.random.normal(ks[1], (BATCH, MEM_TOKENS, D_MODEL), f32),
        "norm_g": 1.0 + nrm(ks[2], (D_MODEL,), 0.05),
        "mem_norm_g": 1.0 + nrm(ks[3], (D_MODEL,), 0.05),
        "w_in": nrm(ks[4], (D_MODEL, D_IN), D_MODEL ** -0.5),
        "b_merge": nrm(ks[5], (N_BRANCHES * D_MODEL,), 0.01),
        "conv_w": nrm(ks[6], (CONV_WIDTH, D_RNN), CONV_WIDTH ** -0.5),
        "conv_b": nrm(ks[7], (D_RNN,), 0.01),
        "lru_wa": nrm(ks[8], (RNN_BLOCKS, RNN_BLOCK_DIM, RNN_BLOCK_DIM), RNN_BLOCK_DIM ** -0.5),
        "lru_ba": nrm(ks[9], (D_RNN,), 0.01),
        "lru_wx": nrm(ks[10], (RNN_BLOCKS, RNN_BLOCK_DIM, RNN_BLOCK_DIM), RNN_BLOCK_DIM ** -0.5),
        "lru_bx": nrm(ks[11], (D_RNN,), 0.01),
        "lru_lambda": lru_lambda,
        "q_norm_g": 1.0 + nrm(ks[13], (ATT_HEAD_DIM,), 0.05),
        "k_norm_g": 1.0 + nrm(ks[14], (ATT_HEAD_DIM,), 0.05),
        "rel_bias": nrm(ks[15], (ATT_HEADS, 2 * MAX_REL + 1), 0.1),
        "w_mem_kv": nrm(ks[16], (D_MODEL, 2 * D_MEM), D_MODEL ** -0.5),
        "mem_q_norm_g": 1.0 + nrm(ks[17], (MEM_HEAD_DIM,), 0.05),
        "mem_k_norm_g": 1.0 + nrm(ks[18], (MEM_HEAD_DIM,), 0.05),
        "w_proj_rnn": nrm(ks[19], (D_RNN, D_MODEL), D_RNN ** -0.5),
        "w_proj_att": nrm(ks[20], (D_ATT, D_MODEL), D_ATT ** -0.5),
        "w_proj_mem": nrm(ks[21], (D_MEM, D_MODEL), D_MEM ** -0.5),
        "w_out": nrm(ks[22], (D_MODEL, D_MODEL), D_MODEL ** -0.5),
    }


def reference(x, mem, norm_g, mem_norm_g, w_in, b_merge, conv_w, conv_b, lru_wa, lru_ba,
              lru_wx, lru_bx, lru_lambda, q_norm_g, k_norm_g, rel_bias, w_mem_kv,
              mem_q_norm_g, mem_k_norm_g, w_proj_rnn, w_proj_att, w_proj_mem, w_out):
    for l in range(DEPTH):
        x = _layer(x, mem, norm_g[l], mem_norm_g[l], w_in[l], b_merge[l], conv_w[l], conv_b[l],
                   lru_wa[l], lru_ba[l], lru_wx[l], lru_bx[l], lru_lambda[l], q_norm_g[l],
                   k_norm_g[l], rel_bias[l], w_mem_kv[l], mem_q_norm_g[l], mem_k_norm_g[l],
                   w_proj_rnn[l], w_proj_att[l], w_proj_mem[l], w_out[l])
    return x
```

```cpp
#include <hip/hip_runtime.h>
#include <hip/hip_cooperative_groups.h>
#include <cstdio>
#include <cstddef>
namespace cg = cooperative_groups;

#define DI __device__ __forceinline__
typedef unsigned short u16;
using bf16x8 = __attribute__((ext_vector_type(8))) short;
using f32x4  = __attribute__((ext_vector_type(4))) float;
using f32x16 = __attribute__((ext_vector_type(16))) float;
using u32x4  = __attribute__((ext_vector_type(4))) unsigned;

constexpr int SEQ = 4096;
constexpr int GB = 4;
constexpr int NPASS = 4;
constexpr int TOK = GB * SEQ;
constexpr int SMEM_BYTES = 73728;
constexpr int T_TR = 2816 + 1024 + 512 + 64;
constexpr int T_ROWS = 16384 + 1024;
constexpr float EPS = 1e-6f;

constexpr unsigned long long ACT = (unsigned long long)TOK * 1024 * 2;
constexpr unsigned long long OFF_wt_in = 0ull;
constexpr unsigned long long OFF_wt_prnn = OFF_wt_in + ((11264ull*1024*2 + 255ull) & ~255ull);
constexpr unsigned long long OFF_wt_patt = OFF_wt_prnn + ((1024ull*1024*2 + 255ull) & ~255ull);
constexpr unsigned long long OFF_wt_pmem = OFF_wt_patt + ((1024ull*1024*2 + 255ull) & ~255ull);
constexpr unsigned long long OFF_wt_out = OFF_wt_pmem + ((1024ull*1024*2 + 255ull) & ~255ull);
constexpr unsigned long long OFF_wt_memkv = OFF_wt_out + ((1024ull*1024*2 + 255ull) & ~255ull);
constexpr unsigned long long OFF_wt_a = OFF_wt_memkv + ((2048ull*1024*2 + 255ull) & ~255ull);
constexpr unsigned long long OFF_wt_x = OFF_wt_a + ((8ull*128*128*2 + 255ull) & ~255ull);
constexpr unsigned long long OFF_h = OFF_wt_x + ((8ull*128*128*2 + 255ull) & ~255ull);
constexpr unsigned long long OFF_mem_n = OFF_h + ((65536ull*1024*2 + 255ull) & ~255ull);
constexpr unsigned long long OFF_memk = OFF_mem_n + ((4096ull*1024*2 + 255ull) & ~255ull);
constexpr unsigned long long OFF_memvt = OFF_memk + ((4096ull*1024*2 + 255ull) & ~255ull);
constexpr unsigned long long OFF_xr = OFF_memvt + ((4096ull*1024*2 + 255ull) & ~255ull);
constexpr unsigned long long OFF_grs = OFF_xr + ((ACT + 255ull) & ~255ull);
constexpr unsigned long long OFF_qn = OFF_grs + ((ACT + 255ull) & ~255ull);
constexpr unsigned long long OFF_kn = OFF_qn + ((ACT + 255ull) & ~255ull);
constexpr unsigned long long OFF_vt = OFF_kn + ((ACT + 255ull) & ~255ull);
constexpr unsigned long long OFF_gas = OFF_vt + ((ACT + 255ull) & ~255ull);
constexpr unsigned long long OFF_qm = OFF_gas + ((ACT + 255ull) & ~255ull);
constexpr unsigned long long OFF_gms = OFF_qm + ((ACT + 255ull) & ~255ull);
constexpr unsigned long long OFF_gsig = OFF_gms + ((ACT + 255ull) & ~255ull);
constexpr unsigned long long OFF_hloc = OFF_gsig + ((ACT*3 + 255ull) & ~255ull);
constexpr unsigned long long OFF_cuma = OFF_hloc + ((ACT*2 + 255ull) & ~255ull);
constexpr unsigned long long OFF_chA = OFF_cuma + ((ACT*2 + 255ull) & ~255ull);
constexpr unsigned long long OFF_chH = OFF_chA + (((unsigned long long)GB*64*1024*4 + 255ull) & ~255ull);
constexpr unsigned long long OFF_rnn_g = OFF_chH + (((unsigned long long)GB*64*1024*4 + 255ull) & ~255ull);
constexpr unsigned long long OFF_att_g = OFF_rnn_g + ((ACT + 255ull) & ~255ull);
constexpr unsigned long long OFF_mem_g = OFF_att_g + ((ACT + 255ull) & ~255ull);
constexpr unsigned long long OFF_y = OFF_mem_g + ((ACT + 255ull) & ~255ull);
constexpr unsigned long long WS_NEED = OFF_y + ((ACT + 255ull) & ~255ull);
DI unsigned char* oq(unsigned char* w) { asm volatile("" : "+s"(w)); return w; }
struct Params {
  const float *x, *mem, *norm_g, *mem_norm_g, *w_in, *b_merge, *conv_w, *conv_b, *lru_wa, *lru_ba, *lru_wx, *lru_bx,
      *lru_lambda, *q_norm_g, *k_norm_g, *rel_bias, *w_mem_kv, *mem_q_norm_g, *mem_k_norm_g, *w_proj_rnn, *w_proj_att,
      *w_proj_mem, *w_out;
  float* out;
  unsigned char* ws;
  int step_lo, step_hi;
  DI u16* wt_in() const { return (u16*)(ws + OFF_wt_in); }
  DI u16* wt_prnn() const { return (u16*)(ws + OFF_wt_prnn); }
  DI u16* wt_patt() const { return (u16*)(ws + OFF_wt_patt); }
  DI u16* wt_pmem() const { return (u16*)(ws + OFF_wt_pmem); }
  DI u16* wt_out() const { return (u16*)(ws + OFF_wt_out); }
  DI u16* wt_memkv() const { return (u16*)(ws + OFF_wt_memkv); }
  DI u16* wt_a() const { return (u16*)(ws + OFF_wt_a); }
  DI u16* wt_x() const { return (u16*)(ws + OFF_wt_x); }
  DI u16* h() const { return (u16*)(ws + OFF_h); }
  DI u16* mem_n() const { return (u16*)(ws + OFF_mem_n); }
  DI u16* memk() const { return (u16*)(ws + OFF_memk); }
  DI u16* memvt() const { return (u16*)(ws + OFF_memvt); }
  DI u16* xr() const { return (u16*)(ws + OFF_xr); }
  DI u16* grs() const { return (u16*)(ws + OFF_grs); }
  DI u16* qn() const { return (u16*)(ws + OFF_qn); }
  DI u16* kn() const { return (u16*)(ws + OFF_kn); }
  DI u16* vt() const { return (u16*)(ws + OFF_vt); }
  DI u16* gas() const { return (u16*)(ws + OFF_gas); }
  DI u16* qm() const { return (u16*)(ws + OFF_qm); }
  DI u16* gms() const { return (u16*)(ws + OFF_gms); }
  DI u16* gsig() const { return (u16*)(ws + OFF_gsig); }
  DI float* hloc() const { return (float*)(ws + OFF_hloc); }
  DI float* cuma() const { return (float*)(ws + OFF_cuma); }
  DI float* chA() const { return (float*)(ws + OFF_chA); }
  DI float* chH() const { return (float*)(ws + OFF_chH); }
  DI u16* rnn_g() const { return (u16*)(ws + OFF_rnn_g); }
  DI u16* att_g() const { return (u16*)(ws + OFF_att_g); }
  DI u16* mem_g() const { return (u16*)(ws + OFF_mem_g); }
  DI u16* y() const { return (u16*)(ws + OFF_y); }
};

DI int get_tid() { int t = __builtin_amdgcn_workitem_id_x(); asm volatile("" : "+v"(t)); return t; }
DI u16 f2bf(float x) { unsigned u = __float_as_uint(x); u += 0x7fffu + ((u >> 16) & 1u); return (u16)(u >> 16); }
DI float bf2f(u16 b) { return __uint_as_float(((unsigned)b) << 16); }
DI unsigned pack2(float a, float b) { return (unsigned)f2bf(a) | ((unsigned)f2bf(b) << 16); }
DI float sigm(float v) { return 1.f / (1.f + __expf(-v)); }
DI float silu(float v) { return v / (1.f + __expf(-v)); }
DI uint4 pack8(const float* v) { uint4 r; r.x = pack2(v[0], v[1]); r.y = pack2(v[2], v[3]); r.z = pack2(v[4], v[5]); r.w = pack2(v[6], v[7]); return r; }
DI void unpack8(uint4 r, float* v) {
  v[0] = __uint_as_float(r.x << 16); v[1] = __uint_as_float(r.x & 0xffff0000u);
  v[2] = __uint_as_float(r.y << 16); v[3] = __uint_as_float(r.y & 0xffff0000u);
  v[4] = __uint_as_float(r.z << 16); v[5] = __uint_as_float(r.z & 0xffff0000u);
  v[6] = __uint_as_float(r.w << 16); v[7] = __uint_as_float(r.w & 0xffff0000u);
}

DI void transpose_tile(const float* __restrict__ src, int R, int C, u16* __restrict__ dst, int tr, int tc, float* tile) {
  const int tid = get_tid();
  __syncthreads();
#pragma unroll
  for (int i = 0; i < 4; ++i) {
    const int r = (tid >> 4) + 16 * i, c4 = (tid & 15) * 4;
    const float4 v = *(const float4*)(src + (size_t)(tr * 64 + r) * C + tc * 64 + c4);
    tile[r * 65 + c4 + 0] = v.x; tile[r * 65 + c4 + 1] = v.y; tile[r * 65 + c4 + 2] = v.z; tile[r * 65 + c4 + 3] = v.w;
  }
  __syncthreads();
#pragma unroll
  for (int i = 0; i < 2; ++i) {
    const int c = (tid >> 3) + 32 * i, r8 = (tid & 7) * 8;
    float v[8];
#pragma unroll
    for (int j = 0; j < 8; ++j) v[j] = tile[(r8 + j) * 65 + c];
    *(uint4*)(dst + (size_t)(tc * 64 + c) * R + tr * 64 + r8) = pack8(v);
  }
}

DI void rms_row(const float* __restrict__ src, const float* __restrict__ g, u16* __restrict__ dst) {
  const int lane = get_tid() & 63;
  float4 v[4];
  float ss = 0.f;
#pragma unroll
  for (int i = 0; i < 4; ++i) {
    v[i] = *(const float4*)(src + i * 256 + lane * 4);
    ss += v[i].x * v[i].x + v[i].y * v[i].y + v[i].z * v[i].z + v[i].w * v[i].w;
  }
#pragma unroll
  for (int o = 32; o >= 1; o >>= 1) ss += __shfl_xor(ss, o);
  const float rstd = rsqrtf(ss * (1.f / 1024.f) + EPS);
#pragma unroll
  for (int i = 0; i < 4; ++i) {
    const float4 gg = *(const float4*)(g + i * 256 + lane * 4);
    uint2 o;
    o.x = pack2(v[i].x * rstd * gg.x, v[i].y * rstd * gg.y);
    o.y = pack2(v[i].z * rstd * gg.z, v[i].w * rstd * gg.w);
    *(uint2*)(dst + i * 256 + lane * 4) = o;
  }
}

DI void step_prep(const Params& p, unsigned char* smem) {
  float* tile = (float*)smem;
  for (int it = blockIdx.x; it < T_TR + T_ROWS; it += gridDim.x) {
    if (it < T_TR) {
      int j = it;
      if (j < 2816) { transpose_tile(p.w_in, 1024, 11264, p.wt_in(), j % 16, j / 16, tile); continue; }
      j -= 2816;
      if (j < 1024) {
        const int k = j >> 8, jj = j & 255;
        const float* s = k == 0 ? p.w_proj_rnn : k == 1 ? p.w_proj_att : k == 2 ? p.w_proj_mem : p.w_out;
        u16* d = k == 0 ? p.wt_prnn() : k == 1 ? p.wt_patt() : k == 2 ? p.wt_pmem() : p.wt_out();
        transpose_tile(s, 1024, 1024, d, jj % 16, jj / 16, tile);
        continue;
      }
      j -= 1024;
      if (j < 512) { transpose_tile(p.w_mem_kv, 1024, 2048, p.wt_memkv(), j % 16, j / 16, tile); continue; }
      j -= 512;
      {
        const int mat = j >> 5, jj = j & 31, n = jj >> 2, tr = (jj >> 1) & 1, tc = jj & 1;
        transpose_tile((mat ? p.lru_wx : p.lru_wa) + n * 16384, 128, 128, (mat ? p.wt_x() : p.wt_a()) + n * 16384, tr, tc, tile);
      }
    } else {
      const int r = (it - T_TR) * 4 + (get_tid() >> 6);
      if (r < 65536) rms_row(p.x + (size_t)r * 1024, p.norm_g, p.h() + (size_t)r * 1024);
      else { const int m = r - 65536; rms_row(p.mem + (size_t)m * 1024, p.mem_norm_g, p.mem_n() + (size_t)m * 1024); }
    }
  }
}

DI void zero_acc(f32x16 (&acc)[2][2]) {
#pragma unroll
  for (int a = 0; a < 2; ++a)
#pragma unroll
    for (int b = 0; b < 2; ++b)
#pragma unroll
      for (int r = 0; r < 16; ++r) acc[a][b][r] = 0.f;
}

DI void gemm_kloop(const u16* __restrict__ A, int lda, const u16* __restrict__ Bt, int ldb, int K, f32x16 (&acc)[2][2],
                   unsigned char* smem) {
  u16* sA = (u16*)smem;
  u16* sB = (u16*)(smem + 18432);
  const int tid = get_tid(), lane = tid & 63, wave = tid >> 6, wm = wave >> 1, wn = wave & 1;
  const int lr = tid >> 3, lc = (tid & 7) * 8;
  const u16* ga = A + (size_t)lr * lda + lc;
  const u16* gb = Bt + (size_t)lr * ldb + lc;
  const size_t sa32 = (size_t)32 * lda, sb32 = (size_t)32 * ldb;
  u32x4 ra0 = *(const u32x4*)(ga), ra1 = *(const u32x4*)(ga + sa32), ra2 = *(const u32x4*)(ga + 2 * sa32), ra3 = *(const u32x4*)(ga + 3 * sa32);
  u32x4 rb0 = *(const u32x4*)(gb), rb1 = *(const u32x4*)(gb + sb32), rb2 = *(const u32x4*)(gb + 2 * sb32), rb3 = *(const u32x4*)(gb + 3 * sb32);
  const int nk = K >> 6;
  const u16* pa = sA + (wm * 64 + (lane & 31)) * 72 + (lane >> 5) * 8;
  const u16* pb = sB + (wn * 64 + (lane & 31)) * 72 + (lane >> 5) * 8;
  u16* wa_ = sA + lr * 72 + lc;
  u16* wb_ = sB + lr * 72 + lc;
  for (int kt = 0; kt < nk; ++kt) {
    __syncthreads();
    *(u32x4*)(wa_) = ra0; *(u32x4*)(wa_ + 32 * 72) = ra1; *(u32x4*)(wa_ + 64 * 72) = ra2; *(u32x4*)(wa_ + 96 * 72) = ra3;
    *(u32x4*)(wb_) = rb0; *(u32x4*)(wb_ + 32 * 72) = rb1; *(u32x4*)(wb_ + 64 * 72) = rb2; *(u32x4*)(wb_ + 96 * 72) = rb3;
    __syncthreads();
    if (kt + 1 < nk) {
      ga += 64; gb += 64;
      ra0 = *(const u32x4*)(ga); ra1 = *(const u32x4*)(ga + sa32); ra2 = *(const u32x4*)(ga + 2 * sa32); ra3 = *(const u32x4*)(ga + 3 * sa32);
      rb0 = *(const u32x4*)(gb); rb1 = *(const u32x4*)(gb + sb32); rb2 = *(const u32x4*)(gb + 2 * sb32); rb3 = *(const u32x4*)(gb + 3 * sb32);
    }
#pragma unroll
    for (int s = 0; s < 4; ++s) {
      const bf16x8 a0 = *(const bf16x8*)(pa + s * 16);
      const bf16x8 a1 = *(const bf16x8*)(pa + 32 * 72 + s * 16);
      const bf16x8 b0 = *(const bf16x8*)(pb + s * 16);
      const bf16x8 b1 = *(const bf16x8*)(pb + 32 * 72 + s * 16);
      acc[0][0] = __builtin_amdgcn_mfma_f32_32x32x16_bf16(a0, b0, acc[0][0], 0, 0, 0);
      acc[0][1] = __builtin_amdgcn_mfma_f32_32x32x16_bf16(a0, b1, acc[0][1], 0, 0, 0);
      acc[1][0] = __builtin_amdgcn_mfma_f32_32x32x16_bf16(a1, b0, acc[1][0], 0, 0, 0);
      acc[1][1] = __builtin_amdgcn_mfma_f32_32x32x16_bf16(a1, b1, acc[1][1], 0, 0, 0);
    }
  }
}

DI void stage_acc(const f32x16 (&acc)[2][2], float* sC) {
  const int tid = get_tid(), lane = tid & 63, wave = tid >> 6, wm = wave >> 1, wn = wave & 1;
  __syncthreads();
#pragma unroll
  for (int mi = 0; mi < 2; ++mi)
#pragma unroll
    for (int ni = 0; ni < 2; ++ni)
#pragma unroll
      for (int r = 0; r < 16; ++r) {
        const int row = wm * 64 + mi * 32 + (r & 3) + 8 * (r >> 2) + 4 * (lane >> 5);
        const int col = wn * 64 + ni * 32 + (lane & 31);
        sC[row * 132 + col] = acc[mi][ni][r];
      }
  __syncthreads();
}

template <typename F>
DI void for_row_chunks(const float* sC, F f) {
  const int tid = get_tid(), row = tid >> 1, hf = tid & 1;
#pragma unroll
  for (int j = 0; j < 8; ++j) {
    const int c = hf * 64 + ((j + 4 * hf) & 7) * 8;
    float v[8];
    const float4 a = *(const float4*)(sC + row * 132 + c), b = *(const float4*)(sC + row * 132 + c + 4);
    v[0] = a.x; v[1] = a.y; v[2] = a.z; v[3] = a.w; v[4] = b.x; v[5] = b.y; v[6] = b.z; v[7] = b.w;
    f(row, c, v);
  }
}

DI void store_transposed(const float* sC, u16* __restrict__ dst, size_t ldd) {
  const int tid = get_tid(), d = tid & 127, th = tid >> 7;
#pragma unroll
  for (int j = 0; j < 8; ++j) {
    float v[8];
#pragma unroll
    for (int e = 0; e < 8; ++e) v[e] = sC[(th * 64 + j * 8 + e) * 132 + d];
    *(uint4*)(dst + (size_t)d * ldd + th * 64 + j * 8) = pack8(v);
  }
}

DI void step_memkv(const Params& p, unsigned char* smem) {
  float* sC = (float*)smem;
  for (int t = blockIdx.x; t < 32 * 16; t += gridDim.x) {
    const int mt = t % 32, nt = t / 32;
    f32x16 acc[2][2];
    zero_acc(acc);
    gemm_kloop(p.mem_n() + (size_t)mt * 128 * 1024, 1024, p.wt_memkv() + (size_t)nt * 128 * 1024, 1024, 1024, acc, smem);
    stage_acc(acc, sC);
    if (nt < 8) {
      u16* dst = p.memk() + (size_t)mt * 128 * 1024 + nt * 128;
      for_row_chunks(sC, [&](int row, int c, const float* v) { *(uint4*)(dst + (size_t)row * 1024 + c) = pack8(v); });
    } else {
      const int hh = (nt - 8) >> 1, dbase = ((nt - 8) & 1) * 128, bg = mt >> 1, m0 = (mt & 1) * 128;
      store_transposed(sC, p.memvt() + ((size_t)(bg * 4 + hh) * 256 + dbase) * 256 + m0, 256);
    }
  }
}

DI void memk_norm_row(const Params& p, int row) {
  const int lane = get_tid() & 63;
  u16* ptr = p.memk() + (size_t)row * 1024 + lane * 16;
  float v[16];
  unpack8(*(const uint4*)ptr, v);
  unpack8(*(const uint4*)(ptr + 8), v + 8);
  float ss = 0.f;
#pragma unroll
  for (int e = 0; e < 16; ++e) ss += v[e] * v[e];
#pragma unroll
  for (int o = 1; o <= 8; o <<= 1) ss += __shfl_xor(ss, o);
  const float sc = rsqrtf(ss * (1.f / 256.f) + EPS);
  const float* g = p.mem_k_norm_g + (lane & 15) * 16;
#pragma unroll
  for (int e = 0; e < 16; ++e) v[e] *= sc * g[e];
  *(uint4*)ptr = pack8(v);
  *(uint4*)(ptr + 8) = pack8(v + 8);
}

DI void step_gemm1(const Params& p, int pass, unsigned char* smem) {
  float* sC = (float*)smem;
  if (pass == 0) {
    for (int it = blockIdx.x; it < 1024; it += gridDim.x) memk_norm_row(p, it * 4 + (get_tid() >> 6));
  }
  const u16* A = p.h() + (size_t)pass * TOK * 1024;
  constexpr int MT = TOK / 128;
  for (int t = blockIdx.x; t < MT * 88; t += gridDim.x) {
    const int mt = t % MT, nt = t / MT;
    f32x16 acc[2][2];
    zero_acc(acc);
    gemm_kloop(A + (size_t)mt * 128 * 1024, 1024, p.wt_in() + (size_t)nt * 128 * 1024, 1024, 1024, acc, smem);
    stage_acc(acc, sC);
    const int seg = nt >> 3, cb = (nt & 7) * 128;
    const size_t rowbase = (size_t)mt * 128;
    if (seg == 0 || seg == 6) {
      u16* dst = (seg == 0 ? p.xr() : p.qm()) + rowbase * 1024 + cb;
      for_row_chunks(sC, [&](int row, int c, const float* v) { *(uint4*)(dst + (size_t)row * 1024 + c) = pack8(v); });
    } else if (seg == 1 || seg == 5 || seg == 7) {
      u16* dst = (seg == 1 ? p.grs() : seg == 5 ? p.gas() : p.gms()) + rowbase * 1024 + cb;
      for_row_chunks(sC, [&](int row, int c, const float* v) {
        float o[8];
#pragma unroll
        for (int e = 0; e < 8; ++e) o[e] = silu(v[e]);
        *(uint4*)(dst + (size_t)row * 1024 + c) = pack8(o);
      });
    } else if (seg == 2 || seg == 3) {
      float ss = 0.f;
      for_row_chunks(sC, [&](int row, int c, const float* v) {
#pragma unroll
        for (int e = 0; e < 8; ++e) ss += v[e] * v[e];
      });
      ss += __shfl_xor(ss, 1);
      const float sc = rsqrtf(ss * (1.f / 128.f) + EPS) * (seg == 2 ? 0.08838834764831845f : 1.f);
      const float* g = seg == 2 ? p.q_norm_g : p.k_norm_g;
      u16* dst = (seg == 2 ? p.qn() : p.kn()) + rowbase * 1024 + cb;
      for_row_chunks(sC, [&](int row, int c, const float* v) {
        float o[8];
        const float4 g0 = *(const float4*)(g + c), g1 = *(const float4*)(g + c + 4);
        o[0] = v[0] * sc * g0.x; o[1] = v[1] * sc * g0.y; o[2] = v[2] * sc * g0.z; o[3] = v[3] * sc * g0.w;
        o[4] = v[4] * sc * g1.x; o[5] = v[5] * sc * g1.y; o[6] = v[6] * sc * g1.z; o[7] = v[7] * sc * g1.w;
        *(uint4*)(dst + (size_t)row * 1024 + c) = pack8(o);
      });
    } else if (seg == 4) {
      const int bl = mt >> 5, s0 = (mt & 31) * 128, hh = nt & 7;
      store_transposed(sC, p.vt() + (size_t)(bl * 8 + hh) * 128 * 4096 + s0, 4096);
    } else {
      const int gc = (nt - 64) * 128;
      const float* bm = p.b_merge + gc;
      u16* dst = p.gsig() + rowbase * 3072 + gc;
      for_row_chunks(sC, [&](int row, int c, const float* v) {
        float o[8];
        const float4 b0 = *(const float4*)(bm + c), b1 = *(const float4*)(bm + c + 4);
        o[0] = sigm(v[0] + b0.x); o[1] = sigm(v[1] + b0.y); o[2] = sigm(v[2] + b0.z); o[3] = sigm(v[3] + b0.w);
        o[4] = sigm(v[4] + b1.x); o[5] = sigm(v[5] + b1.y); o[6] = sigm(v[6] + b1.z); o[7] = sigm(v[7] + b1.w);
        *(uint4*)(dst + (size_t)row * 3072 + c) = pack8(o);
      });
    }
  }
}

template <int HD, bool BAND>
DI void attn_core(const u16* __restrict__ Q, const u16* __restrict__ K, const u16* __restrict__ Vt, int ldv, int t0, int t1,
                  const float* __restrict__ bias_row, const float* __restrict__ qg, const float* __restrict__ kg,
                  u16* __restrict__ Out, const u16* __restrict__ Gate, unsigned char* smem) {
  constexpr int KS = HD / 32, DB = HD / 16, LDK = HD + 8, NCH = HD / 32;
  u16* sK = (u16*)smem;
  u16* sV = (u16*)(smem + 64 * LDK * 2);
  float* sBias = (float*)(smem + 64 * LDK * 2 + HD * 72 * 2);
  const int tid = get_tid(), lane = tid & 63, w = tid >> 6, l15 = lane & 15, g = lane >> 4;
  __syncthreads();
  if (BAND) { for (int i = tid; i < 513; i += 256) sBias[i] = bias_row[i]; }
  bf16x8 qf[KS];
  {
    const u16* qrow = Q + (size_t)(w * 16 + l15) * 1024 + g * 8;
#pragma unroll
    for (int ks = 0; ks < KS; ++ks) qf[ks] = *(const bf16x8*)(qrow + ks * 32);
    if (!BAND) {
      float ss = 0.f;
#pragma unroll
      for (int ks = 0; ks < KS; ++ks) {
        float v[8];
        unpack8(__builtin_bit_cast(uint4, qf[ks]), v);
#pragma unroll
        for (int e = 0; e < 8; ++e) ss += v[e] * v[e];
      }
      ss += __shfl_xor(ss, 16);
      ss += __shfl_xor(ss, 32);
      const float sc = rsqrtf(ss * (1.f / HD) + EPS) * 0.0625f;
#pragma unroll
      for (int ks = 0; ks < KS; ++ks) {
        float v[8];
        unpack8(__builtin_bit_cast(uint4, qf[ks]), v);
        const float4 g0 = *(const float4*)(qg + ks * 32 + g * 8), g1 = *(const float4*)(qg + ks * 32 + g * 8 + 4);
        v[0] *= sc * g0.x; v[1] *= sc * g0.y; v[2] *= sc * g0.z; v[3] *= sc * g0.w;
        v[4] *= sc * g1.x; v[5] *= sc * g1.y; v[6] *= sc * g1.z; v[7] *= sc * g1.w;
        qf[ks] = __builtin_bit_cast(bf16x8, pack8(v));
      }
    }
  }
  f32x4 o[DB];
#pragma unroll
  for (int db = 0; db < DB; ++db) o[db] = f32x4{0.f, 0.f, 0.f, 0.f};
  float m = -1e30f, lsum = 0.f;

  for (int t = t0; t < t1; ++t) {
    __syncthreads();
    {
      const int row = tid >> 2, part = tid & 3;
      const u16* src = K + ((size_t)t * 64 + row) * 1024 + part * (HD / 4);
      uint4 r[NCH];
#pragma unroll
      for (int i = 0; i < NCH; ++i) r[i] = *(const uint4*)(src + i * 8);
#pragma unroll
      for (int i = 0; i < NCH; ++i) *(uint4*)(sK + row * LDK + part * (HD / 4) + i * 8) = r[i];
    }
    {
#pragma unroll
      for (int i = 0; i < NCH; ++i) {
        const int id = tid + 256 * i, d = id >> 3, cc = id & 7;
        *(uint4*)(sV + d * 72 + cc * 8) = *(const uint4*)(Vt + (size_t)d * ldv + t * 64 + cc * 8);
      }
    }
    __syncthreads();
    f32x4 s[4];
#pragma unroll
    for (int kb = 0; kb < 4; ++kb) {
      s[kb] = f32x4{0.f, 0.f, 0.f, 0.f};
#pragma unroll
      for (int ks = 0; ks < KS; ++ks) {
        const bf16x8 kf = *(const bf16x8*)(sK + (kb * 16 + l15) * LDK + ks * 32 + g * 8);
        s[kb] = __builtin_amdgcn_mfma_f32_16x16x32_bf16(kf, qf[ks], s[kb], 0, 0, 0);
      }
      if (HD > 128) __builtin_amdgcn_sched_barrier(0);
    }
    float mx = -1e30f;
#pragma unroll
    for (int kb = 0; kb < 4; ++kb)
#pragma unroll
      for (int i = 0; i < 4; ++i) {
        if (BAND) {
          const int dist = (8 - t) * 64 + (w * 16 + l15) - (kb * 16 + g * 4 + i);
          s[kb][i] += sBias[min(dist, 256) + 256];
        }
        mx = fmaxf(mx, s[kb][i]);
      }
    mx = fmaxf(mx, __shfl_xor(mx, 16));
    mx = fmaxf(mx, __shfl_xor(mx, 32));
    const float mn = fmaxf(m, mx);
    const float alpha = __expf(m - mn);
    m = mn;
    lsum *= alpha;
#pragma unroll
    for (int db = 0; db < DB; ++db) { o[db][0] *= alpha; o[db][1] *= alpha; o[db][2] *= alpha; o[db][3] *= alpha; }
    bf16x8 pf[2];
#pragma unroll
    for (int k2 = 0; k2 < 2; ++k2) {
      float pv[8];
#pragma unroll
      for (int i = 0; i < 4; ++i) {
        pv[i] = __expf(s[2 * k2][i] - mn);
        pv[4 + i] = __expf(s[2 * k2 + 1][i] - mn);
      }
#pragma unroll
      for (int e = 0; e < 8; ++e) lsum += pv[e];
      pf[k2] = __builtin_bit_cast(bf16x8, pack8(pv));
    }
#pragma unroll
    for (int db = 0; db < DB; ++db) {
#pragma unroll
      for (int k2 = 0; k2 < 2; ++k2) {
        const u16* vp = sV + (db * 16 + l15) * 72 + k2 * 32 + g * 4;
        const uint2 lo = *(const uint2*)vp, hi = *(const uint2*)(vp + 16);
        uint4 vv; vv.x = lo.x; vv.y = lo.y; vv.z = hi.x; vv.w = hi.y;
        o[db] = __builtin_amdgcn_mfma_f32_16x16x32_bf16(__builtin_bit_cast(bf16x8, vv), pf[k2], o[db], 0, 0, 0);
      }
      if (HD > 128 && (db & 3) == 3) __builtin_amdgcn_sched_barrier(0);
    }
  }
  lsum += __shfl_xor(lsum, 16);
  lsum += __shfl_xor(lsum, 32);
  const float inv = 1.f / lsum;
  {
    const size_t ro = (size_t)(w * 16 + l15) * 1024 + g * 4;
#pragma unroll
    for (int db = 0; db < DB; ++db) {
      const uint2 gv = *(const uint2*)(Gate + ro + db * 16);
      uint2 ov;
      ov.x = pack2(o[db][0] * inv * __uint_as_float(gv.x << 16), o[db][1] * inv * __uint_as_float(gv.x & 0xffff0000u));
      ov.y = pack2(o[db][2] * inv * __uint_as_float(gv.y << 16), o[db][3] * inv * __uint_as_float(gv.y & 0xffff0000u));
      *(uint2*)(Out + ro + db * 16) = ov;
    }
  }
}

DI void rnn_local_item(const Params& p, int bl, int c, int n, unsigned char* smem) {
  float* sxc = (float*)smem;
  float* sa = (float*)(smem + 33792);
  u16* sxcb = (u16*)(smem + 33792);
  const int tid = get_tid(), lane = tid & 63, w = tid >> 6, l15 = lane & 15, g = lane >> 4;
  const int ch0 = n * 128;
  const size_t tok0 = (size_t)bl * 4096 + c * 64;
  __syncthreads();
  {
    const int ch = tid & 127, half = tid >> 7;
    const float w0 = p.conv_w[ch0 + ch], w1 = p.conv_w[1024 + ch0 + ch], w2 = p.conv_w[2048 + ch0 + ch],
                w3 = p.conv_w[3072 + ch0 + ch], cb = p.conv_b[ch0 + ch];
    const int tb = half * 32;
    const u16* src = p.xr() + tok0 * 1024 + ch0 + ch;
    float x0 = (c * 64 + tb - 3 >= 0) ? bf2f(src[(ptrdiff_t)(tb - 3) * 1024]) : 0.f;
    float x1 = (c * 64 + tb - 2 >= 0) ? bf2f(src[(ptrdiff_t)(tb - 2) * 1024]) : 0.f;
    float x2 = (c * 64 + tb - 1 >= 0) ? bf2f(src[(ptrdiff_t)(tb - 1) * 1024]) : 0.f;
#pragma unroll 8
    for (int t = tb; t < tb + 32; ++t) {
      const float x3 = bf2f(src[(ptrdiff_t)t * 1024]);
      const float xc = w0 * x0 + w1 * x1 + w2 * x2 + w3 * x3 + cb;
      sxc[t * 132 + ch] = xc;
      sxcb[t * 136 + ch] = f2bf(xc);
      x0 = x1; x1 = x2; x2 = x3;
    }
  }
  __syncthreads();
  f32x4 accR[4][2], accI[4][2];
#pragma unroll
  for (int tb = 0; tb < 4; ++tb)
#pragma unroll
    for (int jb = 0; jb < 2; ++jb) { accR[tb][jb] = f32x4{0.f, 0.f, 0.f, 0.f}; accI[tb][jb] = f32x4{0.f, 0.f, 0.f, 0.f}; }
  {
    bf16x8 bR[2][4], bI[2][4];
#pragma unroll
    for (int jb = 0; jb < 2; ++jb)
#pragma unroll
      for (int ks = 0; ks < 4; ++ks) {
        const size_t off = (size_t)n * 16384 + (size_t)(32 * w + jb * 16 + l15) * 128 + ks * 32 + g * 8;
        bR[jb][ks] = *(const bf16x8*)(p.wt_a() + off);
        bI[jb][ks] = *(const bf16x8*)(p.wt_x() + off);
      }
#pragma unroll
    for (int tb = 0; tb < 4; ++tb)
#pragma unroll
      for (int ks = 0; ks < 4; ++ks) {
        const bf16x8 af = *(const bf16x8*)(sxcb + (tb * 16 + l15) * 136 + ks * 32 + g * 8);
#pragma unroll
        for (int jb = 0; jb < 2; ++jb) {
          accR[tb][jb] = __builtin_amdgcn_mfma_f32_16x16x32_bf16(af, bR[jb][ks], accR[tb][jb], 0, 0, 0);
          accI[tb][jb] = __builtin_amdgcn_mfma_f32_16x16x32_bf16(af, bI[jb][ks], accI[tb][jb], 0, 0, 0);
        }
      }
  }
  __syncthreads();
#pragma unroll
  for (int jb = 0; jb < 2; ++jb) {
    const int ch = 32 * w + jb * 16 + l15;
    const float ba = p.lru_ba[ch0 + ch], bx = p.lru_bx[ch0 + ch];
    const float sp = log1pf(expf(-p.lru_lambda[ch0 + ch]));
#pragma unroll
    for (int tb = 0; tb < 4; ++tb)
#pragma unroll
      for (int r = 0; r < 4; ++r) {
        const int t = tb * 16 + g * 4 + r;
        const float rg = sigm(accR[tb][jb][r] + ba), ig = sigm(accI[tb][jb][r] + bx);
        const float la = -8.f * rg * sp;
        const float a = __expf(la);
        const float mult = sqrtf(fmaxf(-expm1f(2.f * la), 0.f));
        const float xc = sxc[t * 132 + ch];
        sa[t * 132 + ch] = a;
        sxc[t * 132 + ch] = mult * (ig * xc);
      }
  }
  __syncthreads();
  if (tid < 128) {
    const int ch = tid;
    float hh = 0.f, A = 1.f;
    float* ho = p.hloc() + tok0 * 1024 + ch0 + ch;
    float* ao = p.cuma() + tok0 * 1024 + ch0 + ch;
#pragma unroll 8
    for (int t = 0; t < 64; ++t) {
      const float a = sa[t * 132 + ch];
      hh = a * hh + sxc[t * 132 + ch];
      A *= a;
      ho[(size_t)t * 1024] = hh;
      ao[(size_t)t * 1024] = A;
    }
    p.chA()[((size_t)bl * 64 + c) * 1024 + ch0 + ch] = A;
    p.chH()[((size_t)bl * 64 + c) * 1024 + ch0 + ch] = hh;
  }
}

DI void step_mix(const Params& p, int pass, unsigned char* smem) {
  constexpr int NB = GB * 64 * 8, NM = GB * 64 * 4, NR = GB * 64 * 8;
  for (int it = blockIdx.x; it < NB + NM + NR; it += gridDim.x) {
    if (it < NM) {
      const int hh = it & 3, tt = (it >> 2) & 63, bl = it >> 8;
      const int bgl = pass * GB + bl;
      const size_t tok = (size_t)bl * 4096 + tt * 64;
      attn_core<256, false>(p.qm() + tok * 1024 + hh * 256, p.memk() + (size_t)bgl * 256 * 1024 + hh * 256,
                            p.memvt() + (size_t)(bgl * 4 + hh) * 256 * 256, 256, 0, 4, nullptr, p.mem_q_norm_g, p.mem_k_norm_g,
                            p.mem_g() + tok * 1024 + hh * 256, p.gms() + tok * 1024 + hh * 256, smem);
    } else if (it < NM + NB) {
      const int idx = it - NM;
      const int hh = idx & 7, cc = (idx >> 3) & 63, bl = idx >> 9;
      const int c = (cc + 16 * bl) & 63;
      const size_t tok = (size_t)bl * 4096 + c * 64;
      const int t0 = c >= 8 ? 0 : 8 - c;
      const u16* K0 = p.kn() + ((ptrdiff_t)bl * 4096 + (ptrdiff_t)(c - 8) * 64) * 1024 + hh * 128;
      const u16* V0 = p.vt() + (size_t)(bl * 8 + hh) * 128 * 4096 + (ptrdiff_t)(c - 8) * 64;
      attn_core<128, true>(p.qn() + tok * 1024 + hh * 128, K0, V0, 4096, t0, 9, p.rel_bias + hh * 513, nullptr, nullptr,
                           p.att_g() + tok * 1024 + hh * 128, p.gas() + tok * 1024 + hh * 128, smem);
    } else {
      const int idx = it - NM - NB;
      const int n = idx & 7, c = (idx >> 3) & 63, bl = idx >> 9;
      rnn_local_item(p, bl, c, n, smem);
    }
  }
}

DI void step_rnnfin(const Params& p, unsigned char* smem) {
  constexpr int NR = GB * 64 * 8;
  const int tid = get_tid(), ch = tid & 127, half = tid >> 7;
  for (int it = blockIdx.x; it < NR; it += gridDim.x) {
    const int n = it & 7, c = (it >> 3) & 63, bl = it >> 9;
    const int ch0 = n * 128;
    float carry = 0.f;
    for (int k = 0; k < c; ++k) {
      const size_t o = ((size_t)bl * 64 + k) * 1024 + ch0 + ch;
      carry = carry * p.chA()[o] + p.chH()[o];
    }
    const size_t base = ((size_t)bl * 4096 + c * 64 + half * 32) * 1024 + ch0 + ch;
#pragma unroll 8
    for (int t = 0; t < 32; ++t) {
      const size_t o = base + (size_t)t * 1024;
      const float hv = p.hloc()[o] + p.cuma()[o] * carry;
      p.rnn_g()[o] = f2bf(hv * bf2f(p.grs()[o]));
    }
  }
}

DI void step_proj(const Params& p, unsigned char* smem) {
  float* sC = (float*)smem;
  constexpr int MT = TOK / 128;
  for (int t = blockIdx.x; t < MT * 8; t += gridDim.x) {
    const int mt = t % MT, nt = t / MT;
    float yv[64];
#pragma unroll
    for (int i = 0; i < 64; ++i) yv[i] = 0.f;
#pragma unroll 1
    for (int b = 0; b < 3; ++b) {
      const u16* A = (b == 0 ? p.rnn_g() : b == 1 ? p.att_g() : p.mem_g()) + (size_t)mt * 128 * 1024;
      const u16* W = (b == 0 ? p.wt_prnn() : b == 1 ? p.wt_patt() : p.wt_pmem()) + (size_t)nt * 128 * 1024;
      f32x16 acc[2][2];
      zero_acc(acc);
      gemm_kloop(A, 1024, W, 1024, 1024, acc, smem);
      stage_acc(acc, sC);
      const u16* gs = p.gsig() + (size_t)mt * 128 * 3072 + b * 1024 + nt * 128;
      const int row = get_tid() >> 1, hf = get_tid() & 1;
#pragma unroll
      for (int j = 0; j < 8; ++j) {
        const int cidx = (j + 4 * hf) & 7;
        const int c = hf * 64 + cidx * 8;
        const float4 a = *(const float4*)(sC + row * 132 + c), bq = *(const float4*)(sC + row * 132 + c + 4);
        float gv[8];
        unpack8(*(const uint4*)(gs + (size_t)row * 3072 + c), gv);
        yv[j * 8 + 0] += a.x * gv[0]; yv[j * 8 + 1] += a.y * gv[1]; yv[j * 8 + 2] += a.z * gv[2]; yv[j * 8 + 3] += a.w * gv[3];
        yv[j * 8 + 4] += bq.x * gv[4]; yv[j * 8 + 5] += bq.y * gv[5]; yv[j * 8 + 6] += bq.z * gv[6]; yv[j * 8 + 7] += bq.w * gv[7];
      }
    }
    {
      const int row = get_tid() >> 1, hf = get_tid() & 1;
      u16* dst = p.y() + ((size_t)mt * 128 + row) * 1024 + nt * 128;
#pragma unroll
      for (int j = 0; j < 8; ++j) {
        const int c = hf * 64 + ((j + 4 * hf) & 7) * 8;
        *(uint4*)(dst + c) = pack8(&yv[j * 8]);
      }
    }
  }
}

DI void step_out(const Params& p, int pass, unsigned char* smem) {
  float* sC = (float*)smem;
  constexpr int MT = TOK / 128;
  for (int t = blockIdx.x; t < MT * 8; t += gridDim.x) {
    const int mt = t % MT, nt = t / MT;
    f32x16 acc[2][2];
    zero_acc(acc);
    gemm_kloop(p.y() + (size_t)mt * 128 * 1024, 1024, p.wt_out() + (size_t)nt * 128 * 1024, 1024, 1024, acc, smem);
    stage_acc(acc, sC);
    const size_t gbase = ((size_t)pass * TOK + (size_t)mt * 128) * 1024 + nt * 128;
    const float* xs = p.x + gbase;
    float* dst = p.out + gbase;
    for_row_chunks(sC, [&](int row, int c, const float* v) {
      const float4 x0 = *(const float4*)(xs + (size_t)row * 1024 + c), x1 = *(const float4*)(xs + (size_t)row * 1024 + c + 4);
      float4 o0, o1;
      o0.x = x0.x + v[0]; o0.y = x0.y + v[1]; o0.z = x0.z + v[2]; o0.w = x0.w + v[3];
      o1.x = x1.x + v[4]; o1.y = x1.y + v[5]; o1.z = x1.z + v[6]; o1.w = x1.w + v[7];
      *(float4*)(dst + (size_t)row * 1024 + c) = o0;
      *(float4*)(dst + (size_t)row * 1024 + c + 4) = o1;
    });
  }
}

__global__ void __launch_bounds__(256, 2) mega_kernel(Params p_in) {
  __shared__ __attribute__((aligned(16))) unsigned char smem[SMEM_BYTES];
  cg::grid_group grid = cg::this_grid();
  const Params& p = p_in;
  for (int step = p.step_lo; step < p.step_hi; ++step) {
    if (step == 0) step_prep(p, smem);
    else if (step == 1) step_memkv(p, smem);
    else {
      const int pass = (step - 2) / 5, ph = (step - 2) % 5;
      if (ph == 0) step_gemm1(p, pass, smem);
      else if (ph == 1) step_mix(p, pass, smem);
      else if (ph == 2) step_rnnfin(p, smem);
      else if (ph == 3) step_proj(p, smem);
      else step_out(p, pass, smem);
    }
    if (step + 1 < p.step_hi) grid.sync();
  }
}

extern "C" void kernel_launch(void* const* d_in, const int* in_sizes, int n_in, void* d_out, int out_size, void* d_ws,
                              size_t ws_size, hipStream_t stream) {
  static int grid_blocks = 0;
  if (!grid_blocks) {
    int dev = 0, cus = 0, per_cu = 0;
    hipGetDevice(&dev);
    hipDeviceGetAttribute(&cus, hipDeviceAttributeMultiprocessorCount, dev);
    hipOccupancyMaxActiveBlocksPerMultiprocessor(&per_cu, mega_kernel, 256, 0);
    if (per_cu > 2) per_cu = 2;
    if (per_cu < 1) per_cu = 1;
    grid_blocks = cus * per_cu;
  }
  Params p{};
  const float* const* in = (const float* const*)d_in;
  p.x = in[0]; p.mem = in[1]; p.norm_g = in[2]; p.mem_norm_g = in[3]; p.w_in = in[4]; p.b_merge = in[5]; p.conv_w = in[6];
  p.conv_b = in[7]; p.lru_wa = in[8]; p.lru_ba = in[9]; p.lru_wx = in[10]; p.lru_bx = in[11]; p.lru_lambda = in[12];
  p.q_norm_g = in[13]; p.k_norm_g = in[14]; p.rel_bias = in[15]; p.w_mem_kv = in[16]; p.mem_q_norm_g = in[17];
  p.mem_k_norm_g = in[18]; p.w_proj_rnn = in[19]; p.w_proj_att = in[20]; p.w_proj_mem = in[21]; p.w_out = in[22];
  p.out = (float*)d_out;
  p.ws = (unsigned char*)d_ws;
  if (WS_NEED > ws_size) { fprintf(stderr, "workspace too small: need %llu have %zu\n", WS_NEED, ws_size); return; }
  p.step_lo = 0; p.step_hi = 2 + 5 * NPASS;
  void* args[] = {&p};
  hipError_t e = hipLaunchCooperativeKernel((void*)mega_kernel, dim3(grid_blocks), dim3(256), args, 0, stream);
  if (e != hipSuccess) fprintf(stderr, "cooperative launch failed: %s (grid %d)\n", hipGetErrorString(e), grid_blocks);
}
```

```cpp
#include <hip/hip_runtime.h>
#include <hip/hip_cooperative_groups.h>
#include <cstdio>
#include <cstddef>
namespace cg = cooperative_groups;

#define DI __device__ __forceinline__
typedef unsigned short u16;
using bf16x8 = __attribute__((ext_vector_type(8))) short;
using f32x4  = __attribute__((ext_vector_type(4))) float;
using f32x16 = __attribute__((ext_vector_type(16))) float;
using u32x4  = __attribute__((ext_vector_type(4))) unsigned;

constexpr int SEQ = 4096;
constexpr int GB = 4;
constexpr int NPASS = 4;
constexpr int TOK = GB * SEQ;
constexpr int SMEM_BYTES = 147456;
constexpr int T_TR = 2816 + 1024 + 512 + 64;
constexpr int T_ROWS = 8192 + 512;
constexpr float EPS = 1e-6f;

constexpr unsigned long long ACT = (unsigned long long)TOK * 1024 * 2;
constexpr unsigned long long OFF_wt_in = 0ull;
constexpr unsigned long long OFF_wt_prnn = OFF_wt_in + ((11264ull*1024*2 + 255ull) & ~255ull);
constexpr unsigned long long OFF_wt_patt = OFF_wt_prnn + ((1024ull*1024*2 + 255ull) & ~255ull);
constexpr unsigned long long OFF_wt_pmem = OFF_wt_patt + ((1024ull*1024*2 + 255ull) & ~255ull);
constexpr unsigned long long OFF_wt_out = OFF_wt_pmem + ((1024ull*1024*2 + 255ull) & ~255ull);
constexpr unsigned long long OFF_wt_memkv = OFF_wt_out + ((1024ull*1024*2 + 255ull) & ~255ull);
constexpr unsigned long long OFF_wt_a = OFF_wt_memkv + ((2048ull*1024*2 + 255ull) & ~255ull);
constexpr unsigned long long OFF_wt_x = OFF_wt_a + ((8ull*128*128*2 + 255ull) & ~255ull);
constexpr unsigned long long OFF_h = OFF_wt_x + ((8ull*128*128*2 + 255ull) & ~255ull);
constexpr unsigned long long OFF_mem_n = OFF_h + ((65536ull*1024*2 + 255ull) & ~255ull);
constexpr unsigned long long OFF_memk = OFF_mem_n + ((4096ull*1024*2 + 255ull) & ~255ull);
constexpr unsigned long long OFF_memvt = OFF_memk + ((4096ull*1024*2 + 255ull) & ~255ull);
constexpr unsigned long long OFF_xr = OFF_memvt + ((4096ull*1024*2 + 255ull) & ~255ull);
constexpr unsigned long long OFF_grs = OFF_xr + ((ACT + 255ull) & ~255ull);
constexpr unsigned long long OFF_qn = OFF_grs + ((ACT + 255ull) & ~255ull);
constexpr unsigned long long OFF_kn = OFF_qn + ((ACT + 255ull) & ~255ull);
constexpr unsigned long long OFF_vt = OFF_kn + ((ACT + 255ull) & ~255ull);
constexpr unsigned long long OFF_gas = OFF_vt + ((ACT + 255ull) & ~255ull);
constexpr unsigned long long OFF_qm = OFF_gas + ((ACT + 255ull) & ~255ull);
constexpr unsigned long long OFF_gms = OFF_qm + ((ACT + 255ull) & ~255ull);
constexpr unsigned long long OFF_gsig = OFF_gms + ((ACT + 255ull) & ~255ull);
constexpr unsigned long long OFF_hloc = OFF_gsig + ((ACT*3 + 255ull) & ~255ull);
constexpr unsigned long long OFF_cuma = OFF_hloc + ((ACT*2 + 255ull) & ~255ull);
constexpr unsigned long long OFF_chA = OFF_cuma + ((ACT*2 + 255ull) & ~255ull);
constexpr unsigned long long OFF_chH = OFF_chA + (((unsigned long long)GB*64*1024*4 + 255ull) & ~255ull);
constexpr unsigned long long OFF_rnn_g = OFF_chH + (((unsigned long long)GB*64*1024*4 + 255ull) & ~255ull);
constexpr unsigned long long OFF_att_g = OFF_rnn_g + ((ACT + 255ull) & ~255ull);
constexpr unsigned long long OFF_mem_g = OFF_att_g + ((ACT + 255ull) & ~255ull);
constexpr unsigned long long OFF_y = OFF_mem_g + ((ACT + 255ull) & ~255ull);
constexpr unsigned long long WS_NEED = OFF_y + ((ACT + 255ull) & ~255ull);
DI unsigned char* oq(unsigned char* w) { asm volatile("" : "+s"(w)); return w; }
struct Params {
  const float *x, *mem, *norm_g, *mem_norm_g, *w_in, *b_merge, *conv_w, *conv_b, *lru_wa, *lru_ba, *lru_wx, *lru_bx,
      *lru_lambda, *q_norm_g, *k_norm_g, *rel_bias, *w_mem_kv, *mem_q_norm_g, *mem_k_norm_g, *w_proj_rnn, *w_proj_att,
      *w_proj_mem, *w_out;
  float* out;
  unsigned char* ws;
  int step_lo, step_hi;
  DI u16* wt_in() const { return (u16*)(ws + OFF_wt_in); }
  DI u16* wt_prnn() const { return (u16*)(ws + OFF_wt_prnn); }
  DI u16* wt_patt() const { return (u16*)(ws + OFF_wt_patt); }
  DI u16* wt_pmem() const { return (u16*)(ws + OFF_wt_pmem); }
  DI u16* wt_out() const { return (u16*)(ws + OFF_wt_out); }
  DI u16* wt_memkv() const { return (u16*)(ws + OFF_wt_memkv); }
  DI u16* wt_a() const { return (u16*)(ws + OFF_wt_a); }
  DI u16* wt_x() const { return (u16*)(ws + OFF_wt_x); }
  DI u16* h() const { return (u16*)(ws + OFF_h); }
  DI u16* mem_n() const { return (u16*)(ws + OFF_mem_n); }
  DI u16* memk() const { return (u16*)(ws + OFF_memk); }
  DI u16* memvt() const { return (u16*)(ws + OFF_memvt); }
  DI u16* xr() const { return (u16*)(ws + OFF_xr); }
  DI u16* grs() const { return (u16*)(ws + OFF_grs); }
  DI u16* qn() const { return (u16*)(ws + OFF_qn); }
  DI u16* kn() const { return (u16*)(ws + OFF_kn); }
  DI u16* vt() const { return (u16*)(ws + OFF_vt); }
  DI u16* gas() const { return (u16*)(ws + OFF_gas); }
  DI u16* qm() const { return (u16*)(ws + OFF_qm); }
  DI u16* gms() const { return (u16*)(ws + OFF_gms); }
  DI u16* gsig() const { return (u16*)(ws + OFF_gsig); }
  DI float* hloc() const { return (float*)(ws + OFF_hloc); }
  DI float* cuma() const { return (float*)(ws + OFF_cuma); }
  DI float* chA() const { return (float*)(ws + OFF_chA); }
  DI float* chH() const { return (float*)(ws + OFF_chH); }
  DI u16* rnn_g() const { return (u16*)(ws + OFF_rnn_g); }
  DI u16* att_g() const { return (u16*)(ws + OFF_att_g); }
  DI u16* mem_g() const { return (u16*)(ws + OFF_mem_g); }
  DI u16* y() const { return (u16*)(ws + OFF_y); }
};

DI int get_tid() { int t = __builtin_amdgcn_workitem_id_x(); asm volatile("" : "+v"(t)); return t; }
DI u16 f2bf(float x) { unsigned u = __float_as_uint(x); u += 0x7fffu + ((u >> 16) & 1u); return (u16)(u >> 16); }
DI float bf2f(u16 b) { return __uint_as_float(((unsigned)b) << 16); }
DI unsigned pack2(float a, float b) { return (unsigned)f2bf(a) | ((unsigned)f2bf(b) << 16); }
DI float sigm(float v) { return 1.f / (1.f + __expf(-v)); }
DI float silu(float v) { return v / (1.f + __expf(-v)); }
DI uint4 pack8(const float* v) { uint4 r; r.x = pack2(v[0], v[1]); r.y = pack2(v[2], v[3]); r.z = pack2(v[4], v[5]); r.w = pack2(v[6], v[7]); return r; }
DI void unpack8(uint4 r, float* v) {
  v[0] = __uint_as_float(r.x << 16); v[1] = __uint_as_float(r.x & 0xffff0000u);
  v[2] = __uint_as_float(r.y << 16); v[3] = __uint_as_float(r.y & 0xffff0000u);
  v[4] = __uint_as_float(r.z << 16); v[5] = __uint_as_float(r.z & 0xffff0000u);
  v[6] = __uint_as_float(r.w << 16); v[7] = __uint_as_float(r.w & 0xffff0000u);
}

DI void transpose_tile(const float* __restrict__ src, int R, int C, u16* __restrict__ dst, int tr, int tc, float* tile) {
  const int tid = get_tid();
  __syncthreads();
#pragma unroll
  for (int i = 0; i < 2; ++i) {
    const int r = (tid >> 4) + 32 * i, c4 = (tid & 15) * 4;
    const float4 v = *(const float4*)(src + (size_t)(tr * 64 + r) * C + tc * 64 + c4);
    tile[r * 65 + c4 + 0] = v.x; tile[r * 65 + c4 + 1] = v.y; tile[r * 65 + c4 + 2] = v.z; tile[r * 65 + c4 + 3] = v.w;
  }
  __syncthreads();
  {
    const int c = tid >> 3, r8 = (tid & 7) * 8;
    float v[8];
#pragma unroll
    for (int j = 0; j < 8; ++j) v[j] = tile[(r8 + j) * 65 + c];
    *(uint4*)(dst + (size_t)(tc * 64 + c) * R + tr * 64 + r8) = pack8(v);
  }
}

DI void rms_row(const float* __restrict__ src, const float* __restrict__ g, u16* __restrict__ dst) {
  const int lane = get_tid() & 63;
  float4 v[4];
  float ss = 0.f;
#pragma unroll
  for (int i = 0; i < 4; ++i) {
    v[i] = *(const float4*)(src + i * 256 + lane * 4);
    ss += v[i].x * v[i].x + v[i].y * v[i].y + v[i].z * v[i].z + v[i].w * v[i].w;
  }
#pragma unroll
  for (int o = 32; o >= 1; o >>= 1) ss += __shfl_xor(ss, o);
  const float rstd = rsqrtf(ss * (1.f / 1024.f) + EPS);
#pragma unroll
  for (int i = 0; i < 4; ++i) {
    const float4 gg = *(const float4*)(g + i * 256 + lane * 4);
    uint2 o;
    o.x = pack2(v[i].x * rstd * gg.x, v[i].y * rstd * gg.y);
    o.y = pack2(v[i].z * rstd * gg.z, v[i].w * rstd * gg.w);
    *(uint2*)(dst + i * 256 + lane * 4) = o;
  }
}

DI void step_prep(const Params& p, unsigned char* smem) {
  float* tile = (float*)smem;
  for (int it = blockIdx.x; it < T_TR + T_ROWS; it += gridDim.x) {
    if (it < T_TR) {
      int j = it;
      if (j < 2816) { transpose_tile(p.w_in, 1024, 11264, p.wt_in(), j % 16, j / 16, tile); continue; }
      j -= 2816;
      if (j < 1024) {
        const int k = j >> 8, jj = j & 255;
        const float* s = k == 0 ? p.w_proj_rnn : k == 1 ? p.w_proj_att : k == 2 ? p.w_proj_mem : p.w_out;
        u16* d = k == 0 ? p.wt_prnn() : k == 1 ? p.wt_patt() : k == 2 ? p.wt_pmem() : p.wt_out();
        transpose_tile(s, 1024, 1024, d, jj % 16, jj / 16, tile);
        continue;
      }
      j -= 1024;
      if (j < 512) { transpose_tile(p.w_mem_kv, 1024, 2048, p.wt_memkv(), j % 16, j / 16, tile); continue; }
      j -= 512;
      {
        const int mat = j >> 5, jj = j & 31, n = jj >> 2, tr = (jj >> 1) & 1, tc = jj & 1;
        transpose_tile((mat ? p.lru_wx : p.lru_wa) + n * 16384, 128, 128, (mat ? p.wt_x() : p.wt_a()) + n * 16384, tr, tc, tile);
      }
    } else {
      const int r = (it - T_TR) * 8 + (get_tid() >> 6);
      if (r < 65536) rms_row(p.x + (size_t)r * 1024, p.norm_g, p.h() + (size_t)r * 1024);
      else { const int m = r - 65536; rms_row(p.mem + (size_t)m * 1024, p.mem_norm_g, p.mem_n() + (size_t)m * 1024); }
    }
  }
}

DI void zero_acc(f32x16 (&acc)[2][4]) {
#pragma unroll
  for (int a = 0; a < 2; ++a)
#pragma unroll
    for (int b = 0; b < 4; ++b)
#pragma unroll
      for (int r = 0; r < 16; ++r) acc[a][b][r] = 0.f;
}

DI void gemm_kloop(const u16* __restrict__ A, int lda, const u16* __restrict__ Bt, int ldb, int K, f32x16 (&acc)[2][4],
                   unsigned char* smem) {
  u16* sA = (u16*)smem;
  const int tid = get_tid(), lane = tid & 63, wave = tid >> 6, wm = wave >> 1, wn = wave & 1;
  const int lr = tid >> 3, lc = (tid & 7) * 8;
  const u16* ga = A + (size_t)lr * lda + lc;
  const u16* gb = Bt + (size_t)lr * ldb + lc;
  const size_t sa64 = (size_t)64 * lda, sb64 = (size_t)64 * ldb;
  u32x4 ra0 = *(const u32x4*)(ga), ra1 = *(const u32x4*)(ga + sa64), ra2 = *(const u32x4*)(ga + 2 * sa64), ra3 = *(const u32x4*)(ga + 3 * sa64);
  u32x4 rb0 = *(const u32x4*)(gb), rb1 = *(const u32x4*)(gb + sb64), rb2 = *(const u32x4*)(gb + 2 * sb64), rb3 = *(const u32x4*)(gb + 3 * sb64);
  const int nk = K >> 6;
  const int pa_off = (wm * 64 + (lane & 31)) * 72 + (lane >> 5) * 8;
  const int pb_off = 18432 + (wn * 128 + (lane & 31)) * 72 + (lane >> 5) * 8;
  const int wa_off = lr * 72 + lc;
  const int wb_off = 18432 + lr * 72 + lc;
  __syncthreads();
  {
    u16* d = sA + wa_off;
    *(u32x4*)(d) = ra0; *(u32x4*)(d + 64 * 72) = ra1; *(u32x4*)(d + 128 * 72) = ra2; *(u32x4*)(d + 192 * 72) = ra3;
    d = sA + wb_off;
    *(u32x4*)(d) = rb0; *(u32x4*)(d + 64 * 72) = rb1; *(u32x4*)(d + 128 * 72) = rb2; *(u32x4*)(d + 192 * 72) = rb3;
  }
  if (nk > 1) {
    ga += 64; gb += 64;
    ra0 = *(const u32x4*)(ga); ra1 = *(const u32x4*)(ga + sa64); ra2 = *(const u32x4*)(ga + 2 * sa64); ra3 = *(const u32x4*)(ga + 3 * sa64);
    rb0 = *(const u32x4*)(gb); rb1 = *(const u32x4*)(gb + sb64); rb2 = *(const u32x4*)(gb + 2 * sb64); rb3 = *(const u32x4*)(gb + 3 * sb64);
  }
  __syncthreads();
  for (int kt = 0; kt < nk; ++kt) {
    const int cur = (kt & 1) * 36864, nxt = 36864 - cur;
    if (kt + 1 < nk) {
      u16* d = sA + nxt + wa_off;
      *(u32x4*)(d) = ra0; *(u32x4*)(d + 64 * 72) = ra1; *(u32x4*)(d + 128 * 72) = ra2; *(u32x4*)(d + 192 * 72) = ra3;
      d = sA + nxt + wb_off;
      *(u32x4*)(d) = rb0; *(u32x4*)(d + 64 * 72) = rb1; *(u32x4*)(d + 128 * 72) = rb2; *(u32x4*)(d + 192 * 72) = rb3;
    }
    if (kt + 2 < nk) {
      ga += 64; gb += 64;
      ra0 = *(const u32x4*)(ga); ra1 = *(const u32x4*)(ga + sa64); ra2 = *(const u32x4*)(ga + 2 * sa64); ra3 = *(const u32x4*)(ga + 3 * sa64);
      rb0 = *(const u32x4*)(gb); rb1 = *(const u32x4*)(gb + sb64); rb2 = *(const u32x4*)(gb + 2 * sb64); rb3 = *(const u32x4*)(gb + 3 * sb64);
    }
    const u16* pa = sA + cur + pa_off;
    const u16* pb = sA + cur + pb_off;
#pragma unroll
    for (int s = 0; s < 4; ++s) {
      const bf16x8 a0 = *(const bf16x8*)(pa + s * 16);
      const bf16x8 a1 = *(const bf16x8*)(pa + 32 * 72 + s * 16);
      const bf16x8 b0 = *(const bf16x8*)(pb + s * 16);
      const bf16x8 b1 = *(const bf16x8*)(pb + 32 * 72 + s * 16);
      const bf16x8 b2 = *(const bf16x8*)(pb + 64 * 72 + s * 16);
      const bf16x8 b3 = *(const bf16x8*)(pb + 96 * 72 + s * 16);
      acc[0][0] = __builtin_amdgcn_mfma_f32_32x32x16_bf16(a0, b0, acc[0][0], 0, 0, 0);
      acc[0][1] = __builtin_amdgcn_mfma_f32_32x32x16_bf16(a0, b1, acc[0][1], 0, 0, 0);
      acc[0][2] = __builtin_amdgcn_mfma_f32_32x32x16_bf16(a0, b2, acc[0][2], 0, 0, 0);
      acc[0][3] = __builtin_amdgcn_mfma_f32_32x32x16_bf16(a0, b3, acc[0][3], 0, 0, 0);
      acc[1][0] = __builtin_amdgcn_mfma_f32_32x32x16_bf16(a1, b0, acc[1][0], 0, 0, 0);
      acc[1][1] = __builtin_amdgcn_mfma_f32_32x32x16_bf16(a1, b1, acc[1][1], 0, 0, 0);
      acc[1][2] = __builtin_amdgcn_mfma_f32_32x32x16_bf16(a1, b2, acc[1][2], 0, 0, 0);
      acc[1][3] = __builtin_amdgcn_mfma_f32_32x32x16_bf16(a1, b3, acc[1][3], 0, 0, 0);
    }
    __syncthreads();
  }
}

template <typename F>
DI void wave_epilogue(const f32x16 (&acc)[2][4], unsigned char* smem, F f) {
  const int tid = get_tid(), lane = tid & 63, wave = tid >> 6;
  float* sW = (float*)smem + wave * (32 * 132);
#pragma unroll
  for (int mi = 0; mi < 2; ++mi) {
#pragma unroll
    for (int ni = 0; ni < 4; ++ni)
#pragma unroll
      for (int r = 0; r < 16; ++r) {
        const int row = (r & 3) + 8 * (r >> 2) + 4 * (lane >> 5);
        sW[row * 132 + ni * 32 + (lane & 31)] = acc[mi][ni][r];
      }
    f(mi, sW);
  }
}

template <typename F>
DI void slab_rows(const float* sW, F f) {
  const int lane = get_tid() & 63, row = lane >> 1, hf = lane & 1;
#pragma unroll
  for (int j = 0; j < 8; ++j) {
    const int c = hf * 64 + ((j + 4 * hf) & 7) * 8;
    float v[8];
    const float4 a = *(const float4*)(sW + row * 132 + c), b = *(const float4*)(sW + row * 132 + c + 4);
    v[0] = a.x; v[1] = a.y; v[2] = a.z; v[3] = a.w; v[4] = b.x; v[5] = b.y; v[6] = b.z; v[7] = b.w;
    f(row, c, v);
  }
}

DI void slab_store_transposed(const float* sW, u16* __restrict__ dst, size_t ldd) {
  const int lane = get_tid() & 63;
#pragma unroll
  for (int dd = 0; dd < 2; ++dd)
#pragma unroll
    for (int j = 0; j < 4; ++j) {
      const int d = lane + 64 * dd;
      float v[8];
#pragma unroll
      for (int e = 0; e < 8; ++e) v[e] = sW[(j * 8 + e) * 132 + d];
      *(uint4*)(dst + (size_t)d * ldd + j * 8) = pack8(v);
    }
}

DI void step_memkv(const Params& p, unsigned char* smem) {
  for (int t = blockIdx.x; t < 16 * 8; t += gridDim.x) {
    const int mt = t % 16, nt = t / 16;
    f32x16 acc[2][4];
    zero_acc(acc);
    gemm_kloop(p.mem_n() + (size_t)mt * 256 * 1024, 1024, p.wt_memkv() + (size_t)nt * 256 * 1024, 1024, 1024, acc, smem);
    const int wave = get_tid() >> 6, wm = wave >> 1, wn = wave & 1;
    wave_epilogue(acc, smem, [&](int mi, const float* sW) {
      const int r0 = wm * 64 + mi * 32;
      if (nt < 4) {
        u16* dst = p.memk() + ((size_t)mt * 256 + r0) * 1024 + nt * 256 + wn * 128;
        slab_rows(sW, [&](int row, int c, const float* v) { *(uint4*)(dst + (size_t)row * 1024 + c) = pack8(v); });
      } else {
        const int hh = nt - 4;
        slab_store_transposed(sW, p.memvt() + ((size_t)(mt * 4 + hh) * 256 + wn * 128) * 256 + r0, 256);
      }
    });
  }
}

DI void memk_norm_row(const Params& p, int row) {
  const int lane = get_tid() & 63;
  u16* ptr = p.memk() + (size_t)row * 1024 + lane * 16;
  float v[16];
  unpack8(*(const uint4*)ptr, v);
  unpack8(*(const uint4*)(ptr + 8), v + 8);
  float ss = 0.f;
#pragma unroll
  for (int e = 0; e < 16; ++e) ss += v[e] * v[e];
#pragma unroll
  for (int o = 1; o <= 8; o <<= 1) ss += __shfl_xor(ss, o);
  const float sc = rsqrtf(ss * (1.f / 256.f) + EPS);
  const float* g = p.mem_k_norm_g + (lane & 15) * 16;
#pragma unroll
  for (int e = 0; e < 16; ++e) v[e] *= sc * g[e];
  *(uint4*)ptr = pack8(v);
  *(uint4*)(ptr + 8) = pack8(v + 8);
}

DI void step_gemm1(const Params& p, int pass, bool first, unsigned char* smem) {
  if (pass == 0 && first) {
    for (int it = blockIdx.x; it < 512; it += gridDim.x) memk_norm_row(p, it * 8 + (get_tid() >> 6));
  }
  const u16* A = p.h() + (size_t)pass * TOK * 1024;
  constexpr int MT = TOK / 256;
  for (int t = blockIdx.x; t < MT * 44; t += gridDim.x) {
    const int mt = t % MT, nt = t / MT;
    f32x16 acc[2][4];
    zero_acc(acc);
    gemm_kloop(A + (size_t)mt * 256 * 1024, 1024, p.wt_in() + (size_t)nt * 256 * 1024, 1024, 1024, acc, smem);
    const int wave = get_tid() >> 6, wm = wave >> 1, wn = wave & 1;
    const int seg = nt >> 2, cb = (nt & 3) * 256 + wn * 128;
    wave_epilogue(acc, smem, [&](int mi, const float* sW) {
      const size_t rowbase = (size_t)mt * 256 + wm * 64 + mi * 32;
      if (seg == 0 || seg == 6) {
        u16* dst = (seg == 0 ? p.xr() : p.qm()) + rowbase * 1024 + cb;
        slab_rows(sW, [&](int row, int c, const float* v) { *(uint4*)(dst + (size_t)row * 1024 + c) = pack8(v); });
      } else if (seg == 1 || seg == 5 || seg == 7) {
        u16* dst = (seg == 1 ? p.grs() : seg == 5 ? p.gas() : p.gms()) + rowbase * 1024 + cb;
        slab_rows(sW, [&](int row, int c, const float* v) {
          float o[8];
#pragma unroll
          for (int e = 0; e < 8; ++e) o[e] = silu(v[e]);
          *(uint4*)(dst + (size_t)row * 1024 + c) = pack8(o);
        });
      } else if (seg == 2 || seg == 3) {
        float ss = 0.f;
        slab_rows(sW, [&](int row, int c, const float* v) {
#pragma unroll
          for (int e = 0; e < 8; ++e) ss += v[e] * v[e];
        });
        ss += __shfl_xor(ss, 1);
        const float sc = rsqrtf(ss * (1.f / 128.f) + EPS) * (seg == 2 ? 0.08838834764831845f : 1.f);
        const float* g = seg == 2 ? p.q_norm_g : p.k_norm_g;
        u16* dst = (seg == 2 ? p.qn() : p.kn()) + rowbase * 1024 + cb;
        slab_rows(sW, [&](int row, int c, const float* v) {
          float o[8];
          const float4 g0 = *(const float4*)(g + c), g1 = *(const float4*)(g + c + 4);
          o[0] = v[0] * sc * g0.x; o[1] = v[1] * sc * g0.y; o[2] = v[2] * sc * g0.z; o[3] = v[3] * sc * g0.w;
          o[4] = v[4] * sc * g1.x; o[5] = v[5] * sc * g1.y; o[6] = v[6] * sc * g1.z; o[7] = v[7] * sc * g1.w;
          *(uint4*)(dst + (size_t)row * 1024 + c) = pack8(o);
        });
      } else if (seg == 4) {
        const int bl = mt >> 4, s0 = (mt & 15) * 256 + wm * 64 + mi * 32, hh = cb >> 7;
        slab_store_transposed(sW, p.vt() + (size_t)(bl * 8 + hh) * 128 * 4096 + s0, 4096);
      } else {
        const int gc = (nt - 32) * 256 + wn * 128;
        const float* bm = p.b_merge + gc;
        u16* dst = p.gsig() + rowbase * 3072 + gc;
        slab_rows(sW, [&](int row, int c, const float* v) {
          float o[8];
          const float4 b0 = *(const float4*)(bm + c), b1 = *(const float4*)(bm + c + 4);
          o[0] = sigm(v[0] + b0.x); o[1] = sigm(v[1] + b0.y); o[2] = sigm(v[2] + b0.z); o[3] = sigm(v[3] + b0.w);
          o[4] = sigm(v[4] + b1.x); o[5] = sigm(v[5] + b1.y); o[6] = sigm(v[6] + b1.z); o[7] = sigm(v[7] + b1.w);
          *(uint4*)(dst + (size_t)row * 3072 + c) = pack8(o);
        });
      }
    });
  }
}

template <int HD, bool BAND>
DI void attn_core(const u16* __restrict__ Q, const u16* __restrict__ K, const u16* __restrict__ Vt, int ldv, int u0, int u1,
                  const float* __restrict__ bias_row, const float* __restrict__ qg,
                  u16* __restrict__ Out, const u16* __restrict__ Gate, unsigned char* smem) {
  constexpr int KS = HD / 32, DB = HD / 16, LDK = HD + 8, NCH = HD / 64;
  u16* sK = (u16*)smem;
  u16* sV = (u16*)(smem + 64 * LDK * 2);
  float* sBias = (float*)(smem + 64 * LDK * 2 + HD * 72 * 2);
  const int tid = get_tid(), lane = tid & 63, w = tid >> 6, l15 = lane & 15, g = lane >> 4, sb = w >> 2, wq = w & 3;
  __syncthreads();
  if (BAND) { for (int i = tid; i < 513; i += 512) sBias[i] = bias_row[i]; }
  bf16x8 qf[KS];
  {
    const u16* qrow = Q + (size_t)(w * 16 + l15) * 1024 + g * 8;
#pragma unroll
    for (int ks = 0; ks < KS; ++ks) qf[ks] = *(const bf16x8*)(qrow + ks * 32);
    if (!BAND) {
      float ss = 0.f;
#pragma unroll
      for (int ks = 0; ks < KS; ++ks) {
        float v[8];
        unpack8(__builtin_bit_cast(uint4, qf[ks]), v);
#pragma unroll
        for (int e = 0; e < 8; ++e) ss += v[e] * v[e];
      }
      ss += __shfl_xor(ss, 16);
      ss += __shfl_xor(ss, 32);
      const float sc = rsqrtf(ss * (1.f / HD) + EPS) * 0.0625f;
#pragma unroll
      for (int ks = 0; ks < KS; ++ks) {
        float v[8];
        unpack8(__builtin_bit_cast(uint4, qf[ks]), v);
        const float4 g0 = *(const float4*)(qg + ks * 32 + g * 8), g1 = *(const float4*)(qg + ks * 32 + g * 8 + 4);
        v[0] *= sc * g0.x; v[1] *= sc * g0.y; v[2] *= sc * g0.z; v[3] *= sc * g0.w;
        v[4] *= sc * g1.x; v[5] *= sc * g1.y; v[6] *= sc * g1.z; v[7] *= sc * g1.w;
        qf[ks] = __builtin_bit_cast(bf16x8, pack8(v));
      }
    }
  }
  f32x4 o[DB];
#pragma unroll
  for (int db = 0; db < DB; ++db) o[db] = f32x4{0.f, 0.f, 0.f, 0.f};
  float m = -1e30f, lsum = 0.f;

  const int krow = tid >> 3, kpart = (tid & 7) * (HD / 8);
  u32x4 rk[NCH], rv[NCH];
  {
    const u16* ksrc = K + ((size_t)u0 * 64 + krow) * 1024 + kpart;
#pragma unroll
    for (int i = 0; i < NCH; ++i) rk[i] = *(const u32x4*)(ksrc + i * 8);
#pragma unroll
    for (int i = 0; i < NCH; ++i) {
      const int id = tid + 512 * i, d = id >> 3, cc = id & 7;
      rv[i] = *(const u32x4*)(Vt + (size_t)d * ldv + u0 * 64 + cc * 8);
    }
  }
  for (int u = u0; u < u1; ++u) {
    __syncthreads();
#pragma unroll
    for (int i = 0; i < NCH; ++i) *(u32x4*)(sK + krow * LDK + kpart + i * 8) = rk[i];
#pragma unroll
    for (int i = 0; i < NCH; ++i) {
      const int id = tid + 512 * i, d = id >> 3, cc = id & 7;
      *(u32x4*)(sV + d * 72 + cc * 8) = rv[i];
    }
    __syncthreads();
    if (u + 1 < u1) {
      const u16* ksrc = K + ((size_t)(u + 1) * 64 + krow) * 1024 + kpart;
#pragma unroll
      for (int i = 0; i < NCH; ++i) rk[i] = *(const u32x4*)(ksrc + i * 8);
#pragma unroll
      for (int i = 0; i < NCH; ++i) {
        const int id = tid + 512 * i, d = id >> 3, cc = id & 7;
        rv[i] = *(const u32x4*)(Vt + (size_t)d * ldv + (u + 1) * 64 + cc * 8);
      }
    }
    if (BAND && (u < sb || u > sb + 8)) continue;
    f32x4 s[4];
#pragma unroll
    for (int kb = 0; kb < 4; ++kb) {
      s[kb] = f32x4{0.f, 0.f, 0.f, 0.f};
#pragma unroll
      for (int ks = 0; ks < KS; ++ks) {
        const bf16x8 kf = *(const bf16x8*)(sK + (kb * 16 + l15) * LDK + ks * 32 + g * 8);
        s[kb] = __builtin_amdgcn_mfma_f32_16x16x32_bf16(kf, qf[ks], s[kb], 0, 0, 0);
      }
      if (HD > 128) __builtin_amdgcn_sched_barrier(0);
    }
    float mx = -1e30f;
#pragma unroll
    for (int kb = 0; kb < 4; ++kb)
#pragma unroll
      for (int i = 0; i < 4; ++i) {
        if (BAND) {
          const int dist = (8 + sb - u) * 64 + (wq * 16 + l15) - (kb * 16 + g * 4 + i);
          s[kb][i] += sBias[min(dist, 256) + 256];
        }
        mx = fmaxf(mx, s[kb][i]);
      }
    mx = fmaxf(mx, __shfl_xor(mx, 16));
    mx = fmaxf(mx, __shfl_xor(mx, 32));
    const float mn = fmaxf(m, mx);
    const float alpha = __expf(m - mn);
    m = mn;
    lsum *= alpha;
#pragma unroll
    for (int db = 0; db < DB; ++db) { o[db][0] *= alpha; o[db][1] *= alpha; o[db][2] *= alpha; o[db][3] *= alpha; }
    bf16x8 pf[2];
#pragma unroll
    for (int k2 = 0; k2 < 2; ++k2) {
      float pv[8];
#pragma unroll
      for (int i = 0; i < 4; ++i) {
        pv[i] = __expf(s[2 * k2][i] - mn);
        pv[4 + i] = __expf(s[2 * k2 + 1][i] - mn);
      }
#pragma unroll
      for (int e = 0; e < 8; ++e) lsum += pv[e];
      pf[k2] = __builtin_bit_cast(bf16x8, pack8(pv));
    }
#pragma unroll
    for (int db = 0; db < DB; ++db) {
#pragma unroll
      for (int k2 = 0; k2 < 2; ++k2) {
        const u16* vp = sV + (db * 16 + l15) * 72 + k2 * 32 + g * 4;
        const uint2 lo = *(const uint2*)vp, hi = *(const uint2*)(vp + 16);
        uint4 vv; vv.x = lo.x; vv.y = lo.y; vv.z = hi.x; vv.w = hi.y;
        o[db] = __builtin_amdgcn_mfma_f32_16x16x32_bf16(__builtin_bit_cast(bf16x8, vv), pf[k2], o[db], 0, 0, 0);
      }
      if (HD > 128 && (db & 3) == 3) __builtin_amdgcn_sched_barrier(0);
    }
  }
  lsum += __shfl_xor(lsum, 16);
  lsum += __shfl_xor(lsum, 32);
  const float inv = 1.f / lsum;
  {
    const size_t ro = (size_t)(w * 16 + l15) * 1024 + g * 4;
#pragma unroll
    for (int db = 0; db < DB; ++db) {
      const uint2 gv = *(const uint2*)(Gate + ro + db * 16);
      uint2 ov;
      ov.x = pack2(o[db][0] * inv * __uint_as_float(gv.x << 16), o[db][1] * inv * __uint_as_float(gv.x & 0xffff0000u));
      ov.y = pack2(o[db][2] * inv * __uint_as_float(gv.y << 16), o[db][3] * inv * __uint_as_float(gv.y & 0xffff0000u));
      *(uint2*)(Out + ro + db * 16) = ov;
    }
  }
}

DI void rnn_local_item(const Params& p, int bl, int c0, int n, unsigned char* smem) {
  const int tid = get_tid(), sbk = tid >> 8, tl = tid & 255, lane = tid & 63, w = tl >> 6, l15 = lane & 15, g = lane >> 4;
  unsigned char* sm = smem + sbk * 67584;
  float* sxc = (float*)sm;
  float* sa = (float*)(sm + 33792);
  u16* sxcb = (u16*)(sm + 33792);
  const int c = c0 + sbk;
  const int ch0 = n * 128;
  const size_t tok0 = (size_t)bl * 4096 + c * 64;
  __syncthreads();
  {
    const int ch = tl & 127, half = tl >> 7;
    const float w0 = p.conv_w[ch0 + ch], w1 = p.conv_w[1024 + ch0 + ch], w2 = p.conv_w[2048 + ch0 + ch],
                w3 = p.conv_w[3072 + ch0 + ch], cb = p.conv_b[ch0 + ch];
    const int tb = half * 32;
    const u16* src = p.xr() + tok0 * 1024 + ch0 + ch;
    float x0 = (c * 64 + tb - 3 >= 0) ? bf2f(src[(ptrdiff_t)(tb - 3) * 1024]) : 0.f;
    float x1 = (c * 64 + tb - 2 >= 0) ? bf2f(src[(ptrdiff_t)(tb - 2) * 1024]) : 0.f;
    float x2 = (c * 64 + tb - 1 >= 0) ? bf2f(src[(ptrdiff_t)(tb - 1) * 1024]) : 0.f;
#pragma unroll 8
    for (int t = tb; t < tb + 32; ++t) {
      const float x3 = bf2f(src[(ptrdiff_t)t * 1024]);
      const float xc = w0 * x0 + w1 * x1 + w2 * x2 + w3 * x3 + cb;
      sxc[t * 132 + ch] = xc;
      sxcb[t * 136 + ch] = f2bf(xc);
      x0 = x1; x1 = x2; x2 = x3;
    }
  }
  __syncthreads();
  f32x4 accR[4][2], accI[4][2];
#pragma unroll
  for (int tb = 0; tb < 4; ++tb)
#pragma unroll
    for (int jb = 0; jb < 2; ++jb) { accR[tb][jb] = f32x4{0.f, 0.f, 0.f, 0.f}; accI[tb][jb] = f32x4{0.f, 0.f, 0.f, 0.f}; }
  {
    bf16x8 bR[2][4], bI[2][4];
#pragma unroll
    for (int jb = 0; jb < 2; ++jb)
#pragma unroll
      for (int ks = 0; ks < 4; ++ks) {
        const size_t off = (size_t)n * 16384 + (size_t)(32 * w + jb * 16 + l15) * 128 + ks * 32 + g * 8;
        bR[jb][ks] = *(const bf16x8*)(p.wt_a() + off);
        bI[jb][ks] = *(const bf16x8*)(p.wt_x() + off);
      }
#pragma unroll
    for (int tb = 0; tb < 4; ++tb)
#pragma unroll
      for (int ks = 0; ks < 4; ++ks) {
        const bf16x8 af = *(const bf16x8*)(sxcb + (tb * 16 + l15) * 136 + ks * 32 + g * 8);
#pragma unroll
        for (int jb = 0; jb < 2; ++jb) {
          accR[tb][jb] = __builtin_amdgcn_mfma_f32_16x16x32_bf16(af, bR[jb][ks], accR[tb][jb], 0, 0, 0);
          accI[tb][jb] = __builtin_amdgcn_mfma_f32_16x16x32_bf16(af, bI[jb][ks], accI[tb][jb], 0, 0, 0);
        }
      }
  }
  __syncthreads();
#pragma unroll
  for (int jb = 0; jb < 2; ++jb) {
    const int ch = 32 * w + jb * 16 + l15;
    const float ba = p.lru_ba[ch0 + ch], bx = p.lru_bx[ch0 + ch];
    const float sp = log1pf(expf(-p.lru_lambda[ch0 + ch]));
#pragma unroll
    for (int tb = 0; tb < 4; ++tb)
#pragma unroll
      for (int r = 0; r < 4; ++r) {
        const int t = tb * 16 + g * 4 + r;
        const float rg = sigm(accR[tb][jb][r] + ba), ig = sigm(accI[tb][jb][r] + bx);
        const float la = -8.f * rg * sp;
        const float a = __expf(la);
        const float mult = sqrtf(fmaxf(-expm1f(2.f * la), 0.f));
        const float xc = sxc[t * 132 + ch];
        sa[t * 132 + ch] = a;
        sxc[t * 132 + ch] = mult * (ig * xc);
      }
  }
  __syncthreads();
  {
    const int ch = tl & 127, half = tl >> 7, tb = half * 32;
    float hh = 0.f, A = 1.f;
#pragma unroll 8
    for (int t = tb; t < tb + 32; ++t) {
      const float a = sa[t * 132 + ch];
      hh = a * hh + sxc[t * 132 + ch];
      A *= a;
      sxc[t * 132 + ch] = hh;
      sa[t * 132 + ch] = A;
    }
    __syncthreads();
    const float cH = half ? sxc[31 * 132 + ch] : 0.f;
    const float cA = half ? sa[31 * 132 + ch] : 1.f;
    float* ho = p.hloc() + (tok0 + tb) * 1024 + ch0 + ch;
    float* ao = p.cuma() + (tok0 + tb) * 1024 + ch0 + ch;
    float hl = 0.f, al = 1.f;
#pragma unroll 8
    for (int t = 0; t < 32; ++t) {
      const float al_ = sa[(tb + t) * 132 + ch];
      hl = sxc[(tb + t) * 132 + ch] + al_ * cH;
      al = al_ * cA;
      ho[(size_t)t * 1024] = hl;
      ao[(size_t)t * 1024] = al;
    }
    if (half) {
      p.chA()[((size_t)bl * 64 + c) * 1024 + ch0 + ch] = al;
      p.chH()[((size_t)bl * 64 + c) * 1024 + ch0 + ch] = hl;
    }
  }
}

DI void step_mix(const Params& p, int pass, unsigned char* smem) {
  constexpr int NB = GB * 32 * 8, NM = GB * 32 * 4, NR = GB * 32 * 8;
  for (int it = blockIdx.x; it < NB + NM + NR; it += gridDim.x) {
    if (it < NM) {
      const int hh = it & 3, tt = (it >> 2) & 31, bl = it >> 7;
      const int bgl = pass * GB + bl;
      const size_t tok = (size_t)bl * 4096 + tt * 128;
      attn_core<256, false>(p.qm() + tok * 1024 + hh * 256, p.memk() + (size_t)bgl * 256 * 1024 + hh * 256,
                            p.memvt() + (size_t)(bgl * 4 + hh) * 256 * 256, 256, 0, 4, nullptr, p.mem_q_norm_g,
                            p.mem_g() + tok * 1024 + hh * 256, p.gms() + tok * 1024 + hh * 256, smem);
    } else if (it < NM + NB) {
      const int idx = it - NM;
      const int hh = idx & 7, cc = (idx >> 3) & 31, bl = idx >> 8;
      const int c0 = 2 * ((cc + 8 * bl) & 31);
      const size_t tok = (size_t)bl * 4096 + c0 * 64;
      const int u0 = c0 >= 8 ? 0 : 8 - c0;
      const u16* K0 = p.kn() + ((ptrdiff_t)bl * 4096 + (ptrdiff_t)(c0 - 8) * 64) * 1024 + hh * 128;
      const u16* V0 = p.vt() + (size_t)(bl * 8 + hh) * 128 * 4096 + (ptrdiff_t)(c0 - 8) * 64;
      attn_core<128, true>(p.qn() + tok * 1024 + hh * 128, K0, V0, 4096, u0, 10, p.rel_bias + hh * 513, nullptr,
                           p.att_g() + tok * 1024 + hh * 128, p.gas() + tok * 1024 + hh * 128, smem);
    } else {
      const int idx = it - NM - NB;
      const int n = idx & 7, cp = (idx >> 3) & 31, bl = idx >> 8;
      rnn_local_item(p, bl, 2 * cp, n, smem);
    }
  }
}

DI void step_rnnfin(const Params& p, unsigned char* smem) {
  constexpr int NR = GB * 64 * 8;
  const int tid = get_tid(), ch = tid & 127, q = tid >> 7;
  for (int it = blockIdx.x; it < NR; it += gridDim.x) {
    const int n = it & 7, c = (it >> 3) & 63, bl = it >> 9;
    const int ch0 = n * 128;
    float carry = 0.f;
    for (int k = 0; k < c; ++k) {
      const size_t o = ((size_t)bl * 64 + k) * 1024 + ch0 + ch;
      carry = carry * p.chA()[o] + p.chH()[o];
    }
    const size_t base = ((size_t)bl * 4096 + c * 64 + q * 16) * 1024 + ch0 + ch;
#pragma unroll 8
    for (int t = 0; t < 16; ++t) {
      const size_t o = base + (size_t)t * 1024;
      const float hv = p.hloc()[o] + p.cuma()[o] * carry;
      p.rnn_g()[o] = f2bf(hv * bf2f(p.grs()[o]));
    }
  }
}

DI void step_proj(const Params& p, unsigned char* smem) {
  constexpr int MT = TOK / 256;
  float* ytmp = p.hloc();
  for (int t = blockIdx.x; t < MT * 4; t += gridDim.x) {
    const int mt = t % MT, nt = t / MT;
    const int wave = get_tid() >> 6, wm = wave >> 1, wn = wave & 1;
#pragma unroll 1
    for (int b = 0; b < 3; ++b) {
      const u16* A = (b == 0 ? p.rnn_g() : b == 1 ? p.att_g() : p.mem_g()) + (size_t)mt * 256 * 1024;
      const u16* W = (b == 0 ? p.wt_prnn() : b == 1 ? p.wt_patt() : p.wt_pmem()) + (size_t)nt * 256 * 1024;
      f32x16 acc[2][4];
      zero_acc(acc);
      gemm_kloop(A, 1024, W, 1024, 1024, acc, smem);
      wave_epilogue(acc, smem, [&](int mi, const float* sW) {
        const size_t rowbase = (size_t)mt * 256 + wm * 64 + mi * 32;
        const int cb = nt * 256 + wn * 128;
        const u16* gs = p.gsig() + rowbase * 3072 + b * 1024 + cb;
        float* yt = ytmp + rowbase * 1024 + cb;
        u16* yo = p.y() + rowbase * 1024 + cb;
        slab_rows(sW, [&](int row, int c, const float* v) {
          float gv[8], o[8];
          unpack8(*(const uint4*)(gs + (size_t)row * 3072 + c), gv);
          float* yp = yt + (size_t)row * 1024 + c;
          if (b == 0) {
#pragma unroll
            for (int e = 0; e < 8; ++e) o[e] = v[e] * gv[e];
          } else {
            const float4 y0 = *(const float4*)yp, y1 = *(const float4*)(yp + 4);
            o[0] = y0.x + v[0] * gv[0]; o[1] = y0.y + v[1] * gv[1]; o[2] = y0.z + v[2] * gv[2]; o[3] = y0.w + v[3] * gv[3];
            o[4] = y1.x + v[4] * gv[4]; o[5] = y1.y + v[5] * gv[5]; o[6] = y1.z + v[6] * gv[6]; o[7] = y1.w + v[7] * gv[7];
          }
          if (b < 2) {
            *(float4*)yp = float4{o[0], o[1], o[2], o[3]};
            *(float4*)(yp + 4) = float4{o[4], o[5], o[6], o[7]};
          } else {
            *(uint4*)(yo + (size_t)row * 1024 + c) = pack8(o);
          }
        });
      });
    }
  }
}

DI void step_out(const Params& p, int pass, unsigned char* smem) {
  constexpr int MT = TOK / 256;
  for (int t = blockIdx.x; t < MT * 4; t += gridDim.x) {
    const int mt = t % MT, nt = t / MT;
    f32x16 acc[2][4];
    zero_acc(acc);
    gemm_kloop(p.y() + (size_t)mt * 256 * 1024, 1024, p.wt_out() + (size_t)nt * 256 * 1024, 1024, 1024, acc, smem);
    const int wave = get_tid() >> 6, wm = wave >> 1, wn = wave & 1;
    wave_epilogue(acc, smem, [&](int mi, const float* sW) {
      const size_t gbase = ((size_t)pass * TOK + (size_t)mt * 256 + wm * 64 + mi * 32) * 1024 + nt * 256 + wn * 128;
      const float* xs = p.x + gbase;
      float* dst = p.out + gbase;
      slab_rows(sW, [&](int row, int c, const float* v) {
        const float4 x0 = *(const float4*)(xs + (size_t)row * 1024 + c), x1 = *(const float4*)(xs + (size_t)row * 1024 + c + 4);
        float4 o0, o1;
        o0.x = x0.x + v[0]; o0.y = x0.y + v[1]; o0.z = x0.z + v[2]; o0.w = x0.w + v[3];
        o1.x = x1.x + v[4]; o1.y = x1.y + v[5]; o1.z = x1.z + v[6]; o1.w = x1.w + v[7];
        *(float4*)(dst + (size_t)row * 1024 + c) = o0;
        *(float4*)(dst + (size_t)row * 1024 + c + 4) = o1;
      });
    });
  }
}

DI void run_phase(const Params& p, int pass, int ph, bool first, unsigned char* smem) {
  if (ph == 0) step_gemm1(p, pass, first, smem);
  else if (ph == 1) step_mix(p, pass, smem);
  else if (ph == 2) step_rnnfin(p, smem);
  else if (ph == 3) step_proj(p, smem);
  else step_out(p, pass, smem);
}

__global__ void __launch_bounds__(512) mega_kernel(Params p_in) {
  __shared__ __attribute__((aligned(16))) unsigned char smem[SMEM_BYTES];
  cg::grid_group grid = cg::this_grid();
  const Params& p = p_in;
  for (int step = p.step_lo; step < p.step_hi; ++step) {
    if (step == 0) step_prep(p, smem);
    else if (step == 1) step_memkv(p, smem);
    else {
      const int pass = (step - 2) / 5, ph = (step - 2) % 5;
#ifdef DUP_PH
      if (ph == DUP_PH) { run_phase(p, pass, ph, true, smem); grid.sync(); run_phase(p, pass, ph, false, smem); }
      else
#endif
      run_phase(p, pass, ph, true, smem);
    }
    if (step + 1 < p.step_hi) grid.sync();
  }
}

extern "C" void kernel_launch(void* const* d_in, const int* in_sizes, int n_in, void* d_out, int out_size, void* d_ws,
                              size_t ws_size, hipStream_t stream) {
  static int grid_blocks = 0;
  if (!grid_blocks) {
    int dev = 0, cus = 0, per_cu = 0;
    (void)hipGetDevice(&dev);
    (void)hipDeviceGetAttribute(&cus, hipDeviceAttributeMultiprocessorCount, dev);
    (void)hipOccupancyMaxActiveBlocksPerMultiprocessor(&per_cu, mega_kernel, 512, 0);
    if (per_cu > 1) per_cu = 1;
    if (per_cu < 1) per_cu = 1;
    grid_blocks = cus * per_cu;
  }
  Params p{};
  const float* const* in = (const float* const*)d_in;
  p.x = in[0]; p.mem = in[1]; p.norm_g = in[2]; p.mem_norm_g = in[3]; p.w_in = in[4]; p.b_merge = in[5]; p.conv_w = in[6];
  p.conv_b = in[7]; p.lru_wa = in[8]; p.lru_ba = in[9]; p.lru_wx = in[10]; p.lru_bx = in[11]; p.lru_lambda = in[12];
  p.q_norm_g = in[13]; p.k_norm_g = in[14]; p.rel_bias = in[15]; p.w_mem_kv = in[16]; p.mem_q_norm_g = in[17];
  p.mem_k_norm_g = in[18]; p.w_proj_rnn = in[19]; p.w_proj_att = in[20]; p.w_proj_mem = in[21]; p.w_out = in[22];
  p.out = (float*)d_out;
  p.ws = (unsigned char*)d_ws;
  if (WS_NEED > ws_size) { fprintf(stderr, "workspace too small: need %llu have %zu\n", WS_NEED, ws_size); return; }
  p.step_lo = 0; p.step_hi = 2 + 5 * NPASS;
  void* args[] = {&p};
  hipError_t e = hipLaunchCooperativeKernel((void*)mega_kernel, dim3(grid_blocks), dim3(512), args, 0, stream);
  if (e != hipSuccess) fprintf(stderr, "cooperative launch failed: %s (grid %d)\n", hipGetErrorString(e), grid_blocks);
}
```

```cpp
#include <hip/hip_runtime.h>
#include <hip/hip_cooperative_groups.h>
#include <cstdio>
#include <cstddef>
namespace cg = cooperative_groups;

#define DI __device__ __forceinline__
typedef unsigned short u16;
using bf16x8 = __attribute__((ext_vector_type(8))) short;
using f32x4  = __attribute__((ext_vector_type(4))) float;
using f32x16 = __attribute__((ext_vector_type(16))) float;
using u32x4  = __attribute__((ext_vector_type(4))) unsigned;

constexpr int SEQ = 4096;
constexpr int GB = 4;
constexpr int NPASS = 4;
constexpr int TOK = GB * SEQ;
constexpr int SMEM_BYTES = 147456;
constexpr int T_TR = 2816 + 1024 + 512 + 64;
constexpr int T_ROWS = 8192 + 512;
constexpr float EPS = 1e-6f;

constexpr unsigned long long ACT = (unsigned long long)TOK * 1024 * 2;
constexpr unsigned long long OFF_wt_in = 0ull;
constexpr unsigned long long OFF_wt_prnn = OFF_wt_in + ((11264ull*1024*2 + 255ull) & ~255ull);
constexpr unsigned long long OFF_wt_patt = OFF_wt_prnn + ((1024ull*1024*2 + 255ull) & ~255ull);
constexpr unsigned long long OFF_wt_pmem = OFF_wt_patt + ((1024ull*1024*2 + 255ull) & ~255ull);
constexpr unsigned long long OFF_wt_out = OFF_wt_pmem + ((1024ull*1024*2 + 255ull) & ~255ull);
constexpr unsigned long long OFF_wt_memkv = OFF_wt_out + ((1024ull*1024*2 + 255ull) & ~255ull);
constexpr unsigned long long OFF_wt_a = OFF_wt_memkv + ((2048ull*1024*2 + 255ull) & ~255ull);
constexpr unsigned long long OFF_wt_x = OFF_wt_a + ((8ull*128*128*2 + 255ull) & ~255ull);
constexpr unsigned long long OFF_h = OFF_wt_x + ((8ull*128*128*2 + 255ull) & ~255ull);
constexpr unsigned long long OFF_mem_n = OFF_h + ((65536ull*1024*2 + 255ull) & ~255ull);
constexpr unsigned long long OFF_memk = OFF_mem_n + ((4096ull*1024*2 + 255ull) & ~255ull);
constexpr unsigned long long OFF_memvt = OFF_memk + ((4096ull*1024*2 + 255ull) & ~255ull);
constexpr unsigned long long OFF_xr = OFF_memvt + ((4096ull*1024*2 + 255ull) & ~255ull);
constexpr unsigned long long OFF_grs = OFF_xr + ((ACT + 255ull) & ~255ull);
constexpr unsigned long long OFF_qn = OFF_grs + ((ACT + 255ull) & ~255ull);
constexpr unsigned long long OFF_kn = OFF_qn + ((ACT + 255ull) & ~255ull);
constexpr unsigned long long OFF_vt = OFF_kn + ((ACT + 255ull) & ~255ull);
constexpr unsigned long long OFF_gas = OFF_vt + ((ACT + 255ull) & ~255ull);
constexpr unsigned long long OFF_qm = OFF_gas + ((ACT + 255ull) & ~255ull);
constexpr unsigned long long OFF_gms = OFF_qm + ((ACT + 255ull) & ~255ull);
constexpr unsigned long long OFF_gsig = OFF_gms + ((ACT + 255ull) & ~255ull);
constexpr unsigned long long OFF_hloc = OFF_gsig + ((ACT*3 + 255ull) & ~255ull);
constexpr unsigned long long OFF_cuma = OFF_hloc + ((ACT*2 + 255ull) & ~255ull);
constexpr unsigned long long OFF_chA = OFF_cuma + ((ACT*2 + 255ull) & ~255ull);
constexpr unsigned long long OFF_chH = OFF_chA + (((unsigned long long)GB*64*1024*4 + 255ull) & ~255ull);
constexpr unsigned long long OFF_rnn_g = OFF_chH + (((unsigned long long)GB*64*1024*4 + 255ull) & ~255ull);
constexpr unsigned long long OFF_att_g = OFF_rnn_g + ((ACT + 255ull) & ~255ull);
constexpr unsigned long long OFF_mem_g = OFF_att_g + ((ACT + 255ull) & ~255ull);
constexpr unsigned long long OFF_y = OFF_mem_g + ((ACT + 255ull) & ~255ull);
constexpr unsigned long long OFF_bar = OFF_y + ((ACT + 255ull) & ~255ull);
constexpr unsigned long long WS_NEED = OFF_bar + 256ull;
DI unsigned char* oq(unsigned char* w) { asm volatile("" : "+s"(w)); return w; }
struct Params {
  const float *x, *mem, *norm_g, *mem_norm_g, *w_in, *b_merge, *conv_w, *conv_b, *lru_wa, *lru_ba, *lru_wx, *lru_bx,
      *lru_lambda, *q_norm_g, *k_norm_g, *rel_bias, *w_mem_kv, *mem_q_norm_g, *mem_k_norm_g, *w_proj_rnn, *w_proj_att,
      *w_proj_mem, *w_out;
  float* out;
  unsigned char* ws;
  int step_lo, step_hi;
  DI u16* wt_in() const { return (u16*)(ws + OFF_wt_in); }
  DI u16* wt_prnn() const { return (u16*)(ws + OFF_wt_prnn); }
  DI u16* wt_patt() const { return (u16*)(ws + OFF_wt_patt); }
  DI u16* wt_pmem() const { return (u16*)(ws + OFF_wt_pmem); }
  DI u16* wt_out() const { return (u16*)(ws + OFF_wt_out); }
  DI u16* wt_memkv() const { return (u16*)(ws + OFF_wt_memkv); }
  DI u16* wt_a() const { return (u16*)(ws + OFF_wt_a); }
  DI u16* wt_x() const { return (u16*)(ws + OFF_wt_x); }
  DI u16* h() const { return (u16*)(ws + OFF_h); }
  DI u16* mem_n() const { return (u16*)(ws + OFF_mem_n); }
  DI u16* memk() const { return (u16*)(ws + OFF_memk); }
  DI u16* memvt() const { return (u16*)(ws + OFF_memvt); }
  DI u16* xr() const { return (u16*)(ws + OFF_xr); }
  DI u16* grs() const { return (u16*)(ws + OFF_grs); }
  DI u16* qn() const { return (u16*)(ws + OFF_qn); }
  DI u16* kn() const { return (u16*)(ws + OFF_kn); }
  DI u16* vt() const { return (u16*)(ws + OFF_vt); }
  DI u16* gas() const { return (u16*)(ws + OFF_gas); }
  DI u16* qm() const { return (u16*)(ws + OFF_qm); }
  DI u16* gms() const { return (u16*)(ws + OFF_gms); }
  DI u16* gsig() const { return (u16*)(ws + OFF_gsig); }
  DI float* hloc() const { return (float*)(ws + OFF_hloc); }
  DI float* cuma() const { return (float*)(ws + OFF_cuma); }
  DI float* chA() const { return (float*)(ws + OFF_chA); }
  DI float* chH() const { return (float*)(ws + OFF_chH); }
  DI u16* rnn_g() const { return (u16*)(ws + OFF_rnn_g); }
  DI u16* att_g() const { return (u16*)(ws + OFF_att_g); }
  DI u16* mem_g() const { return (u16*)(ws + OFF_mem_g); }
  DI u16* y() const { return (u16*)(ws + OFF_y); }
};

DI void fast_barrier(unsigned* ctr, unsigned target) {
  asm volatile("s_waitcnt vmcnt(0)" ::: "memory");
  __syncthreads();
  if (__builtin_amdgcn_workitem_id_x() == 0) {
    __builtin_amdgcn_fence(__ATOMIC_RELEASE, "agent");
    asm volatile("s_waitcnt vmcnt(0)" ::: "memory");
    (void)__hip_atomic_fetch_add(ctr, 1u, __ATOMIC_RELAXED, __HIP_MEMORY_SCOPE_AGENT);
    unsigned sp = 0;
    while (__hip_atomic_load(ctr, __ATOMIC_RELAXED, __HIP_MEMORY_SCOPE_AGENT) < target) {
      __builtin_amdgcn_s_sleep(1);
      if (++sp > (1u << 24)) break;
    }
    __builtin_amdgcn_fence(__ATOMIC_ACQUIRE, "agent");
    asm volatile("s_waitcnt vmcnt(0)" ::: "memory");
  }
  __syncthreads();
}
DI int get_tid() { int t = __builtin_amdgcn_workitem_id_x(); asm volatile("" : "+v"(t)); return t; }
typedef float f32x2_t __attribute__((ext_vector_type(2)));
typedef __bf16 bf16x2_t __attribute__((ext_vector_type(2)));
DI unsigned pack2(float a, float b) { f32x2_t v = {a, b}; return __builtin_bit_cast(unsigned, __builtin_convertvector(v, bf16x2_t)); }
DI u16 f2bf(float x) { return (u16)(pack2(x, x) & 0xffffu); }
DI float bf2f(u16 b) { return __uint_as_float(((unsigned)b) << 16); }
DI float sigm(float v) { return __builtin_amdgcn_rcpf(1.f + __builtin_amdgcn_exp2f(-1.4426950408889634f * v)); }
DI float silu(float v) { return v * sigm(v); }
DI uint4 pack8(const float* v) { uint4 r; r.x = pack2(v[0], v[1]); r.y = pack2(v[2], v[3]); r.z = pack2(v[4], v[5]); r.w = pack2(v[6], v[7]); return r; }
DI void unpack8(uint4 r, float* v) {
  v[0] = __uint_as_float(r.x << 16); v[1] = __uint_as_float(r.x & 0xffff0000u);
  v[2] = __uint_as_float(r.y << 16); v[3] = __uint_as_float(r.y & 0xffff0000u);
  v[4] = __uint_as_float(r.z << 16); v[5] = __uint_as_float(r.z & 0xffff0000u);
  v[6] = __uint_as_float(r.w << 16); v[7] = __uint_as_float(r.w & 0xffff0000u);
}

template <bool PANEL>
DI void transpose_tile(const float* __restrict__ src, int R, int C, u16* __restrict__ dst, int tr, int tc, float* tile) {
  const int tid = get_tid();
  __syncthreads();
#pragma unroll
  for (int i = 0; i < 2; ++i) {
    const int r = (tid >> 4) + 32 * i, c4 = (tid & 15) * 4;
    const float4 v = *(const float4*)(src + (size_t)(tr * 64 + r) * C + tc * 64 + c4);
    tile[r * 65 + c4 + 0] = v.x; tile[r * 65 + c4 + 1] = v.y; tile[r * 65 + c4 + 2] = v.z; tile[r * 65 + c4 + 3] = v.w;
  }
  __syncthreads();
  {
    const int c = tid >> 3, r8 = (tid & 7) * 8;
    float v[8];
#pragma unroll
    for (int j = 0; j < 8; ++j) v[j] = tile[(r8 + j) * 65 + c];
    if (PANEL) *(uint4*)(dst + ((size_t)tr * C + tc * 64 + c) * 64 + r8) = pack8(v);
    else *(uint4*)(dst + (size_t)(tc * 64 + c) * R + tr * 64 + r8) = pack8(v);
  }
}

DI void rms_row(const float* __restrict__ src, const float* __restrict__ g, u16* __restrict__ dst, size_t ROWS, size_t r) {
  const int lane = get_tid() & 63;
  float4 v[4];
  float ss = 0.f;
#pragma unroll
  for (int i = 0; i < 4; ++i) {
    v[i] = *(const float4*)(src + i * 256 + lane * 4);
    ss += v[i].x * v[i].x + v[i].y * v[i].y + v[i].z * v[i].z + v[i].w * v[i].w;
  }
#pragma unroll
  for (int o = 32; o >= 1; o >>= 1) ss += __shfl_xor(ss, o);
  const float rstd = rsqrtf(ss * (1.f / 1024.f) + EPS);
#pragma unroll
  for (int i = 0; i < 4; ++i) {
    const float4 gg = *(const float4*)(g + i * 256 + lane * 4);
    uint2 o;
    o.x = pack2(v[i].x * rstd * gg.x, v[i].y * rstd * gg.y);
    o.y = pack2(v[i].z * rstd * gg.z, v[i].w * rstd * gg.w);
    *(uint2*)(dst + ((size_t)(i * 4 + (lane >> 4)) * ROWS + r) * 64 + (lane & 15) * 4) = o;
  }
}

DI void step_prep(const Params& p, unsigned char* smem) {
  float* tile = (float*)smem;
  for (int it = blockIdx.x; it < T_TR + T_ROWS; it += gridDim.x) {
    if (it < T_TR) {
      int j = it;
      if (j < 2816) { transpose_tile<true>(p.w_in, 1024, 11264, p.wt_in(), j % 16, j / 16, tile); continue; }
      j -= 2816;
      if (j < 1024) {
        const int k = j >> 8, jj = j & 255;
        const float* s = k == 0 ? p.w_proj_rnn : k == 1 ? p.w_proj_att : k == 2 ? p.w_proj_mem : p.w_out;
        u16* d = k == 0 ? p.wt_prnn() : k == 1 ? p.wt_patt() : k == 2 ? p.wt_pmem() : p.wt_out();
        transpose_tile<true>(s, 1024, 1024, d, jj % 16, jj / 16, tile);
        continue;
      }
      j -= 1024;
      if (j < 512) { transpose_tile<true>(p.w_mem_kv, 1024, 2048, p.wt_memkv(), j % 16, j / 16, tile); continue; }
      j -= 512;
      {
        const int mat = j >> 5, jj = j & 31, n = jj >> 2, tr = (jj >> 1) & 1, tc = jj & 1;
        transpose_tile<false>((mat ? p.lru_wx : p.lru_wa) + n * 16384, 128, 128, (mat ? p.wt_x() : p.wt_a()) + n * 16384, tr, tc, tile);
      }
    } else {
      const int r = (it - T_TR) * 8 + (get_tid() >> 6);
      if (r < 65536) rms_row(p.x + (size_t)r * 1024, p.norm_g, p.h(), 65536, r);
      else { const int m = r - 65536; rms_row(p.mem + (size_t)m * 1024, p.mem_norm_g, p.mem_n(), 4096, m); }
    }
  }
}

DI void zero_acc(f32x16 (&acc)[2][4]) {
#pragma unroll
  for (int a = 0; a < 2; ++a)
#pragma unroll
    for (int b = 0; b < 4; ++b)
#pragma unroll
      for (int r = 0; r < 16; ++r) acc[a][b][r] = 0.f;
}

DI void gemm_kloop(const u16* __restrict__ A, size_t aks, const u16* __restrict__ Bt, size_t bks, int K, f32x16 (&acc)[2][4],
                   unsigned char* smem) {
  u16* sA = (u16*)smem;
  const int tid = get_tid(), lane = tid & 63, wave = tid >> 6, wm = wave >> 1, wn = wave & 1;
  const int lr = tid >> 3, lc = (tid & 7) * 8;
  const u16* ga = A + (size_t)lr * 64 + lc;
  const u16* gb = Bt + (size_t)lr * 64 + lc;
  constexpr size_t sa64 = 4096, sb64 = 4096;
  u32x4 ra0 = *(const u32x4*)(ga), ra1 = *(const u32x4*)(ga + sa64), ra2 = *(const u32x4*)(ga + 2 * sa64), ra3 = *(const u32x4*)(ga + 3 * sa64);
  u32x4 rb0 = *(const u32x4*)(gb), rb1 = *(const u32x4*)(gb + sb64), rb2 = *(const u32x4*)(gb + 2 * sb64), rb3 = *(const u32x4*)(gb + 3 * sb64);
  const int nk = K >> 6;
  const int pa_off = (wm * 64 + (lane & 31)) * 72 + (lane >> 5) * 8;
  const int pb_off = 18432 + (wn * 128 + (lane & 31)) * 72 + (lane >> 5) * 8;
  const int wa_off = lr * 72 + lc;
  const int wb_off = 18432 + lr * 72 + lc;
  __syncthreads();
  {
    u16* d = sA + wa_off;
    *(u32x4*)(d) = ra0; *(u32x4*)(d + 64 * 72) = ra1; *(u32x4*)(d + 128 * 72) = ra2; *(u32x4*)(d + 192 * 72) = ra3;
    d = sA + wb_off;
    *(u32x4*)(d) = rb0; *(u32x4*)(d + 64 * 72) = rb1; *(u32x4*)(d + 128 * 72) = rb2; *(u32x4*)(d + 192 * 72) = rb3;
  }
  if (nk > 1) {
    ga += aks; gb += bks;
    ra0 = *(const u32x4*)(ga); ra1 = *(const u32x4*)(ga + sa64); ra2 = *(const u32x4*)(ga + 2 * sa64); ra3 = *(const u32x4*)(ga + 3 * sa64);
    rb0 = *(const u32x4*)(gb); rb1 = *(const u32x4*)(gb + sb64); rb2 = *(const u32x4*)(gb + 2 * sb64); rb3 = *(const u32x4*)(gb + 3 * sb64);
  }
  __syncthreads();
  for (int kt = 0; kt < nk; ++kt) {
    const int cur = (kt & 1) * 36864, nxt = 36864 - cur;
    const bool wr = kt + 1 < nk, ld = kt + 2 < nk;
    if (ld) { ga += aks; gb += bks; }
    const u16* pa = sA + cur + pa_off;
    const u16* pb = sA + cur + pb_off;
    u16* da = sA + nxt + wa_off;
    u16* db = sA + nxt + wb_off;
#pragma unroll
    for (int s = 0; s < 4; ++s) {
      if (wr) {
        if (s == 0) { *(u32x4*)(da) = ra0; *(u32x4*)(da + 64 * 72) = ra1; }
        if (s == 1) { *(u32x4*)(da + 128 * 72) = ra2; *(u32x4*)(da + 192 * 72) = ra3; }
        if (s == 2) { *(u32x4*)(db) = rb0; *(u32x4*)(db + 64 * 72) = rb1; }
        if (s == 3) { *(u32x4*)(db + 128 * 72) = rb2; *(u32x4*)(db + 192 * 72) = rb3; }
      }
      if (ld) {
        if (s == 0) { ra0 = *(const u32x4*)(ga); ra1 = *(const u32x4*)(ga + sa64); }
        if (s == 1) { ra2 = *(const u32x4*)(ga + 2 * sa64); ra3 = *(const u32x4*)(ga + 3 * sa64); }
        if (s == 2) { rb0 = *(const u32x4*)(gb); rb1 = *(const u32x4*)(gb + sb64); }
        if (s == 3) { rb2 = *(const u32x4*)(gb + 2 * sb64); rb3 = *(const u32x4*)(gb + 3 * sb64); }
      }
      const bf16x8 a0 = *(const bf16x8*)(pa + s * 16);
      const bf16x8 a1 = *(const bf16x8*)(pa + 32 * 72 + s * 16);
      const bf16x8 b0 = *(const bf16x8*)(pb + s * 16);
      const bf16x8 b1 = *(const bf16x8*)(pb + 32 * 72 + s * 16);
      const bf16x8 b2 = *(const bf16x8*)(pb + 64 * 72 + s * 16);
      const bf16x8 b3 = *(const bf16x8*)(pb + 96 * 72 + s * 16);
      acc[0][0] = __builtin_amdgcn_mfma_f32_32x32x16_bf16(a0, b0, acc[0][0], 0, 0, 0);
      acc[0][1] = __builtin_amdgcn_mfma_f32_32x32x16_bf16(a0, b1, acc[0][1], 0, 0, 0);
      acc[0][2] = __builtin_amdgcn_mfma_f32_32x32x16_bf16(a0, b2, acc[0][2], 0, 0, 0);
      acc[0][3] = __builtin_amdgcn_mfma_f32_32x32x16_bf16(a0, b3, acc[0][3], 0, 0, 0);
      acc[1][0] = __builtin_amdgcn_mfma_f32_32x32x16_bf16(a1, b0, acc[1][0], 0, 0, 0);
      acc[1][1] = __builtin_amdgcn_mfma_f32_32x32x16_bf16(a1, b1, acc[1][1], 0, 0, 0);
      acc[1][2] = __builtin_amdgcn_mfma_f32_32x32x16_bf16(a1, b2, acc[1][2], 0, 0, 0);
      acc[1][3] = __builtin_amdgcn_mfma_f32_32x32x16_bf16(a1, b3, acc[1][3], 0, 0, 0);
      __builtin_amdgcn_sched_barrier(0);
    }
    __syncthreads();
  }
}

template <typename F>
DI void wave_epilogue(const f32x16 (&acc)[2][4], unsigned char* smem, F f) {
  const int tid = get_tid(), lane = tid & 63, wave = tid >> 6;
  float* sW = (float*)smem + wave * (32 * 132);
#pragma unroll
  for (int mi = 0; mi < 2; ++mi) {
#pragma unroll
    for (int ni = 0; ni < 4; ++ni)
#pragma unroll
      for (int r = 0; r < 16; ++r) {
        const int row = (r & 3) + 8 * (r >> 2) + 4 * (lane >> 5);
        sW[row * 132 + ni * 32 + (lane & 31)] = acc[mi][ni][r];
      }
    __builtin_amdgcn_fence(__ATOMIC_RELEASE, "wavefront");
    __builtin_amdgcn_fence(__ATOMIC_ACQUIRE, "wavefront");
    f(mi, sW);
    __builtin_amdgcn_fence(__ATOMIC_RELEASE, "wavefront");
    __builtin_amdgcn_fence(__ATOMIC_ACQUIRE, "wavefront");
  }
}

template <typename F>
DI void slab_rows(const float* sW, F f) {
  const int lane = get_tid() & 63, rsub = lane >> 3, chunk = lane & 7;
#pragma unroll
  for (int i = 0; i < 4; ++i)
#pragma unroll
    for (int hf = 0; hf < 2; ++hf) {
      const int row = i * 8 + rsub, c = hf * 64 + chunk * 8;
      float v[8];
      const float4 a = *(const float4*)(sW + row * 132 + c), b = *(const float4*)(sW + row * 132 + c + 4);
      v[0] = a.x; v[1] = a.y; v[2] = a.z; v[3] = a.w; v[4] = b.x; v[5] = b.y; v[6] = b.z; v[7] = b.w;
      f(row, c, v, i);
    }
}

DI void slab_store_transposed(const float* sW, u16* __restrict__ dst, size_t ldd) {
  const int lane = get_tid() & 63;
#pragma unroll
  for (int dd = 0; dd < 2; ++dd)
#pragma unroll
    for (int j = 0; j < 4; ++j) {
      const int d = lane + 64 * dd;
      float v[8];
#pragma unroll
      for (int e = 0; e < 8; ++e) v[e] = sW[(j * 8 + e) * 132 + d];
      *(uint4*)(dst + (size_t)d * ldd + j * 8) = pack8(v);
    }
}

DI void step_memkv(const Params& p, unsigned char* smem) {
  for (int t = blockIdx.x; t < 16 * 8; t += gridDim.x) {
    const int mt = t % 16, nt = t / 16;
    f32x16 acc[2][4];
    zero_acc(acc);
    gemm_kloop(p.mem_n() + (size_t)mt * 256 * 64, (size_t)4096 * 64, p.wt_memkv() + (size_t)nt * 256 * 64, (size_t)2048 * 64, 1024, acc, smem);
    const int wave = get_tid() >> 6, wm = wave >> 1, wn = wave & 1;
    wave_epilogue(acc, smem, [&](int mi, const float* sW) {
      const int r0 = wm * 64 + mi * 32;
      if (nt < 4) {
        u16* dst = p.memk() + ((size_t)mt * 256 + r0) * 1024 + nt * 256 + wn * 128;
        slab_rows(sW, [&](int row, int c, const float* v, int i_) { *(uint4*)(dst + (size_t)row * 1024 + c) = pack8(v); });
      } else {
        const int hh = nt - 4;
        slab_store_transposed(sW, p.memvt() + ((size_t)(mt * 4 + hh) * 256 + wn * 128) * 256 + r0, 256);
      }
    });
  }
}

DI void memk_norm_row(const Params& p, int row) {
  const int lane = get_tid() & 63;
  u16* ptr = p.memk() + (size_t)row * 1024 + lane * 16;
  float v[16];
  unpack8(*(const uint4*)ptr, v);
  unpack8(*(const uint4*)(ptr + 8), v + 8);
  float ss = 0.f;
#pragma unroll
  for (int e = 0; e < 16; ++e) ss += v[e] * v[e];
#pragma unroll
  for (int o = 1; o <= 8; o <<= 1) ss += __shfl_xor(ss, o);
  const float sc = rsqrtf(ss * (1.f / 256.f) + EPS);
  const float* g = p.mem_k_norm_g + (lane & 15) * 16;
#pragma unroll
  for (int e = 0; e < 16; ++e) v[e] *= sc * g[e];
  *(uint4*)ptr = pack8(v);
  *(uint4*)(ptr + 8) = pack8(v + 8);
}

DI void step_gemm1(const Params& p, int pass, bool first, unsigned char* smem) {
  if (pass == 0 && first) {
    for (int it = blockIdx.x; it < 512; it += gridDim.x) memk_norm_row(p, it * 8 + (get_tid() >> 6));
  }
  const u16* A = p.h() + (size_t)pass * TOK * 64;
  constexpr int MT = TOK / 256;
  for (int t = blockIdx.x; t < MT * 44; t += gridDim.x) {
    const int mt = t % MT, nt = t / MT;
    f32x16 acc[2][4];
    zero_acc(acc);
    gemm_kloop(A + (size_t)mt * 256 * 64, (size_t)65536 * 64, p.wt_in() + (size_t)nt * 256 * 64, (size_t)11264 * 64, 1024, acc, smem);
    const int wave = get_tid() >> 6, wm = wave >> 1, wn = wave & 1;
    const int seg = nt >> 2, cb = (nt & 3) * 256 + wn * 128;
    wave_epilogue(acc, smem, [&](int mi, const float* sW) {
      const size_t rowbase = (size_t)mt * 256 + wm * 64 + mi * 32;
      if (seg == 0 || seg == 6) {
        u16* dst = (seg == 0 ? p.xr() : p.qm()) + rowbase * 1024 + cb;
        slab_rows(sW, [&](int row, int c, const float* v, int i_) { *(uint4*)(dst + (size_t)row * 1024 + c) = pack8(v); });
      } else if (seg == 1 || seg == 5 || seg == 7) {
        u16* dst = (seg == 1 ? p.grs() : seg == 5 ? p.gas() : p.gms()) + rowbase * 1024 + cb;
        slab_rows(sW, [&](int row, int c, const float* v, int i_) {
          float o[8];
#pragma unroll
          for (int e = 0; e < 8; ++e) o[e] = silu(v[e]);
          *(uint4*)(dst + (size_t)row * 1024 + c) = pack8(o);
        });
      } else if (seg == 2 || seg == 3) {
        float ss[4] = {0.f, 0.f, 0.f, 0.f};
        slab_rows(sW, [&](int row, int c, const float* v, int i_) {
#pragma unroll
          for (int e = 0; e < 8; ++e) ss[i_] += v[e] * v[e];
        });
        float sc[4];
#pragma unroll
        for (int q_ = 0; q_ < 4; ++q_) {
          float t_ = ss[q_];
          t_ += __shfl_xor(t_, 1); t_ += __shfl_xor(t_, 2); t_ += __shfl_xor(t_, 4);
          sc[q_] = rsqrtf(t_ * (1.f / 128.f) + EPS) * (seg == 2 ? 0.08838834764831845f : 1.f);
        }
        const float* g = seg == 2 ? p.q_norm_g : p.k_norm_g;
        u16* dst = (seg == 2 ? p.qn() : p.kn()) + rowbase * 1024 + cb;
        slab_rows(sW, [&](int row, int c, const float* v, int i_) {
          float o[8];
          const float4 g0 = *(const float4*)(g + c), g1 = *(const float4*)(g + c + 4);
          const float s_ = sc[i_];
          o[0] = v[0] * s_ * g0.x; o[1] = v[1] * s_ * g0.y; o[2] = v[2] * s_ * g0.z; o[3] = v[3] * s_ * g0.w;
          o[4] = v[4] * s_ * g1.x; o[5] = v[5] * s_ * g1.y; o[6] = v[6] * s_ * g1.z; o[7] = v[7] * s_ * g1.w;
          *(uint4*)(dst + (size_t)row * 1024 + c) = pack8(o);
        });
      } else if (seg == 4) {
        const int bl = mt >> 4, s0 = (mt & 15) * 256 + wm * 64 + mi * 32, hh = cb >> 7;
        slab_store_transposed(sW, p.vt() + (size_t)(bl * 8 + hh) * 128 * 4096 + s0, 4096);
      } else {
        const int gc = (nt - 32) * 256 + wn * 128;
        const float* bm = p.b_merge + gc;
        u16* dst = p.gsig() + rowbase * 3072 + gc;
        slab_rows(sW, [&](int row, int c, const float* v, int i_) {
          float o[8];
          const float4 b0 = *(const float4*)(bm + c), b1 = *(const float4*)(bm + c + 4);
          o[0] = sigm(v[0] + b0.x); o[1] = sigm(v[1] + b0.y); o[2] = sigm(v[2] + b0.z); o[3] = sigm(v[3] + b0.w);
          o[4] = sigm(v[4] + b1.x); o[5] = sigm(v[5] + b1.y); o[6] = sigm(v[6] + b1.z); o[7] = sigm(v[7] + b1.w);
          *(uint4*)(dst + (size_t)row * 3072 + c) = pack8(o);
        });
      }
    });
  }
}

template <int HD, bool BAND>
DI void attn_core(const u16* __restrict__ Q, const u16* __restrict__ K, const u16* __restrict__ Vt, int ldv, int u0, int u1,
                  const float* __restrict__ bias_row, const float* __restrict__ qg,
                  u16* __restrict__ Out, size_t orow0, int okb, const u16* __restrict__ Gate, unsigned char* smem) {
  constexpr int KS = HD / 32, DB = HD / 16, LDK = HD + 8, NCH = HD / 64;
  u16* sK = (u16*)smem;
  u16* sV = (u16*)(smem + 64 * LDK * 2);
  float* sBias = (float*)(smem + 64 * LDK * 2 + HD * 72 * 2);
  const int tid = get_tid(), lane = tid & 63, w = tid >> 6, l15 = lane & 15, g = lane >> 4, sb = w >> 2, wq = w & 3;
  __syncthreads();
  if (BAND) { for (int i = tid; i < 513; i += 512) sBias[i] = bias_row[i]; }
  bf16x8 qf[KS];
  {
    const u16* qrow = Q + (size_t)(w * 16 + l15) * 1024 + g * 8;
#pragma unroll
    for (int ks = 0; ks < KS; ++ks) qf[ks] = *(const bf16x8*)(qrow + ks * 32);
    if (!BAND) {
      float ss = 0.f;
#pragma unroll
      for (int ks = 0; ks < KS; ++ks) {
        float v[8];
        unpack8(__builtin_bit_cast(uint4, qf[ks]), v);
#pragma unroll
        for (int e = 0; e < 8; ++e) ss += v[e] * v[e];
      }
      ss += __shfl_xor(ss, 16);
      ss += __shfl_xor(ss, 32);
      const float sc = rsqrtf(ss * (1.f / HD) + EPS) * 0.0625f;
#pragma unroll
      for (int ks = 0; ks < KS; ++ks) {
        float v[8];
        unpack8(__builtin_bit_cast(uint4, qf[ks]), v);
        const float4 g0 = *(const float4*)(qg + ks * 32 + g * 8), g1 = *(const float4*)(qg + ks * 32 + g * 8 + 4);
        v[0] *= sc * g0.x; v[1] *= sc * g0.y; v[2] *= sc * g0.z; v[3] *= sc * g0.w;
        v[4] *= sc * g1.x; v[5] *= sc * g1.y; v[6] *= sc * g1.z; v[7] *= sc * g1.w;
        qf[ks] = __builtin_bit_cast(bf16x8, pack8(v));
      }
    }
  }
  f32x4 o[DB];
#pragma unroll
  for (int db = 0; db < DB; ++db) o[db] = f32x4{0.f, 0.f, 0.f, 0.f};
  float m = -1e30f, lsum = 0.f;

  const int krow = tid >> 3, kpart = (tid & 7) * (HD / 8);
  u32x4 rk[NCH], rv[NCH];
  {
    const u16* ksrc = K + ((size_t)u0 * 64 + krow) * 1024 + kpart;
#pragma unroll
    for (int i = 0; i < NCH; ++i) rk[i] = *(const u32x4*)(ksrc + i * 8);
#pragma unroll
    for (int i = 0; i < NCH; ++i) {
      const int id = tid + 512 * i, d = id >> 3, cc = id & 7;
      rv[i] = *(const u32x4*)(Vt + (size_t)d * ldv + u0 * 64 + cc * 8);
    }
  }
  for (int u = u0; u < u1; ++u) {
    __syncthreads();
#pragma unroll
    for (int i = 0; i < NCH; ++i) *(u32x4*)(sK + krow * LDK + kpart + i * 8) = rk[i];
#pragma unroll
    for (int i = 0; i < NCH; ++i) {
      const int id = tid + 512 * i, d = id >> 3, cc = id & 7;
      *(u32x4*)(sV + d * 72 + cc * 8) = rv[i];
    }
    __syncthreads();
    if (u + 1 < u1) {
      const u16* ksrc = K + ((size_t)(u + 1) * 64 + krow) * 1024 + kpart;
#pragma unroll
      for (int i = 0; i < NCH; ++i) rk[i] = *(const u32x4*)(ksrc + i * 8);
#pragma unroll
      for (int i = 0; i < NCH; ++i) {
        const int id = tid + 512 * i, d = id >> 3, cc = id & 7;
        rv[i] = *(const u32x4*)(Vt + (size_t)d * ldv + (u + 1) * 64 + cc * 8);
      }
    }
    if (BAND && (u < sb || u > sb + 8)) continue;
    f32x4 s[4];
#pragma unroll
    for (int kb = 0; kb < 4; ++kb) {
      s[kb] = f32x4{0.f, 0.f, 0.f, 0.f};
#pragma unroll
      for (int ks = 0; ks < KS; ++ks) {
        const bf16x8 kf = *(const bf16x8*)(sK + (kb * 16 + l15) * LDK + ks * 32 + g * 8);
        s[kb] = __builtin_amdgcn_mfma_f32_16x16x32_bf16(kf, qf[ks], s[kb], 0, 0, 0);
      }
      if (HD > 128) __builtin_amdgcn_sched_barrier(0);
    }
    float mx = -1e30f;
#pragma unroll
    for (int kb = 0; kb < 4; ++kb)
#pragma unroll
      for (int i = 0; i < 4; ++i) {
        if (BAND) {
          const int dist = (8 + sb - u) * 64 + (wq * 16 + l15) - (kb * 16 + g * 4 + i);
          s[kb][i] += sBias[min(dist, 256) + 256];
        }
        mx = fmaxf(mx, s[kb][i]);
      }
    mx = fmaxf(mx, __shfl_xor(mx, 16));
    mx = fmaxf(mx, __shfl_xor(mx, 32));
    const float mn = fmaxf(m, mx);
    const float alpha = __expf(m - mn);
    m = mn;
    lsum *= alpha;
#pragma unroll
    for (int db = 0; db < DB; ++db) { o[db][0] *= alpha; o[db][1] *= alpha; o[db][2] *= alpha; o[db][3] *= alpha; }
    bf16x8 pf[2];
#pragma unroll
    for (int k2 = 0; k2 < 2; ++k2) {
      float pv[8];
#pragma unroll
      for (int i = 0; i < 4; ++i) {
        pv[i] = __expf(s[2 * k2][i] - mn);
        pv[4 + i] = __expf(s[2 * k2 + 1][i] - mn);
      }
#pragma unroll
      for (int e = 0; e < 8; ++e) lsum += pv[e];
      pf[k2] = __builtin_bit_cast(bf16x8, pack8(pv));
    }
#pragma unroll
    for (int db = 0; db < DB; ++db) {
#pragma unroll
      for (int k2 = 0; k2 < 2; ++k2) {
        const u16* vp = sV + (db * 16 + l15) * 72 + k2 * 32 + g * 4;
        const uint2 lo = *(const uint2*)vp, hi = *(const uint2*)(vp + 16);
        uint4 vv; vv.x = lo.x; vv.y = lo.y; vv.z = hi.x; vv.w = hi.y;
        o[db] = __builtin_amdgcn_mfma_f32_16x16x32_bf16(__builtin_bit_cast(bf16x8, vv), pf[k2], o[db], 0, 0, 0);
      }
      if (HD > 128 && (db & 3) == 3) __builtin_amdgcn_sched_barrier(0);
    }
  }
  lsum += __shfl_xor(lsum, 16);
  lsum += __shfl_xor(lsum, 32);
  const float inv = 1.f / lsum;
  {
    const size_t ro = (size_t)(w * 16 + l15) * 1024 + g * 4;
#pragma unroll
    for (int db = 0; db < DB; ++db) {
      const uint2 gv = *(const uint2*)(Gate + ro + db * 16);
      uint2 ov;
      ov.x = pack2(o[db][0] * inv * __uint_as_float(gv.x << 16), o[db][1] * inv * __uint_as_float(gv.x & 0xffff0000u));
      ov.y = pack2(o[db][2] * inv * __uint_as_float(gv.y << 16), o[db][3] * inv * __uint_as_float(gv.y & 0xffff0000u));
      *(uint2*)(Out + ((size_t)((okb >> 6) + (db >> 2)) * TOK + orow0 + w * 16 + l15) * 64 + (db & 3) * 16 + g * 4) = ov;
    }
  }
}

DI void rnn_local_item(const Params& p, int bl, int c0, int n, unsigned char* smem) {
  const int tid = get_tid(), sbk = tid >> 8, tl = tid & 255, lane = tid & 63, w = tl >> 6, l15 = lane & 15, g = lane >> 4;
  unsigned char* sm = smem + sbk * 67584;
  float* sxc = (float*)sm;
  float* sa = (float*)(sm + 33792);
  u16* sxcb = (u16*)(sm + 33792);
  const int c = c0 + sbk;
  const int ch0 = n * 128;
  const size_t tok0 = (size_t)bl * 4096 + c * 64;
  __syncthreads();
  {
    const int ch = tl & 127, half = tl >> 7;
    const float w0 = p.conv_w[ch0 + ch], w1 = p.conv_w[1024 + ch0 + ch], w2 = p.conv_w[2048 + ch0 + ch],
                w3 = p.conv_w[3072 + ch0 + ch], cb = p.conv_b[ch0 + ch];
    const int tb = half * 32;
    const u16* src = p.xr() + tok0 * 1024 + ch0 + ch;
    float x0 = (c * 64 + tb - 3 >= 0) ? bf2f(src[(ptrdiff_t)(tb - 3) * 1024]) : 0.f;
    float x1 = (c * 64 + tb - 2 >= 0) ? bf2f(src[(ptrdiff_t)(tb - 2) * 1024]) : 0.f;
    float x2 = (c * 64 + tb - 1 >= 0) ? bf2f(src[(ptrdiff_t)(tb - 1) * 1024]) : 0.f;
#pragma unroll 8
    for (int t = tb; t < tb + 32; ++t) {
      const float x3 = bf2f(src[(ptrdiff_t)t * 1024]);
      const float xc = w0 * x0 + w1 * x1 + w2 * x2 + w3 * x3 + cb;
      sxc[t * 132 + ch] = xc;
      sxcb[t * 136 + ch] = f2bf(xc);
      x0 = x1; x1 = x2; x2 = x3;
    }
  }
  __syncthreads();
  f32x4 accR[4][2], accI[4][2];
#pragma unroll
  for (int tb = 0; tb < 4; ++tb)
#pragma unroll
    for (int jb = 0; jb < 2; ++jb) { accR[tb][jb] = f32x4{0.f, 0.f, 0.f, 0.f}; accI[tb][jb] = f32x4{0.f, 0.f, 0.f, 0.f}; }
  {
    bf16x8 bR[2][4], bI[2][4];
#pragma unroll
    for (int jb = 0; jb < 2; ++jb)
#pragma unroll
      for (int ks = 0; ks < 4; ++ks) {
        const size_t off = (size_t)n * 16384 + (size_t)(32 * w + jb * 16 + l15) * 128 + ks * 32 + g * 8;
        bR[jb][ks] = *(const bf16x8*)(p.wt_a() + off);
        bI[jb][ks] = *(const bf16x8*)(p.wt_x() + off);
      }
#pragma unroll
    for (int tb = 0; tb < 4; ++tb)
#pragma unroll
      for (int ks = 0; ks < 4; ++ks) {
        const bf16x8 af = *(const bf16x8*)(sxcb + (tb * 16 + l15) * 136 + ks * 32 + g * 8);
#pragma unroll
        for (int jb = 0; jb < 2; ++jb) {
          accR[tb][jb] = __builtin_amdgcn_mfma_f32_16x16x32_bf16(af, bR[jb][ks], accR[tb][jb], 0, 0, 0);
          accI[tb][jb] = __builtin_amdgcn_mfma_f32_16x16x32_bf16(af, bI[jb][ks], accI[tb][jb], 0, 0, 0);
        }
      }
  }
  __syncthreads();
#pragma unroll
  for (int jb = 0; jb < 2; ++jb) {
    const int ch = 32 * w + jb * 16 + l15;
    const float ba = p.lru_ba[ch0 + ch], bx = p.lru_bx[ch0 + ch];
    const float sp = log1pf(expf(-p.lru_lambda[ch0 + ch]));
#pragma unroll
    for (int tb = 0; tb < 4; ++tb)
#pragma unroll
      for (int r = 0; r < 4; ++r) {
        const int t = tb * 16 + g * 4 + r;
        const float rg = sigm(accR[tb][jb][r] + ba), ig = sigm(accI[tb][jb][r] + bx);
        const float la = -8.f * rg * sp;
        const float a = __expf(la);
        const float mult = __builtin_amdgcn_sqrtf(fmaxf(1.f - __expf(2.f * la), 0.f));
        const float xc = sxc[t * 132 + ch];
        sa[t * 132 + ch] = a;
        sxc[t * 132 + ch] = mult * (ig * xc);
      }
  }
  __syncthreads();
  {
    const int ch = tl & 127, half = tl >> 7, tb = half * 32;
    float hh = 0.f, A = 1.f;
#pragma unroll 8
    for (int t = tb; t < tb + 32; ++t) {
      const float a = sa[t * 132 + ch];
      hh = a * hh + sxc[t * 132 + ch];
      A *= a;
      sxc[t * 132 + ch] = hh;
      sa[t * 132 + ch] = A;
    }
    __syncthreads();
    const float cH = half ? sxc[31 * 132 + ch] : 0.f;
    const float cA = half ? sa[31 * 132 + ch] : 1.f;
    float* ho = p.hloc() + (tok0 + tb) * 1024 + ch0 + ch;
    float* ao = p.cuma() + (tok0 + tb) * 1024 + ch0 + ch;
    float hl = 0.f, al = 1.f;
#pragma unroll 8
    for (int t = 0; t < 32; ++t) {
      const float al_ = sa[(tb + t) * 132 + ch];
      hl = sxc[(tb + t) * 132 + ch] + al_ * cH;
      al = al_ * cA;
      ho[(size_t)t * 1024] = hl;
      ao[(size_t)t * 1024] = al;
    }
    if (half) {
      p.chA()[((size_t)bl * 64 + c) * 1024 + ch0 + ch] = al;
      p.chH()[((size_t)bl * 64 + c) * 1024 + ch0 + ch] = hl;
    }
  }
}

DI void step_mix(const Params& p, int pass, unsigned char* smem) {
  constexpr int NB = GB * 32 * 8, NM = GB * 32 * 4, NR = GB * 32 * 8;
  for (int it = blockIdx.x; it < NB + NM + NR; it += gridDim.x) {
    if (it < NM) {
      const int hh = it & 3, tt = (it >> 2) & 31, bl = it >> 7;
      const int bgl = pass * GB + bl;
      const size_t tok = (size_t)bl * 4096 + tt * 128;
      attn_core<256, false>(p.qm() + tok * 1024 + hh * 256, p.memk() + (size_t)bgl * 256 * 1024 + hh * 256,
                            p.memvt() + (size_t)(bgl * 4 + hh) * 256 * 256, 256, 0, 4, nullptr, p.mem_q_norm_g,
                            p.mem_g(), tok, hh * 256, p.gms() + tok * 1024 + hh * 256, smem);
    } else if (it < NM + NB) {
      const int idx = it - NM;
      const int hh = idx & 7, cc = (idx >> 3) & 31, bl = idx >> 8;
      const int c0 = 2 * ((cc + 8 * bl) & 31);
      const size_t tok = (size_t)bl * 4096 + c0 * 64;
      const int u0 = c0 >= 8 ? 0 : 8 - c0;
      const u16* K0 = p.kn() + ((ptrdiff_t)bl * 4096 + (ptrdiff_t)(c0 - 8) * 64) * 1024 + hh * 128;
      const u16* V0 = p.vt() + (size_t)(bl * 8 + hh) * 128 * 4096 + (ptrdiff_t)(c0 - 8) * 64;
      attn_core<128, true>(p.qn() + tok * 1024 + hh * 128, K0, V0, 4096, u0, 10, p.rel_bias + hh * 513, nullptr,
                           p.att_g(), tok, hh * 128, p.gas() + tok * 1024 + hh * 128, smem);
    } else {
      const int idx = it - NM - NB;
      const int n = idx & 7, cp = (idx >> 3) & 31, bl = idx >> 8;
      rnn_local_item(p, bl, 2 * cp, n, smem);
    }
  }
}

DI void step_rnnfin(const Params& p, unsigned char* smem) {
  constexpr int NR = GB * 64 * 8;
  const int tid = get_tid(), ch = tid & 127, q = tid >> 7;
  for (int it = blockIdx.x; it < NR; it += gridDim.x) {
    const int n = it & 7, c = (it >> 3) & 63, bl = it >> 9;
    const int ch0 = n * 128;
    float carry = 0.f;
    for (int k = 0; k < c; ++k) {
      const size_t o = ((size_t)bl * 64 + k) * 1024 + ch0 + ch;
      carry = carry * p.chA()[o] + p.chH()[o];
    }
    const size_t base = ((size_t)bl * 4096 + c * 64 + q * 16) * 1024 + ch0 + ch;
#pragma unroll 8
    for (int t = 0; t < 16; ++t) {
      const size_t o = base + (size_t)t * 1024;
      const float hv = p.hloc()[o] + p.cuma()[o] * carry;
      p.rnn_g()[((size_t)((ch0 + ch) >> 6) * TOK + (size_t)bl * 4096 + c * 64 + q * 16 + t) * 64 + ((ch0 + ch) & 63)] = f2bf(hv * bf2f(p.grs()[o]));
    }
  }
}

DI void step_proj(const Params& p, unsigned char* smem) {
  constexpr int MT = TOK / 256;
  float* ytmp = p.hloc();
  for (int t = blockIdx.x; t < MT * 4; t += gridDim.x) {
    const int mt = t % MT, nt = t / MT;
    const int wave = get_tid() >> 6, wm = wave >> 1, wn = wave & 1;
#pragma unroll 1
    for (int b = 0; b < 3; ++b) {
      const u16* A = (b == 0 ? p.rnn_g() : b == 1 ? p.att_g() : p.mem_g()) + (size_t)mt * 256 * 64;
      const u16* W = (b == 0 ? p.wt_prnn() : b == 1 ? p.wt_patt() : p.wt_pmem()) + (size_t)nt * 256 * 64;
      f32x16 acc[2][4];
      zero_acc(acc);
      gemm_kloop(A, (size_t)TOK * 64, W, (size_t)1024 * 64, 1024, acc, smem);
      wave_epilogue(acc, smem, [&](int mi, const float* sW) {
        const size_t rowbase = (size_t)mt * 256 + wm * 64 + mi * 32;
        const int cb = nt * 256 + wn * 128;
        const u16* gs = p.gsig() + rowbase * 3072 + b * 1024 + cb;
        float* yt = ytmp + rowbase * 1024 + cb;
        u16* yo = p.y();
        slab_rows(sW, [&](int row, int c, const float* v, int i_) {
          float gv[8], o[8];
          unpack8(*(const uint4*)(gs + (size_t)row * 3072 + c), gv);
          float* yp = yt + (size_t)row * 1024 + c;
          if (b == 0) {
#pragma unroll
            for (int e = 0; e < 8; ++e) o[e] = v[e] * gv[e];
          } else {
            const float4 y0 = *(const float4*)yp, y1 = *(const float4*)(yp + 4);
            o[0] = y0.x + v[0] * gv[0]; o[1] = y0.y + v[1] * gv[1]; o[2] = y0.z + v[2] * gv[2]; o[3] = y0.w + v[3] * gv[3];
            o[4] = y1.x + v[4] * gv[4]; o[5] = y1.y + v[5] * gv[5]; o[6] = y1.z + v[6] * gv[6]; o[7] = y1.w + v[7] * gv[7];
          }
          if (b < 2) {
            *(float4*)yp = float4{o[0], o[1], o[2], o[3]};
            *(float4*)(yp + 4) = float4{o[4], o[5], o[6], o[7]};
          } else {
            *(uint4*)(yo + ((size_t)((cb + c) >> 6) * TOK + rowbase + row) * 64 + ((cb + c) & 63)) = pack8(o);
          }
        });
      });
    }
  }
}

DI void step_out(const Params& p, int pass, unsigned char* smem) {
  constexpr int MT = TOK / 256;
  for (int t = blockIdx.x; t < MT * 4; t += gridDim.x) {
    const int mt = t % MT, nt = t / MT;
    f32x16 acc[2][4];
    zero_acc(acc);
    gemm_kloop(p.y() + (size_t)mt * 256 * 64, (size_t)TOK * 64, p.wt_out() + (size_t)nt * 256 * 64, (size_t)1024 * 64, 1024, acc, smem);
    const int wave = get_tid() >> 6, wm = wave >> 1, wn = wave & 1;
    wave_epilogue(acc, smem, [&](int mi, const float* sW) {
      const size_t gbase = ((size_t)pass * TOK + (size_t)mt * 256 + wm * 64 + mi * 32) * 1024 + nt * 256 + wn * 128;
      const float* xs = p.x + gbase;
      float* dst = p.out + gbase;
      slab_rows(sW, [&](int row, int c, const float* v, int i_) {
        const float4 x0 = *(const float4*)(xs + (size_t)row * 1024 + c), x1 = *(const float4*)(xs + (size_t)row * 1024 + c + 4);
        float4 o0, o1;
        o0.x = x0.x + v[0]; o0.y = x0.y + v[1]; o0.z = x0.z + v[2]; o0.w = x0.w + v[3];
        o1.x = x1.x + v[4]; o1.y = x1.y + v[5]; o1.z = x1.z + v[6]; o1.w = x1.w + v[7];
        *(float4*)(dst + (size_t)row * 1024 + c) = o0;
        *(float4*)(dst + (size_t)row * 1024 + c + 4) = o1;
      });
    });
  }
}

DI void run_phase(const Params& p, int pass, int ph, bool first, unsigned char* smem) {
  if (ph == 0) step_gemm1(p, pass, first, smem);
  else if (ph == 1) step_mix(p, pass, smem);
  else if (ph == 2) step_rnnfin(p, smem);
  else if (ph == 3) step_proj(p, smem);
  else step_out(p, pass, smem);
}

__global__ void __launch_bounds__(512) mega_kernel(Params p_in) {
  __shared__ __attribute__((aligned(16))) unsigned char smem[SMEM_BYTES];
  cg::grid_group grid = cg::this_grid();
  const Params& p = p_in;
  unsigned* bar = (unsigned*)(p.ws + OFF_bar);
  if (blockIdx.x == 0 && __builtin_amdgcn_workitem_id_x() == 0) __hip_atomic_store(bar, 0u, __ATOMIC_RELAXED, __HIP_MEMORY_SCOPE_AGENT);
  unsigned nbar = 0;
  for (int step = p.step_lo; step < p.step_hi; ++step) {
    if (step == 0) step_prep(p, smem);
    else if (step == 1) step_memkv(p, smem);
    else {
      const int pass = (step - 2) / 5, ph = (step - 2) % 5;
#ifdef DUP_PH
      if (ph == DUP_PH) { run_phase(p, pass, ph, true, smem); ++nbar; fast_barrier(bar, nbar * gridDim.x); run_phase(p, pass, ph, false, smem); }
      else
#endif
      run_phase(p, pass, ph, true, smem);
    }
    if (step + 1 < p.step_hi) {
      if (step == p.step_lo) grid.sync();
      else { ++nbar; fast_barrier(bar, nbar * gridDim.x); }
    }
  }
}

extern "C" void kernel_launch(void* const* d_in, const int* in_sizes, int n_in, void* d_out, int out_size, void* d_ws,
                              size_t ws_size, hipStream_t stream) {
  static int grid_blocks = 0;
  if (!grid_blocks) {
    int dev = 0, cus = 0, per_cu = 0;
    (void)hipGetDevice(&dev);
    (void)hipDeviceGetAttribute(&cus, hipDeviceAttributeMultiprocessorCount, dev);
    (void)hipOccupancyMaxActiveBlocksPerMultiprocessor(&per_cu, mega_kernel, 512, 0);
    if (per_cu > 1) per_cu = 1;
    if (per_cu < 1) per_cu = 1;
    grid_blocks = cus * per_cu;
  }
  Params p{};
  const float* const* in = (const float* const*)d_in;
  p.x = in[0]; p.mem = in[1]; p.norm_g = in[2]; p.mem_norm_g = in[3]; p.w_in = in[4]; p.b_merge = in[5]; p.conv_w = in[6];
  p.conv_b = in[7]; p.lru_wa = in[8]; p.lru_ba = in[9]; p.lru_wx = in[10]; p.lru_bx = in[11]; p.lru_lambda = in[12];
  p.q_norm_g = in[13]; p.k_norm_g = in[14]; p.rel_bias = in[15]; p.w_mem_kv = in[16]; p.mem_q_norm_g = in[17];
  p.mem_k_norm_g = in[18]; p.w_proj_rnn = in[19]; p.w_proj_att = in[20]; p.w_proj_mem = in[21]; p.w_out = in[22];
  p.out = (float*)d_out;
  p.ws = (unsigned char*)d_ws;
  if (WS_NEED > ws_size) { fprintf(stderr, "workspace too small: need %llu have %zu\n", WS_NEED, ws_size); return; }
  p.step_lo = 0; p.step_hi = 2 + 5 * NPASS;
  void* args[] = {&p};
  hipError_t e = hipLaunchCooperativeKernel((void*)mega_kernel, dim3(grid_blocks), dim3(512), args, 0, stream);
  if (e != hipSuccess) fprintf(stderr, "cooperative launch failed: %s (grid %d)\n", hipGetErrorString(e), grid_blocks);
}
```

```cpp
#include <hip/hip_runtime.h>
#include <hip/hip_cooperative_groups.h>
#include <cstdio>
#include <cstddef>
namespace cg = cooperative_groups;

#define DI __device__ __forceinline__
typedef unsigned short u16;
using bf16x8 = __attribute__((ext_vector_type(8))) short;
using f32x4  = __attribute__((ext_vector_type(4))) float;
using f32x16 = __attribute__((ext_vector_type(16))) float;
using u32x4  = __attribute__((ext_vector_type(4))) unsigned;

constexpr int SEQ = 4096;
constexpr int GB = 4;
constexpr int NPASS = 4;
constexpr int TOK = GB * SEQ;
constexpr int SMEM_BYTES = 147456;
constexpr int T_TR = 2816 + 1024 + 512 + 64;
constexpr int T_ROWS = 8192 + 512;
constexpr float EPS = 1e-6f;

constexpr unsigned long long ACT = (unsigned long long)TOK * 1024 * 2;
constexpr unsigned long long OFF_wt_in = 0ull;
constexpr unsigned long long OFF_wt_prnn = OFF_wt_in + ((11264ull*1024*2 + 255ull) & ~255ull);
constexpr unsigned long long OFF_wt_patt = OFF_wt_prnn + ((1024ull*1024*2 + 255ull) & ~255ull);
constexpr unsigned long long OFF_wt_pmem = OFF_wt_patt + ((1024ull*1024*2 + 255ull) & ~255ull);
constexpr unsigned long long OFF_wt_out = OFF_wt_pmem + ((1024ull*1024*2 + 255ull) & ~255ull);
constexpr unsigned long long OFF_wt_memkv = OFF_wt_out + ((1024ull*1024*2 + 255ull) & ~255ull);
constexpr unsigned long long OFF_wt_a = OFF_wt_memkv + ((2048ull*1024*2 + 255ull) & ~255ull);
constexpr unsigned long long OFF_wt_x = OFF_wt_a + ((8ull*128*128*2 + 255ull) & ~255ull);
constexpr unsigned long long OFF_h = OFF_wt_x + ((8ull*128*128*2 + 255ull) & ~255ull);
constexpr unsigned long long OFF_mem_n = OFF_h + ((65536ull*1024*2 + 255ull) & ~255ull);
constexpr unsigned long long OFF_memk = OFF_mem_n + ((4096ull*1024*2 + 255ull) & ~255ull);
constexpr unsigned long long OFF_memvt = OFF_memk + ((4096ull*1024*2 + 255ull) & ~255ull);
constexpr unsigned long long OFF_xr = OFF_memvt + ((4096ull*1024*2 + 255ull) & ~255ull);
constexpr unsigned long long OFF_grs = OFF_xr + ((ACT + 255ull) & ~255ull);
constexpr unsigned long long OFF_qn = OFF_grs + ((ACT + 255ull) & ~255ull);
constexpr unsigned long long OFF_kn = OFF_qn + ((ACT + 255ull) & ~255ull);
constexpr unsigned long long OFF_vt = OFF_kn + ((ACT + 255ull) & ~255ull);
constexpr unsigned long long OFF_gas = OFF_vt + ((ACT + 255ull) & ~255ull);
constexpr unsigned long long OFF_qm = OFF_gas + ((ACT + 255ull) & ~255ull);
constexpr unsigned long long OFF_gms = OFF_qm + ((ACT + 255ull) & ~255ull);
constexpr unsigned long long OFF_gsig = OFF_gms + ((ACT + 255ull) & ~255ull);
constexpr unsigned long long OFF_hloc = OFF_gsig + ((ACT*3 + 255ull) & ~255ull);
constexpr unsigned long long OFF_cuma = OFF_hloc + ((ACT*2 + 255ull) & ~255ull);
constexpr unsigned long long OFF_chA = OFF_cuma + ((ACT*2 + 255ull) & ~255ull);
constexpr unsigned long long OFF_chH = OFF_chA + (((unsigned long long)GB*64*1024*4 + 255ull) & ~255ull);
constexpr unsigned long long OFF_rnn_g = OFF_chH + (((unsigned long long)GB*64*1024*4 + 255ull) & ~255ull);
constexpr unsigned long long OFF_att_g = OFF_rnn_g + ((ACT + 255ull) & ~255ull);
constexpr unsigned long long OFF_mem_g = OFF_att_g + ((ACT + 255ull) & ~255ull);
constexpr unsigned long long OFF_y = OFF_mem_g + ((ACT + 255ull) & ~255ull);
constexpr unsigned long long OFF_bar = OFF_y + ((ACT + 255ull) & ~255ull);
constexpr unsigned long long WS_NEED = OFF_bar + 256ull;
DI unsigned char* oq(unsigned char* w) { asm volatile("" : "+s"(w)); return w; }
struct Params {
  const float *x, *mem, *norm_g, *mem_norm_g, *w_in, *b_merge, *conv_w, *conv_b, *lru_wa, *lru_ba, *lru_wx, *lru_bx,
      *lru_lambda, *q_norm_g, *k_norm_g, *rel_bias, *w_mem_kv, *mem_q_norm_g, *mem_k_norm_g, *w_proj_rnn, *w_proj_att,
      *w_proj_mem, *w_out;
  float* out;
  unsigned char* ws;
  int step_lo, step_hi;
  DI u16* wt_in() const { return (u16*)(ws + OFF_wt_in); }
  DI u16* wt_prnn() const { return (u16*)(ws + OFF_wt_prnn); }
  DI u16* wt_patt() const { return (u16*)(ws + OFF_wt_patt); }
  DI u16* wt_pmem() const { return (u16*)(ws + OFF_wt_pmem); }
  DI u16* wt_out() const { return (u16*)(ws + OFF_wt_out); }
  DI u16* wt_memkv() const { return (u16*)(ws + OFF_wt_memkv); }
  DI u16* wt_a() const { return (u16*)(ws + OFF_wt_a); }
  DI u16* wt_x() const { return (u16*)(ws + OFF_wt_x); }
  DI u16* h() const { return (u16*)(ws + OFF_h); }
  DI u16* mem_n() const { return (u16*)(ws + OFF_mem_n); }
  DI u16* memk() const { return (u16*)(ws + OFF_memk); }
  DI u16* memvt() const { return (u16*)(ws + OFF_memvt); }
  DI u16* xr() const { return (u16*)(ws + OFF_xr); }
  DI u16* grs() const { return (u16*)(ws + OFF_grs); }
  DI u16* qn() const { return (u16*)(ws + OFF_qn); }
  DI u16* kn() const { return (u16*)(ws + OFF_kn); }
  DI u16* vt() const { return (u16*)(ws + OFF_vt); }
  DI u16* gas() const { return (u16*)(ws + OFF_gas); }
  DI u16* qm() const { return (u16*)(ws + OFF_qm); }
  DI u16* gms() const { return (u16*)(ws + OFF_gms); }
  DI u16* gsig() const { return (u16*)(ws + OFF_gsig); }
  DI u16* hloc() const { return (u16*)(ws + OFF_hloc); }
  DI float* ytmp() const { return (float*)(ws + OFF_hloc); }
  DI u16* cuma() const { return (u16*)(ws + OFF_cuma); }
  DI float* chA() const { return (float*)(ws + OFF_chA); }
  DI float* chH() const { return (float*)(ws + OFF_chH); }
  DI u16* rnn_g() const { return (u16*)(ws + OFF_rnn_g); }
  DI u16* att_g() const { return (u16*)(ws + OFF_att_g); }
  DI u16* mem_g() const { return (u16*)(ws + OFF_mem_g); }
  DI u16* y() const { return (u16*)(ws + OFF_y); }
};

DI void fast_barrier(unsigned* ctr, unsigned target) {
  asm volatile("s_waitcnt vmcnt(0)" ::: "memory");
  __syncthreads();
  if (__builtin_amdgcn_workitem_id_x() == 0) {
    __builtin_amdgcn_fence(__ATOMIC_RELEASE, "agent");
    asm volatile("s_waitcnt vmcnt(0)" ::: "memory");
    (void)__hip_atomic_fetch_add(ctr, 1u, __ATOMIC_RELAXED, __HIP_MEMORY_SCOPE_AGENT);
    unsigned sp = 0;
    while (__hip_atomic_load(ctr, __ATOMIC_RELAXED, __HIP_MEMORY_SCOPE_AGENT) < target) {
      __builtin_amdgcn_s_sleep(1);
      if (++sp > (1u << 24)) break;
    }
    __builtin_amdgcn_fence(__ATOMIC_ACQUIRE, "agent");
    asm volatile("s_waitcnt vmcnt(0)" ::: "memory");
  }
  __syncthreads();
}
DI int get_tid() { int t = __builtin_amdgcn_workitem_id_x(); asm volatile("" : "+v"(t)); return t; }
typedef float f32x2_t __attribute__((ext_vector_type(2)));
typedef __bf16 bf16x2_t __attribute__((ext_vector_type(2)));
DI unsigned pack2(float a, float b) { f32x2_t v = {a, b}; return __builtin_bit_cast(unsigned, __builtin_convertvector(v, bf16x2_t)); }
DI u16 f2bf(float x) { return (u16)(pack2(x, x) & 0xffffu); }
DI float bf2f(u16 b) { return __uint_as_float(((unsigned)b) << 16); }
DI float sigm(float v) { return __builtin_amdgcn_rcpf(1.f + __builtin_amdgcn_exp2f(-1.4426950408889634f * v)); }
DI float silu(float v) { return v * sigm(v); }
DI uint4 pack8(const float* v) { uint4 r; r.x = pack2(v[0], v[1]); r.y = pack2(v[2], v[3]); r.z = pack2(v[4], v[5]); r.w = pack2(v[6], v[7]); return r; }
DI void unpack8(uint4 r, float* v) {
  v[0] = __uint_as_float(r.x << 16); v[1] = __uint_as_float(r.x & 0xffff0000u);
  v[2] = __uint_as_float(r.y << 16); v[3] = __uint_as_float(r.y & 0xffff0000u);
  v[4] = __uint_as_float(r.z << 16); v[5] = __uint_as_float(r.z & 0xffff0000u);
  v[6] = __uint_as_float(r.w << 16); v[7] = __uint_as_float(r.w & 0xffff0000u);
}

template <bool PANEL>
DI void transpose_tile(const float* __restrict__ src, int R, int C, u16* __restrict__ dst, int tr, int tc, float* tile) {
  const int tid = get_tid();
  __syncthreads();
#pragma unroll
  for (int i = 0; i < 2; ++i) {
    const int r = (tid >> 4) + 32 * i, c4 = (tid & 15) * 4;
    const float4 v = *(const float4*)(src + (size_t)(tr * 64 + r) * C + tc * 64 + c4);
    tile[r * 65 + c4 + 0] = v.x; tile[r * 65 + c4 + 1] = v.y; tile[r * 65 + c4 + 2] = v.z; tile[r * 65 + c4 + 3] = v.w;
  }
  __syncthreads();
  {
    const int c = tid >> 3, r8 = (tid & 7) * 8;
    float v[8];
#pragma unroll
    for (int j = 0; j < 8; ++j) v[j] = tile[(r8 + j) * 65 + c];
    if (PANEL) *(uint4*)(dst + ((size_t)tr * C + tc * 64 + c) * 64 + r8) = pack8(v);
    else *(uint4*)(dst + (size_t)(tc * 64 + c) * R + tr * 64 + r8) = pack8(v);
  }
}

DI void rms_row(const float* __restrict__ src, const float* __restrict__ g, u16* __restrict__ dst, size_t ROWS, size_t r) {
  const int lane = get_tid() & 63;
  float4 v[4];
  float ss = 0.f;
#pragma unroll
  for (int i = 0; i < 4; ++i) {
    v[i] = *(const float4*)(src + i * 256 + lane * 4);
    ss += v[i].x * v[i].x + v[i].y * v[i].y + v[i].z * v[i].z + v[i].w * v[i].w;
  }
#pragma unroll
  for (int o = 32; o >= 1; o >>= 1) ss += __shfl_xor(ss, o);
  const float rstd = rsqrtf(ss * (1.f / 1024.f) + EPS);
#pragma unroll
  for (int i = 0; i < 4; ++i) {
    const float4 gg = *(const float4*)(g + i * 256 + lane * 4);
    uint2 o;
    o.x = pack2(v[i].x * rstd * gg.x, v[i].y * rstd * gg.y);
    o.y = pack2(v[i].z * rstd * gg.z, v[i].w * rstd * gg.w);
    *(uint2*)(dst + ((size_t)(i * 4 + (lane >> 4)) * ROWS + r) * 64 + (lane & 15) * 4) = o;
  }
}

DI void step_prep(const Params& p, unsigned char* smem) {
  float* tile = (float*)smem;
  for (int it = blockIdx.x; it < T_TR + T_ROWS; it += gridDim.x) {
    if (it < T_TR) {
      int j = it;
      if (j < 2816) { transpose_tile<true>(p.w_in, 1024, 11264, p.wt_in(), j % 16, j / 16, tile); continue; }
      j -= 2816;
      if (j < 1024) {
        const int k = j >> 8, jj = j & 255;
        const float* s = k == 0 ? p.w_proj_rnn : k == 1 ? p.w_proj_att : k == 2 ? p.w_proj_mem : p.w_out;
        u16* d = k == 0 ? p.wt_prnn() : k == 1 ? p.wt_patt() : k == 2 ? p.wt_pmem() : p.wt_out();
        transpose_tile<true>(s, 1024, 1024, d, jj % 16, jj / 16, tile);
        continue;
      }
      j -= 1024;
      if (j < 512) { transpose_tile<true>(p.w_mem_kv, 1024, 2048, p.wt_memkv(), j % 16, j / 16, tile); continue; }
      j -= 512;
      {
        const int mat = j >> 5, jj = j & 31, n = jj >> 2, tr = (jj >> 1) & 1, tc = jj & 1;
        transpose_tile<false>((mat ? p.lru_wx : p.lru_wa) + n * 16384, 128, 128, (mat ? p.wt_x() : p.wt_a()) + n * 16384, tr, tc, tile);
      }
    } else {
      const int r = (it - T_TR) * 8 + (get_tid() >> 6);
      if (r < 65536) rms_row(p.x + (size_t)r * 1024, p.norm_g, p.h(), 65536, r);
      else { const int m = r - 65536; rms_row(p.mem + (size_t)m * 1024, p.mem_norm_g, p.mem_n(), 4096, m); }
    }
  }
}

DI void zero_acc(f32x16 (&acc)[2][4]) {
#pragma unroll
  for (int a = 0; a < 2; ++a)
#pragma unroll
    for (int b = 0; b < 4; ++b)
#pragma unroll
      for (int r = 0; r < 16; ++r) acc[a][b][r] = 0.f;
}

DI void gemm_kloop(const u16* __restrict__ A, size_t aks, const u16* __restrict__ Bt, size_t bks, int K, f32x16 (&acc)[2][4],
                   unsigned char* smem) {
  u16* sA = (u16*)smem;
  const int tid = get_tid(), lane = tid & 63, wave = tid >> 6, wm = wave >> 1, wn = wave & 1;
  const int lr = tid >> 3, lc = (tid & 7) * 8;
  const u16* ga = A + (size_t)lr * 64 + lc;
  const u16* gb = Bt + (size_t)lr * 64 + lc;
  constexpr size_t sa64 = 4096, sb64 = 4096;
  u32x4 ra0 = *(const u32x4*)(ga), ra1 = *(const u32x4*)(ga + sa64), ra2 = *(const u32x4*)(ga + 2 * sa64), ra3 = *(const u32x4*)(ga + 3 * sa64);
  u32x4 rb0 = *(const u32x4*)(gb), rb1 = *(const u32x4*)(gb + sb64), rb2 = *(const u32x4*)(gb + 2 * sb64), rb3 = *(const u32x4*)(gb + 3 * sb64);
  const int nk = K >> 6;
  const int pa_off = (wm * 64 + (lane & 31)) * 72 + (lane >> 5) * 8;
  const int pb_off = 18432 + (wn * 128 + (lane & 31)) * 72 + (lane >> 5) * 8;
  const int wa_off = lr * 72 + lc;
  const int wb_off = 18432 + lr * 72 + lc;
  __syncthreads();
  {
    u16* d = sA + wa_off;
    *(u32x4*)(d) = ra0; *(u32x4*)(d + 64 * 72) = ra1; *(u32x4*)(d + 128 * 72) = ra2; *(u32x4*)(d + 192 * 72) = ra3;
    d = sA + wb_off;
    *(u32x4*)(d) = rb0; *(u32x4*)(d + 64 * 72) = rb1; *(u32x4*)(d + 128 * 72) = rb2; *(u32x4*)(d + 192 * 72) = rb3;
  }
  if (nk > 1) {
    ga += aks; gb += bks;
    ra0 = *(const u32x4*)(ga); ra1 = *(const u32x4*)(ga + sa64); ra2 = *(const u32x4*)(ga + 2 * sa64); ra3 = *(const u32x4*)(ga + 3 * sa64);
    rb0 = *(const u32x4*)(gb); rb1 = *(const u32x4*)(gb + sb64); rb2 = *(const u32x4*)(gb + 2 * sb64); rb3 = *(const u32x4*)(gb + 3 * sb64);
  }
  __syncthreads();
  for (int kt = 0; kt < nk; ++kt) {
    const int cur = (kt & 1) * 36864, nxt = 36864 - cur;
    const bool wr = kt + 1 < nk, ld = kt + 2 < nk;
    if (ld) { ga += aks; gb += bks; }
    const u16* pa = sA + cur + pa_off;
    const u16* pb = sA + cur + pb_off;
    u16* da = sA + nxt + wa_off;
    u16* db = sA + nxt + wb_off;
#pragma unroll
    for (int s = 0; s < 4; ++s) {
      if (wr) {
        if (s == 0) { *(u32x4*)(da) = ra0; *(u32x4*)(da + 64 * 72) = ra1; }
        if (s == 1) { *(u32x4*)(da + 128 * 72) = ra2; *(u32x4*)(da + 192 * 72) = ra3; }
        if (s == 2) { *(u32x4*)(db) = rb0; *(u32x4*)(db + 64 * 72) = rb1; }
        if (s == 3) { *(u32x4*)(db + 128 * 72) = rb2; *(u32x4*)(db + 192 * 72) = rb3; }
      }
      if (ld) {
        if (s == 0) { ra0 = *(const u32x4*)(ga); ra1 = *(const u32x4*)(ga + sa64); }
        if (s == 1) { ra2 = *(const u32x4*)(ga + 2 * sa64); ra3 = *(const u32x4*)(ga + 3 * sa64); }
        if (s == 2) { rb0 = *(const u32x4*)(gb); rb1 = *(const u32x4*)(gb + sb64); }
        if (s == 3) { rb2 = *(const u32x4*)(gb + 2 * sb64); rb3 = *(const u32x4*)(gb + 3 * sb64); }
      }
      const bf16x8 a0 = *(const bf16x8*)(pa + s * 16);
      const bf16x8 a1 = *(const bf16x8*)(pa + 32 * 72 + s * 16);
      const bf16x8 b0 = *(const bf16x8*)(pb + s * 16);
      const bf16x8 b1 = *(const bf16x8*)(pb + 32 * 72 + s * 16);
      const bf16x8 b2 = *(const bf16x8*)(pb + 64 * 72 + s * 16);
      const bf16x8 b3 = *(const bf16x8*)(pb + 96 * 72 + s * 16);
      acc[0][0] = __builtin_amdgcn_mfma_f32_32x32x16_bf16(a0, b0, acc[0][0], 0, 0, 0);
      acc[0][1] = __builtin_amdgcn_mfma_f32_32x32x16_bf16(a0, b1, acc[0][1], 0, 0, 0);
      acc[0][2] = __builtin_amdgcn_mfma_f32_32x32x16_bf16(a0, b2, acc[0][2], 0, 0, 0);
      acc[0][3] = __builtin_amdgcn_mfma_f32_32x32x16_bf16(a0, b3, acc[0][3], 0, 0, 0);
      acc[1][0] = __builtin_amdgcn_mfma_f32_32x32x16_bf16(a1, b0, acc[1][0], 0, 0, 0);
      acc[1][1] = __builtin_amdgcn_mfma_f32_32x32x16_bf16(a1, b1, acc[1][1], 0, 0, 0);
      acc[1][2] = __builtin_amdgcn_mfma_f32_32x32x16_bf16(a1, b2, acc[1][2], 0, 0, 0);
      acc[1][3] = __builtin_amdgcn_mfma_f32_32x32x16_bf16(a1, b3, acc[1][3], 0, 0, 0);
      __builtin_amdgcn_sched_barrier(0);
    }
    __syncthreads();
  }
}

template <typename F>
DI void wave_epilogue(const f32x16 (&acc)[2][4], unsigned char* smem, F f) {
  const int tid = get_tid(), lane = tid & 63, wave = tid >> 6;
  float* sW = (float*)smem + wave * (32 * 132);
#pragma unroll
  for (int mi = 0; mi < 2; ++mi) {
#pragma unroll
    for (int ni = 0; ni < 4; ++ni)
#pragma unroll
      for (int r = 0; r < 16; ++r) {
        const int row = (r & 3) + 8 * (r >> 2) + 4 * (lane >> 5);
        sW[row * 132 + ni * 32 + (lane & 31)] = acc[mi][ni][r];
      }
    __builtin_amdgcn_fence(__ATOMIC_RELEASE, "wavefront");
    __builtin_amdgcn_fence(__ATOMIC_ACQUIRE, "wavefront");
    f(mi, sW);
    __builtin_amdgcn_fence(__ATOMIC_RELEASE, "wavefront");
    __builtin_amdgcn_fence(__ATOMIC_ACQUIRE, "wavefront");
  }
}

template <typename F>
DI void slab_rows(const float* sW, F f) {
  const int lane = get_tid() & 63, rsub = lane >> 3, chunk = lane & 7;
#pragma unroll
  for (int i = 0; i < 4; ++i)
#pragma unroll
    for (int hf = 0; hf < 2; ++hf) {
      const int row = i * 8 + rsub, c = hf * 64 + chunk * 8;
      float v[8];
      const float4 a = *(const float4*)(sW + row * 132 + c), b = *(const float4*)(sW + row * 132 + c + 4);
      v[0] = a.x; v[1] = a.y; v[2] = a.z; v[3] = a.w; v[4] = b.x; v[5] = b.y; v[6] = b.z; v[7] = b.w;
      f(row, c, v, i);
    }
}

DI void slab_store_transposed(const float* sW, u16* __restrict__ dst, size_t ldd) {
  const int lane = get_tid() & 63;
#pragma unroll
  for (int dd = 0; dd < 2; ++dd)
#pragma unroll
    for (int j = 0; j < 4; ++j) {
      const int d = lane + 64 * dd;
      float v[8];
#pragma unroll
      for (int e = 0; e < 8; ++e) v[e] = sW[(j * 8 + e) * 132 + d];
      *(uint4*)(dst + (size_t)d * ldd + j * 8) = pack8(v);
    }
}

DI void step_memkv(const Params& p, unsigned char* smem) {
  for (int t = blockIdx.x; t < 16 * 8; t += gridDim.x) {
    const int mt = t % 16, nt = t / 16;
    f32x16 acc[2][4];
    zero_acc(acc);
    gemm_kloop(p.mem_n() + (size_t)mt * 256 * 64, (size_t)4096 * 64, p.wt_memkv() + (size_t)nt * 256 * 64, (size_t)2048 * 64, 1024, acc, smem);
    const int wave = get_tid() >> 6, wm = wave >> 1, wn = wave & 1;
    wave_epilogue(acc, smem, [&](int mi, const float* sW) {
      const int r0 = wm * 64 + mi * 32;
      if (nt < 4) {
        u16* dst = p.memk() + ((size_t)mt * 256 + r0) * 1024 + nt * 256 + wn * 128;
        slab_rows(sW, [&](int row, int c, const float* v, int i_) { *(uint4*)(dst + (size_t)row * 1024 + c) = pack8(v); });
      } else {
        const int hh = nt - 4;
        slab_store_transposed(sW, p.memvt() + ((size_t)(mt * 4 + hh) * 256 + wn * 128) * 256 + r0, 256);
      }
    });
  }
}

DI void memk_norm_row(const Params& p, int row) {
  const int lane = get_tid() & 63;
  u16* ptr = p.memk() + (size_t)row * 1024 + lane * 16;
  float v[16];
  unpack8(*(const uint4*)ptr, v);
  unpack8(*(const uint4*)(ptr + 8), v + 8);
  float ss = 0.f;
#pragma unroll
  for (int e = 0; e < 16; ++e) ss += v[e] * v[e];
#pragma unroll
  for (int o = 1; o <= 8; o <<= 1) ss += __shfl_xor(ss, o);
  const float sc = rsqrtf(ss * (1.f / 256.f) + EPS);
  const float* g = p.mem_k_norm_g + (lane & 15) * 16;
#pragma unroll
  for (int e = 0; e < 16; ++e) v[e] *= sc * g[e];
  *(uint4*)ptr = pack8(v);
  *(uint4*)(ptr + 8) = pack8(v + 8);
}

DI void step_gemm1(const Params& p, int pass, bool first, unsigned char* smem) {
  if (pass == 0 && first) {
    for (int it = blockIdx.x; it < 512; it += gridDim.x) memk_norm_row(p, it * 8 + (get_tid() >> 6));
  }
  const u16* A = p.h() + (size_t)pass * TOK * 64;
  constexpr int MT = TOK / 256;
  for (int t = blockIdx.x; t < MT * 44; t += gridDim.x) {
    const int mt = t % MT, nt = t / MT;
    f32x16 acc[2][4];
    zero_acc(acc);
    gemm_kloop(A + (size_t)mt * 256 * 64, (size_t)65536 * 64, p.wt_in() + (size_t)nt * 256 * 64, (size_t)11264 * 64, 1024, acc, smem);
    const int wave = get_tid() >> 6, wm = wave >> 1, wn = wave & 1;
    const int seg = nt >> 2, cb = (nt & 3) * 256 + wn * 128;
    wave_epilogue(acc, smem, [&](int mi, const float* sW) {
      const size_t rowbase = (size_t)mt * 256 + wm * 64 + mi * 32;
      if (seg == 0 || seg == 6) {
        u16* dst = (seg == 0 ? p.xr() : p.qm()) + rowbase * 1024 + cb;
        slab_rows(sW, [&](int row, int c, const float* v, int i_) { *(uint4*)(dst + (size_t)row * 1024 + c) = pack8(v); });
      } else if (seg == 1 || seg == 5 || seg == 7) {
        u16* dst = (seg == 1 ? p.grs() : seg == 5 ? p.gas() : p.gms()) + rowbase * 1024 + cb;
        slab_rows(sW, [&](int row, int c, const float* v, int i_) {
          float o[8];
#pragma unroll
          for (int e = 0; e < 8; ++e) o[e] = silu(v[e]);
          *(uint4*)(dst + (size_t)row * 1024 + c) = pack8(o);
        });
      } else if (seg == 2 || seg == 3) {
        float ss[4] = {0.f, 0.f, 0.f, 0.f};
        slab_rows(sW, [&](int row, int c, const float* v, int i_) {
#pragma unroll
          for (int e = 0; e < 8; ++e) ss[i_] += v[e] * v[e];
        });
        float sc[4];
#pragma unroll
        for (int q_ = 0; q_ < 4; ++q_) {
          float t_ = ss[q_];
          t_ += __shfl_xor(t_, 1); t_ += __shfl_xor(t_, 2); t_ += __shfl_xor(t_, 4);
          sc[q_] = rsqrtf(t_ * (1.f / 128.f) + EPS) * (seg == 2 ? 0.08838834764831845f : 1.f);
        }
        const float* g = seg == 2 ? p.q_norm_g : p.k_norm_g;
        u16* dst = (seg == 2 ? p.qn() : p.kn()) + rowbase * 1024 + cb;
        slab_rows(sW, [&](int row, int c, const float* v, int i_) {
          float o[8];
          const float4 g0 = *(const float4*)(g + c), g1 = *(const float4*)(g + c + 4);
          const float s_ = sc[i_];
          o[0] = v[0] * s_ * g0.x; o[1] = v[1] * s_ * g0.y; o[2] = v[2] * s_ * g0.z; o[3] = v[3] * s_ * g0.w;
          o[4] = v[4] * s_ * g1.x; o[5] = v[5] * s_ * g1.y; o[6] = v[6] * s_ * g1.z; o[7] = v[7] * s_ * g1.w;
          *(uint4*)(dst + (size_t)row * 1024 + c) = pack8(o);
        });
      } else if (seg == 4) {
        const int bl = mt >> 4, s0 = (mt & 15) * 256 + wm * 64 + mi * 32, hh = cb >> 7;
        slab_store_transposed(sW, p.vt() + (size_t)(bl * 8 + hh) * 128 * 4096 + s0, 4096);
      } else {
        const int gc = (nt - 32) * 256 + wn * 128;
        const float* bm = p.b_merge + gc;
        u16* dst = p.gsig() + rowbase * 3072 + gc;
        slab_rows(sW, [&](int row, int c, const float* v, int i_) {
          float o[8];
          const float4 b0 = *(const float4*)(bm + c), b1 = *(const float4*)(bm + c + 4);
          o[0] = sigm(v[0] + b0.x); o[1] = sigm(v[1] + b0.y); o[2] = sigm(v[2] + b0.z); o[3] = sigm(v[3] + b0.w);
          o[4] = sigm(v[4] + b1.x); o[5] = sigm(v[5] + b1.y); o[6] = sigm(v[6] + b1.z); o[7] = sigm(v[7] + b1.w);
          *(uint4*)(dst + (size_t)row * 3072 + c) = pack8(o);
        });
      }
    });
  }
}

template <int HD, bool BAND>
DI void attn_core(const u16* __restrict__ Q, const u16* __restrict__ K, const u16* __restrict__ Vt, int ldv, int u0, int u1,
                  const float* __restrict__ bias_row, const float* __restrict__ qg,
                  u16* __restrict__ Out, size_t orow0, int okb, const u16* __restrict__ Gate, unsigned char* smem) {
  constexpr int KS = HD / 32, DB = HD / 16, LDK = HD + 8, NCH = HD / 64;
  u16* sK = (u16*)smem;
  u16* sV = (u16*)(smem + 64 * LDK * 2);
  float* sBias = (float*)(smem + 64 * LDK * 2 + HD * 72 * 2);
  const int tid = get_tid(), lane = tid & 63, w = tid >> 6, l15 = lane & 15, g = lane >> 4, sb = w >> 2, wq = w & 3;
  __syncthreads();
  if (BAND) { for (int i = tid; i < 513; i += 512) sBias[i] = bias_row[i]; }
  bf16x8 qf[KS];
  {
    const u16* qrow = Q + (size_t)(w * 16 + l15) * 1024 + g * 8;
#pragma unroll
    for (int ks = 0; ks < KS; ++ks) qf[ks] = *(const bf16x8*)(qrow + ks * 32);
    if (!BAND) {
      float ss = 0.f;
#pragma unroll
      for (int ks = 0; ks < KS; ++ks) {
        float v[8];
        unpack8(__builtin_bit_cast(uint4, qf[ks]), v);
#pragma unroll
        for (int e = 0; e < 8; ++e) ss += v[e] * v[e];
      }
      ss += __shfl_xor(ss, 16);
      ss += __shfl_xor(ss, 32);
      const float sc = rsqrtf(ss * (1.f / HD) + EPS) * 0.0625f;
#pragma unroll
      for (int ks = 0; ks < KS; ++ks) {
        float v[8];
        unpack8(__builtin_bit_cast(uint4, qf[ks]), v);
        const float4 g0 = *(const float4*)(qg + ks * 32 + g * 8), g1 = *(const float4*)(qg + ks * 32 + g * 8 + 4);
        v[0] *= sc * g0.x; v[1] *= sc * g0.y; v[2] *= sc * g0.z; v[3] *= sc * g0.w;
        v[4] *= sc * g1.x; v[5] *= sc * g1.y; v[6] *= sc * g1.z; v[7] *= sc * g1.w;
        qf[ks] = __builtin_bit_cast(bf16x8, pack8(v));
      }
    }
  }
  f32x4 o[DB];
#pragma unroll
  for (int db = 0; db < DB; ++db) o[db] = f32x4{0.f, 0.f, 0.f, 0.f};
  float m = -1e30f, lsum = 0.f;

  const int krow = tid >> 3, kpart = (tid & 7) * (HD / 8);
  u32x4 rk[NCH], rv[NCH];
  {
    const u16* ksrc = K + ((size_t)u0 * 64 + krow) * 1024 + kpart;
#pragma unroll
    for (int i = 0; i < NCH; ++i) rk[i] = *(const u32x4*)(ksrc + i * 8);
#pragma unroll
    for (int i = 0; i < NCH; ++i) {
      const int id = tid + 512 * i, d = id >> 3, cc = id & 7;
      rv[i] = *(const u32x4*)(Vt + (size_t)d * ldv + u0 * 64 + cc * 8);
    }
  }
  for (int u = u0; u < u1; ++u) {
    __syncthreads();
#pragma unroll
    for (int i = 0; i < NCH; ++i) *(u32x4*)(sK + krow * LDK + kpart + i * 8) = rk[i];
#pragma unroll
    for (int i = 0; i < NCH; ++i) {
      const int id = tid + 512 * i, d = id >> 3, cc = id & 7;
      *(u32x4*)(sV + d * 72 + cc * 8) = rv[i];
    }
    __syncthreads();
    if (u + 1 < u1) {
      const u16* ksrc = K + ((size_t)(u + 1) * 64 + krow) * 1024 + kpart;
#pragma unroll
      for (int i = 0; i < NCH; ++i) rk[i] = *(const u32x4*)(ksrc + i * 8);
#pragma unroll
      for (int i = 0; i < NCH; ++i) {
        const int id = tid + 512 * i, d = id >> 3, cc = id & 7;
        rv[i] = *(const u32x4*)(Vt + (size_t)d * ldv + (u + 1) * 64 + cc * 8);
      }
    }
    if (BAND && (u < sb || u > sb + 8)) continue;
    f32x4 s[4];
#pragma unroll
    for (int kb = 0; kb < 4; ++kb) {
      s[kb] = f32x4{0.f, 0.f, 0.f, 0.f};
#pragma unroll
      for (int ks = 0; ks < KS; ++ks) {
        const bf16x8 kf = *(const bf16x8*)(sK + (kb * 16 + l15) * LDK + ks * 32 + g * 8);
        s[kb] = __builtin_amdgcn_mfma_f32_16x16x32_bf16(kf, qf[ks], s[kb], 0, 0, 0);
      }
      if (HD > 128) __builtin_amdgcn_sched_barrier(0);
    }
    float mx = -1e30f;
#pragma unroll
    for (int kb = 0; kb < 4; ++kb)
#pragma unroll
      for (int i = 0; i < 4; ++i) {
        if (BAND) {
          const int dist = (8 + sb - u) * 64 + (wq * 16 + l15) - (kb * 16 + g * 4 + i);
          s[kb][i] += sBias[min(dist, 256) + 256];
        }
        mx = fmaxf(mx, s[kb][i]);
      }
    mx = fmaxf(mx, __shfl_xor(mx, 16));
    mx = fmaxf(mx, __shfl_xor(mx, 32));
    const float mn = fmaxf(m, mx);
    const float alpha = __expf(m - mn);
    m = mn;
    lsum *= alpha;
#pragma unroll
    for (int db = 0; db < DB; ++db) { o[db][0] *= alpha; o[db][1] *= alpha; o[db][2] *= alpha; o[db][3] *= alpha; }
    bf16x8 pf[2];
#pragma unroll
    for (int k2 = 0; k2 < 2; ++k2) {
      float pv[8];
#pragma unroll
      for (int i = 0; i < 4; ++i) {
        pv[i] = __expf(s[2 * k2][i] - mn);
        pv[4 + i] = __expf(s[2 * k2 + 1][i] - mn);
      }
#pragma unroll
      for (int e = 0; e < 8; ++e) lsum += pv[e];
      pf[k2] = __builtin_bit_cast(bf16x8, pack8(pv));
    }
#pragma unroll
    for (int db = 0; db < DB; ++db) {
#pragma unroll
      for (int k2 = 0; k2 < 2; ++k2) {
        const u16* vp = sV + (db * 16 + l15) * 72 + k2 * 32 + g * 4;
        const uint2 lo = *(const uint2*)vp, hi = *(const uint2*)(vp + 16);
        uint4 vv; vv.x = lo.x; vv.y = lo.y; vv.z = hi.x; vv.w = hi.y;
        o[db] = __builtin_amdgcn_mfma_f32_16x16x32_bf16(__builtin_bit_cast(bf16x8, vv), pf[k2], o[db], 0, 0, 0);
      }
      if (HD > 128 && (db & 3) == 3) __builtin_amdgcn_sched_barrier(0);
    }
  }
  lsum += __shfl_xor(lsum, 16);
  lsum += __shfl_xor(lsum, 32);
  const float inv = 1.f / lsum;
  {
    const size_t ro = (size_t)(w * 16 + l15) * 1024 + g * 4;
#pragma unroll
    for (int db = 0; db < DB; ++db) {
      const uint2 gv = *(const uint2*)(Gate + ro + db * 16);
      uint2 ov;
      ov.x = pack2(o[db][0] * inv * __uint_as_float(gv.x << 16), o[db][1] * inv * __uint_as_float(gv.x & 0xffff0000u));
      ov.y = pack2(o[db][2] * inv * __uint_as_float(gv.y << 16), o[db][3] * inv * __uint_as_float(gv.y & 0xffff0000u));
      *(uint2*)(Out + ((size_t)((okb >> 6) + (db >> 2)) * TOK + orow0 + w * 16 + l15) * 64 + (db & 3) * 16 + g * 4) = ov;
    }
  }
}

DI void rnn_local_item(const Params& p, int bl, int c0, int n, unsigned char* smem) {
  const int tid = get_tid(), sbk = tid >> 8, tl = tid & 255, lane = tid & 63, w = tl >> 6, l15 = lane & 15, g = lane >> 4;
  unsigned char* sm = smem + sbk * 67584;
  float* sxc = (float*)sm;
  float* sa = (float*)(sm + 33792);
  u16* sxcb = (u16*)(sm + 33792);
  const int c = c0 + sbk;
  const int ch0 = n * 128;
  const size_t tok0 = (size_t)bl * 4096 + c * 64;
  __syncthreads();
  {
    const int c8 = (tl & 15) * 8, t4 = (tl >> 4) * 4;
    const u16* src = p.xr() + tok0 * 1024 + ch0 + c8;
    uint4 xr_[7];
#pragma unroll
    for (int j = 0; j < 7; ++j) {
      const int t = t4 - 3 + j;
      if (c * 64 + t >= 0) xr_[j] = *(const uint4*)(src + (ptrdiff_t)t * 1024);
      else xr_[j] = uint4{0u, 0u, 0u, 0u};
    }
    float wv[4][8], cbv[8];
#pragma unroll
    for (int k = 0; k < 4; ++k) {
      const float4 w0 = *(const float4*)(p.conv_w + k * 1024 + ch0 + c8), w1 = *(const float4*)(p.conv_w + k * 1024 + ch0 + c8 + 4);
      wv[k][0] = w0.x; wv[k][1] = w0.y; wv[k][2] = w0.z; wv[k][3] = w0.w; wv[k][4] = w1.x; wv[k][5] = w1.y; wv[k][6] = w1.z; wv[k][7] = w1.w;
    }
    {
      const float4 b0 = *(const float4*)(p.conv_b + ch0 + c8), b1 = *(const float4*)(p.conv_b + ch0 + c8 + 4);
      cbv[0] = b0.x; cbv[1] = b0.y; cbv[2] = b0.z; cbv[3] = b0.w; cbv[4] = b1.x; cbv[5] = b1.y; cbv[6] = b1.z; cbv[7] = b1.w;
    }
    float xf[7][8];
#pragma unroll
    for (int j = 0; j < 7; ++j) unpack8(xr_[j], xf[j]);
#pragma unroll
    for (int tt = 0; tt < 4; ++tt) {
      float xc[8];
#pragma unroll
      for (int e = 0; e < 8; ++e)
        xc[e] = wv[0][e] * xf[tt][e] + wv[1][e] * xf[tt + 1][e] + wv[2][e] * xf[tt + 2][e] + wv[3][e] * xf[tt + 3][e] + cbv[e];
      float* d = sxc + (t4 + tt) * 132 + c8;
      *(float4*)d = float4{xc[0], xc[1], xc[2], xc[3]};
      *(float4*)(d + 4) = float4{xc[4], xc[5], xc[6], xc[7]};
      *(uint4*)(sxcb + (t4 + tt) * 136 + c8) = pack8(xc);
    }
  }
  __syncthreads();
  f32x4 accR[4][2], accI[4][2];
#pragma unroll
  for (int tb = 0; tb < 4; ++tb)
#pragma unroll
    for (int jb = 0; jb < 2; ++jb) { accR[tb][jb] = f32x4{0.f, 0.f, 0.f, 0.f}; accI[tb][jb] = f32x4{0.f, 0.f, 0.f, 0.f}; }
  {
    bf16x8 bR[2][4], bI[2][4];
#pragma unroll
    for (int jb = 0; jb < 2; ++jb)
#pragma unroll
      for (int ks = 0; ks < 4; ++ks) {
        const size_t off = (size_t)n * 16384 + (size_t)(32 * w + jb * 16 + l15) * 128 + ks * 32 + g * 8;
        bR[jb][ks] = *(const bf16x8*)(p.wt_a() + off);
        bI[jb][ks] = *(const bf16x8*)(p.wt_x() + off);
      }
#pragma unroll
    for (int tb = 0; tb < 4; ++tb)
#pragma unroll
      for (int ks = 0; ks < 4; ++ks) {
        const bf16x8 af = *(const bf16x8*)(sxcb + (tb * 16 + l15) * 136 + ks * 32 + g * 8);
#pragma unroll
        for (int jb = 0; jb < 2; ++jb) {
          accR[tb][jb] = __builtin_amdgcn_mfma_f32_16x16x32_bf16(af, bR[jb][ks], accR[tb][jb], 0, 0, 0);
          accI[tb][jb] = __builtin_amdgcn_mfma_f32_16x16x32_bf16(af, bI[jb][ks], accI[tb][jb], 0, 0, 0);
        }
      }
  }
  __syncthreads();
#pragma unroll
  for (int jb = 0; jb < 2; ++jb) {
    const int ch = 32 * w + jb * 16 + l15;
    const float ba = p.lru_ba[ch0 + ch], bx = p.lru_bx[ch0 + ch];
    const float sp = log1pf(expf(-p.lru_lambda[ch0 + ch]));
#pragma unroll
    for (int tb = 0; tb < 4; ++tb)
#pragma unroll
      for (int r = 0; r < 4; ++r) {
        const int t = tb * 16 + g * 4 + r;
        const float rg = sigm(accR[tb][jb][r] + ba), ig = sigm(accI[tb][jb][r] + bx);
        const float la = -8.f * rg * sp;
        const float a = __expf(la);
        const float mult = __builtin_amdgcn_sqrtf(fmaxf(1.f - __expf(2.f * la), 0.f));
        const float xc = sxc[t * 132 + ch];
        sa[t * 132 + ch] = a;
        sxc[t * 132 + ch] = mult * (ig * xc);
      }
  }
  __syncthreads();
  {
    const int ch = tl & 127, half = tl >> 7, tb = half * 32;
    float hh = 0.f, A = 1.f;
#pragma unroll 8
    for (int t = tb; t < tb + 32; ++t) {
      const float a = sa[t * 132 + ch];
      hh = a * hh + sxc[t * 132 + ch];
      A *= a;
      sxc[t * 132 + ch] = hh;
      sa[t * 132 + ch] = A;
    }
    __syncthreads();
  }
  {
    const int c8 = (tl & 15) * 8, r0 = tl >> 4;
    float cH[8], cA[8];
    {
      const float4 h0 = *(const float4*)(sxc + 31 * 132 + c8), h1 = *(const float4*)(sxc + 31 * 132 + c8 + 4);
      const float4 a0 = *(const float4*)(sa + 31 * 132 + c8), a1 = *(const float4*)(sa + 31 * 132 + c8 + 4);
      cH[0] = h0.x; cH[1] = h0.y; cH[2] = h0.z; cH[3] = h0.w; cH[4] = h1.x; cH[5] = h1.y; cH[6] = h1.z; cH[7] = h1.w;
      cA[0] = a0.x; cA[1] = a0.y; cA[2] = a0.z; cA[3] = a0.w; cA[4] = a1.x; cA[5] = a1.y; cA[6] = a1.z; cA[7] = a1.w;
    }
#pragma unroll
    for (int i = 0; i < 4; ++i) {
      const int row = r0 + 16 * i;
      const float4 h0 = *(const float4*)(sxc + row * 132 + c8), h1 = *(const float4*)(sxc + row * 132 + c8 + 4);
      const float4 a0 = *(const float4*)(sa + row * 132 + c8), a1 = *(const float4*)(sa + row * 132 + c8 + 4);
      float hv[8] = {h0.x, h0.y, h0.z, h0.w, h1.x, h1.y, h1.z, h1.w};
      float av[8] = {a0.x, a0.y, a0.z, a0.w, a1.x, a1.y, a1.z, a1.w};
      if (i >= 2) {
#pragma unroll
        for (int e = 0; e < 8; ++e) { hv[e] += av[e] * cH[e]; av[e] *= cA[e]; }
      }
      const size_t o = (tok0 + row) * 1024 + ch0 + c8;
      *(uint4*)(p.hloc() + o) = pack8(hv);
      *(uint4*)(p.cuma() + o) = pack8(av);
      if (row == 63) {
        float* da = p.chA() + ((size_t)bl * 64 + c) * 1024 + ch0 + c8;
        float* dh = p.chH() + ((size_t)bl * 64 + c) * 1024 + ch0 + c8;
        *(float4*)da = float4{av[0], av[1], av[2], av[3]}; *(float4*)(da + 4) = float4{av[4], av[5], av[6], av[7]};
        *(float4*)dh = float4{hv[0], hv[1], hv[2], hv[3]}; *(float4*)(dh + 4) = float4{hv[4], hv[5], hv[6], hv[7]};
      }
    }
  }
}

DI void step_mix(const Params& p, int pass, unsigned char* smem) {
  constexpr int NB = GB * 32 * 8, NM = GB * 32 * 4, NR = GB * 32 * 8;
  for (int it = blockIdx.x; it < NB + NM + NR; it += gridDim.x) {
    if (it < NM) {
      const int hh = it & 3, tt = (it >> 2) & 31, bl = it >> 7;
      const int bgl = pass * GB + bl;
      const size_t tok = (size_t)bl * 4096 + tt * 128;
      attn_core<256, false>(p.qm() + tok * 1024 + hh * 256, p.memk() + (size_t)bgl * 256 * 1024 + hh * 256,
                            p.memvt() + (size_t)(bgl * 4 + hh) * 256 * 256, 256, 0, 4, nullptr, p.mem_q_norm_g,
                            p.mem_g(), tok, hh * 256, p.gms() + tok * 1024 + hh * 256, smem);
    } else if (it < NM + NB) {
      const int idx = it - NM;
      const int hh = idx & 7, cc = (idx >> 3) & 31, bl = idx >> 8;
      const int c0 = 2 * ((cc + 8 * bl) & 31);
      const size_t tok = (size_t)bl * 4096 + c0 * 64;
      const int u0 = c0 >= 8 ? 0 : 8 - c0;
      const u16* K0 = p.kn() + ((ptrdiff_t)bl * 4096 + (ptrdiff_t)(c0 - 8) * 64) * 1024 + hh * 128;
      const u16* V0 = p.vt() + (size_t)(bl * 8 + hh) * 128 * 4096 + (ptrdiff_t)(c0 - 8) * 64;
      attn_core<128, true>(p.qn() + tok * 1024 + hh * 128, K0, V0, 4096, u0, 10, p.rel_bias + hh * 513, nullptr,
                           p.att_g(), tok, hh * 128, p.gas() + tok * 1024 + hh * 128, smem);
    } else {
      const int idx = it - NM - NB;
      const int n = idx & 7, cp = (idx >> 3) & 31, bl = idx >> 8;
      rnn_local_item(p, bl, 2 * cp, n, smem);
    }
  }
}

DI void step_rnnfin(const Params& p, unsigned char* smem) {
  constexpr int NR = GB * 64 * 8;
  float* sP = (float*)smem;
  const int tid = get_tid(), ch = tid & 127, q = tid >> 7;
  for (int it = blockIdx.x; it < NR; it += gridDim.x) {
    const int n = it & 7, c = (it >> 3) & 63, bl = it >> 9;
    const int ch0 = n * 128;
    float Aq = 1.f, Hq = 0.f;
    {
      const float* pa = p.chA() + ((size_t)bl * 64) * 1024 + ch0 + ch;
      const float* ph = p.chH() + ((size_t)bl * 64) * 1024 + ch0 + ch;
      float av[16], hv[16];
#pragma unroll
      for (int j = 0; j < 16; ++j) {
        const int k = q * 16 + j;
        const int kk = k < c ? k : 0;
        av[j] = pa[(size_t)kk * 1024];
        hv[j] = ph[(size_t)kk * 1024];
        if (k >= c) { av[j] = 1.f; hv[j] = 0.f; }
      }
#pragma unroll
      for (int j = 0; j < 16; ++j) { Hq = Hq * av[j] + hv[j]; Aq *= av[j]; }
    }
    __syncthreads();
    sP[(q * 2 + 0) * 128 + ch] = Aq;
    sP[(q * 2 + 1) * 128 + ch] = Hq;
    __syncthreads();
    if (tid < 128) {
      float carry = 0.f;
#pragma unroll
      for (int qq = 0; qq < 4; ++qq) carry = carry * sP[(qq * 2 + 0) * 128 + ch] + sP[(qq * 2 + 1) * 128 + ch];
      sP[1024 + ch] = carry;
    }
    __syncthreads();
    {
      const int c8 = (tid & 15) * 8;
      float cr[8];
      {
        const float4 c0 = *(const float4*)(sP + 1024 + c8), c1 = *(const float4*)(sP + 1024 + c8 + 4);
        cr[0] = c0.x; cr[1] = c0.y; cr[2] = c0.z; cr[3] = c0.w; cr[4] = c1.x; cr[5] = c1.y; cr[6] = c1.z; cr[7] = c1.w;
      }
#pragma unroll
      for (int i = 0; i < 2; ++i) {
        const int row = (tid >> 4) + 32 * i;
        const size_t tokr = (size_t)bl * 4096 + c * 64 + row;
        const size_t o = tokr * 1024 + ch0 + c8;
        float hl[8], cu[8], gr[8], ov[8];
        unpack8(*(const uint4*)(p.hloc() + o), hl);
        unpack8(*(const uint4*)(p.cuma() + o), cu);
        unpack8(*(const uint4*)(p.grs() + o), gr);
#pragma unroll
        for (int e = 0; e < 8; ++e) ov[e] = (hl[e] + cu[e] * cr[e]) * gr[e];
        *(uint4*)(p.rnn_g() + ((size_t)((ch0 + c8) >> 6) * TOK + tokr) * 64 + ((ch0 + c8) & 63)) = pack8(ov);
      }
    }
  }
}

DI void step_proj(const Params& p, unsigned char* smem) {
  constexpr int MT = TOK / 256;
  float* ytmp = p.ytmp();
  for (int t = blockIdx.x; t < MT * 4; t += gridDim.x) {
    const int mt = t % MT, nt = t / MT;
    const int wave = get_tid() >> 6, wm = wave >> 1, wn = wave & 1;
#pragma unroll 1
    for (int b = 0; b < 3; ++b) {
      const u16* A = (b == 0 ? p.rnn_g() : b == 1 ? p.att_g() : p.mem_g()) + (size_t)mt * 256 * 64;
      const u16* W = (b == 0 ? p.wt_prnn() : b == 1 ? p.wt_patt() : p.wt_pmem()) + (size_t)nt * 256 * 64;
      f32x16 acc[2][4];
      zero_acc(acc);
      gemm_kloop(A, (size_t)TOK * 64, W, (size_t)1024 * 64, 1024, acc, smem);
      wave_epilogue(acc, smem, [&](int mi, const float* sW) {
        const size_t rowbase = (size_t)mt * 256 + wm * 64 + mi * 32;
        const int cb = nt * 256 + wn * 128;
        const u16* gs = p.gsig() + rowbase * 3072 + b * 1024 + cb;
        float* yt = ytmp + ((size_t)(t * 8 + wave) * 2 + mi) * 4096 + (get_tid() & 63) * 8;
        u16* yo = p.y();
        slab_rows(sW, [&](int row, int c, const float* v, int i_) {
          float gv[8], o[8];
          unpack8(*(const uint4*)(gs + (size_t)row * 3072 + c), gv);
          float* yp = yt + (i_ * 2 + (c >> 6)) * 512;
          if (b == 0) {
#pragma unroll
            for (int e = 0; e < 8; ++e) o[e] = v[e] * gv[e];
          } else {
            const float4 y0 = *(const float4*)yp, y1 = *(const float4*)(yp + 4);
            o[0] = y0.x + v[0] * gv[0]; o[1] = y0.y + v[1] * gv[1]; o[2] = y0.z + v[2] * gv[2]; o[3] = y0.w + v[3] * gv[3];
            o[4] = y1.x + v[4] * gv[4]; o[5] = y1.y + v[5] * gv[5]; o[6] = y1.z + v[6] * gv[6]; o[7] = y1.w + v[7] * gv[7];
          }
          if (b < 2) {
            *(float4*)yp = float4{o[0], o[1], o[2], o[3]};
            *(float4*)(yp + 4) = float4{o[4], o[5], o[6], o[7]};
          } else {
            *(uint4*)(yo + ((size_t)((cb + c) >> 6) * TOK + rowbase + row) * 64 + ((cb + c) & 63)) = pack8(o);
          }
        });
      });
    }
  }
}

DI void step_out(const Params& p, int pass, unsigned char* smem) {
  constexpr int MT = TOK / 256;
  for (int t = blockIdx.x; t < MT * 4; t += gridDim.x) {
    const int mt = t % MT, nt = t / MT;
    f32x16 acc[2][4];
    zero_acc(acc);
    gemm_kloop(p.y() + (size_t)mt * 256 * 64, (size_t)TOK * 64, p.wt_out() + (size_t)nt * 256 * 64, (size_t)1024 * 64, 1024, acc, smem);
    const int wave = get_tid() >> 6, wm = wave >> 1, wn = wave & 1;
    wave_epilogue(acc, smem, [&](int mi, const float* sW) {
      const size_t gbase = ((size_t)pass * TOK + (size_t)mt * 256 + wm * 64 + mi * 32) * 1024 + nt * 256 + wn * 128;
      const float* xs = p.x + gbase;
      float* dst = p.out + gbase;
      slab_rows(sW, [&](int row, int c, const float* v, int i_) {
        const float4 x0 = *(const float4*)(xs + (size_t)row * 1024 + c), x1 = *(const float4*)(xs + (size_t)row * 1024 + c + 4);
        float4 o0, o1;
        o0.x = x0.x + v[0]; o0.y = x0.y + v[1]; o0.z = x0.z + v[2]; o0.w = x0.w + v[3];
        o1.x = x1.x + v[4]; o1.y = x1.y + v[5]; o1.z = x1.z + v[6]; o1.w = x1.w + v[7];
        *(float4*)(dst + (size_t)row * 1024 + c) = o0;
        *(float4*)(dst + (size_t)row * 1024 + c + 4) = o1;
      });
    });
  }
}

DI void run_phase(const Params& p, int pass, int ph, bool first, unsigned char* smem) {
  if (ph == 0) step_gemm1(p, pass, first, smem);
  else if (ph == 1) step_mix(p, pass, smem);
  else if (ph == 2) step_rnnfin(p, smem);
  else if (ph == 3) step_proj(p, smem);
  else step_out(p, pass, smem);
}

__global__ void __launch_bounds__(512) mega_kernel(Params p_in) {
  __shared__ __attribute__((aligned(16))) unsigned char smem[SMEM_BYTES];
  cg::grid_group grid = cg::this_grid();
  const Params& p = p_in;
  unsigned* bar = (unsigned*)(p.ws + OFF_bar);
  if (blockIdx.x == 0 && __builtin_amdgcn_workitem_id_x() == 0) __hip_atomic_store(bar, 0u, __ATOMIC_RELAXED, __HIP_MEMORY_SCOPE_AGENT);
  unsigned nbar = 0;
  for (int step = p.step_lo; step < p.step_hi; ++step) {
    if (step == 0) step_prep(p, smem);
    else if (step == 1) step_memkv(p, smem);
    else {
      const int pass = (step - 2) / 5, ph = (step - 2) % 5;
#ifdef DUP_PH
      if (ph == DUP_PH) { run_phase(p, pass, ph, true, smem); ++nbar; fast_barrier(bar, nbar * gridDim.x); run_phase(p, pass, ph, false, smem); }
      else
#endif
      run_phase(p, pass, ph, true, smem);
    }
    if (step + 1 < p.step_hi) {
      if (step == p.step_lo) grid.sync();
      else if (step >= 2 && (step - 2) % 5 == 4) {   }
      else { ++nbar; fast_barrier(bar, nbar * gridDim.x); }
    }
  }
}

extern "C" void kernel_launch(void* const* d_in, const int* in_sizes, int n_in, void* d_out, int out_size, void* d_ws,
                              size_t ws_size, hipStream_t stream) {
  static int grid_blocks = 0;
  if (!grid_blocks) {
    int dev = 0, cus = 0, per_cu = 0;
    (void)hipGetDevice(&dev);
    (void)hipDeviceGetAttribute(&cus, hipDeviceAttributeMultiprocessorCount, dev);
    (void)hipOccupancyMaxActiveBlocksPerMultiprocessor(&per_cu, mega_kernel, 512, 0);
    if (per_cu > 1) per_cu = 1;
    if (per_cu < 1) per_cu = 1;
    grid_blocks = cus * per_cu;
  }
  Params p{};
  const float* const* in = (const float* const*)d_in;
  p.x = in[0]; p.mem = in[1]; p.norm_g = in[2]; p.mem_norm_g = in[3]; p.w_in = in[4]; p.b_merge = in[5]; p.conv_w = in[6];
  p.conv_b = in[7]; p.lru_wa = in[8]; p.lru_ba = in[9]; p.lru_wx = in[10]; p.lru_bx = in[11]; p.lru_lambda = in[12];
  p.q_norm_g = in[13]; p.k_norm_g = in[14]; p.rel_bias = in[15]; p.w_mem_kv = in[16]; p.mem_q_norm_g = in[17];
  p.mem_k_norm_g = in[18]; p.w_proj_rnn = in[19]; p.w_proj_att = in[20]; p.w_proj_mem = in[21]; p.w_out = in[22];
  p.out = (float*)d_out;
  p.ws = (unsigned char*)d_ws;
  if (WS_NEED > ws_size) { fprintf(stderr, "workspace too small: need %llu have %zu\n", WS_NEED, ws_size); return; }
  p.step_lo = 0; p.step_hi = 2 + 5 * NPASS;
  void* args[] = {&p};
  hipError_t e = hipLaunchCooperativeKernel((void*)mega_kernel, dim3(grid_blocks), dim3(512), args, 0, stream);
  if (e != hipSuccess) fprintf(stderr, "cooperative launch failed: %s (grid %d)\n", hipGetErrorString(e), grid_blocks);
}
```

```cpp
#include <hip/hip_runtime.h>
#include <hip/hip_cooperative_groups.h>
#include <cstdio>
#include <cstddef>
namespace cg = cooperative_groups;

#define DI __device__ __forceinline__
typedef unsigned short u16;
using bf16x8 = __attribute__((ext_vector_type(8))) short;
using f32x4  = __attribute__((ext_vector_type(4))) float;
using f32x16 = __attribute__((ext_vector_type(16))) float;
using u32x4  = __attribute__((ext_vector_type(4))) unsigned;

constexpr int SEQ = 4096;
constexpr int GB = 4;
constexpr int NPASS = 4;
constexpr int TOK = GB * SEQ;
constexpr int SMEM_BYTES = 147456;
constexpr int T_TR = 2816 + 1024 + 512 + 64;
constexpr int T_ROWS = 8192 + 512;
constexpr float EPS = 1e-6f;

constexpr unsigned long long ACT = (unsigned long long)TOK * 1024 * 2;
constexpr unsigned long long OFF_wt_in = 0ull;
constexpr unsigned long long OFF_wt_prnn = OFF_wt_in + ((11264ull*1024*2 + 255ull) & ~255ull);
constexpr unsigned long long OFF_wt_patt = OFF_wt_prnn + ((1024ull*1024*2 + 255ull) & ~255ull);
constexpr unsigned long long OFF_wt_pmem = OFF_wt_patt + ((1024ull*1024*2 + 255ull) & ~255ull);
constexpr unsigned long long OFF_wt_out = OFF_wt_pmem + ((1024ull*1024*2 + 255ull) & ~255ull);
constexpr unsigned long long OFF_wt_memkv = OFF_wt_out + ((1024ull*1024*2 + 255ull) & ~255ull);
constexpr unsigned long long OFF_wt_a = OFF_wt_memkv + ((2048ull*1024*2 + 255ull) & ~255ull);
constexpr unsigned long long OFF_wt_x = OFF_wt_a + ((8ull*128*128*2 + 255ull) & ~255ull);
constexpr unsigned long long OFF_h = OFF_wt_x + ((8ull*128*128*2 + 255ull) & ~255ull);
constexpr unsigned long long OFF_mem_n = OFF_h + ((65536ull*1024*2 + 255ull) & ~255ull);
constexpr unsigned long long OFF_memk = OFF_mem_n + ((4096ull*1024*2 + 255ull) & ~255ull);
constexpr unsigned long long OFF_memvt = OFF_memk + ((4096ull*1024*2 + 255ull) & ~255ull);
constexpr unsigned long long OFF_xr = OFF_memvt + ((4096ull*1024*2 + 255ull) & ~255ull);
constexpr unsigned long long OFF_grs = OFF_xr + ((ACT + 255ull) & ~255ull);
constexpr unsigned long long OFF_qn = OFF_grs + ((ACT + 255ull) & ~255ull);
constexpr unsigned long long OFF_kn = OFF_qn + ((ACT + 255ull) & ~255ull);
constexpr unsigned long long OFF_vt = OFF_kn + ((ACT + 255ull) & ~255ull);
constexpr unsigned long long OFF_gas = OFF_vt + ((ACT + 255ull) & ~255ull);
constexpr unsigned long long OFF_qm = OFF_gas + ((ACT + 255ull) & ~255ull);
constexpr unsigned long long OFF_gms = OFF_qm + ((ACT + 255ull) & ~255ull);
constexpr unsigned long long OFF_gsig = OFF_gms + ((ACT + 255ull) & ~255ull);
constexpr unsigned long long OFF_hloc = OFF_gsig + ((ACT*3 + 255ull) & ~255ull);
constexpr unsigned long long OFF_cuma = OFF_hloc + ((ACT*2 + 255ull) & ~255ull);
constexpr unsigned long long OFF_chA = OFF_cuma + ((ACT*2 + 255ull) & ~255ull);
constexpr unsigned long long OFF_chH = OFF_chA + (((unsigned long long)GB*64*1024*4 + 255ull) & ~255ull);
constexpr unsigned long long OFF_rnn_g = OFF_chH + (((unsigned long long)GB*64*1024*4 + 255ull) & ~255ull);
constexpr unsigned long long OFF_att_g = OFF_rnn_g + ((ACT + 255ull) & ~255ull);
constexpr unsigned long long OFF_mem_g = OFF_att_g + ((ACT + 255ull) & ~255ull);
constexpr unsigned long long OFF_y = OFF_mem_g + ((ACT + 255ull) & ~255ull);
constexpr unsigned long long OFF_bar = OFF_y + ((ACT + 255ull) & ~255ull);
constexpr unsigned long long WS_NEED = OFF_bar + 256ull;
DI unsigned char* oq(unsigned char* w) { asm volatile("" : "+s"(w)); return w; }
struct Params {
  const float *x, *mem, *norm_g, *mem_norm_g, *w_in, *b_merge, *conv_w, *conv_b, *lru_wa, *lru_ba, *lru_wx, *lru_bx,
      *lru_lambda, *q_norm_g, *k_norm_g, *rel_bias, *w_mem_kv, *mem_q_norm_g, *mem_k_norm_g, *w_proj_rnn, *w_proj_att,
      *w_proj_mem, *w_out;
  float* out;
  unsigned char* ws;
  int step_lo, step_hi;
  DI u16* wt_in() const { return (u16*)(ws + OFF_wt_in); }
  DI u16* wt_prnn() const { return (u16*)(ws + OFF_wt_prnn); }
  DI u16* wt_patt() const { return (u16*)(ws + OFF_wt_patt); }
  DI u16* wt_pmem() const { return (u16*)(ws + OFF_wt_pmem); }
  DI u16* wt_out() const { return (u16*)(ws + OFF_wt_out); }
  DI u16* wt_memkv() const { return (u16*)(ws + OFF_wt_memkv); }
  DI u16* wt_a() const { return (u16*)(ws + OFF_wt_a); }
  DI u16* wt_x() const { return (u16*)(ws + OFF_wt_x); }
  DI u16* h() const { return (u16*)(ws + OFF_h); }
  DI u16* mem_n() const { return (u16*)(ws + OFF_mem_n); }
  DI u16* memk() const { return (u16*)(ws + OFF_memk); }
  DI u16* memvt() const { return (u16*)(ws + OFF_memvt); }
  DI u16* xr() const { return (u16*)(ws + OFF_xr); }
  DI u16* grs() const { return (u16*)(ws + OFF_grs); }
  DI u16* qn() const { return (u16*)(ws + OFF_qn); }
  DI u16* kn() const { return (u16*)(ws + OFF_kn); }
  DI u16* vt() const { return (u16*)(ws + OFF_vt); }
  DI u16* gas() const { return (u16*)(ws + OFF_gas); }
  DI u16* qm() const { return (u16*)(ws + OFF_qm); }
  DI u16* gms() const { return (u16*)(ws + OFF_gms); }
  DI u16* gsig() const { return (u16*)(ws + OFF_gsig); }
  DI u16* hloc() const { return (u16*)(ws + OFF_hloc); }
  DI u16* ytmp() const { return (u16*)(ws + OFF_hloc); }
  DI u16* cuma() const { return (u16*)(ws + OFF_cuma); }
  DI float* chA() const { return (float*)(ws + OFF_chA); }
  DI float* chH() const { return (float*)(ws + OFF_chH); }
  DI u16* rnn_g() const { return (u16*)(ws + OFF_rnn_g); }
  DI u16* att_g() const { return (u16*)(ws + OFF_att_g); }
  DI u16* mem_g() const { return (u16*)(ws + OFF_mem_g); }
  DI u16* y() const { return (u16*)(ws + OFF_y); }
};

DI void fast_barrier(unsigned* ctr, unsigned target) {
  asm volatile("s_waitcnt vmcnt(0)" ::: "memory");
  __syncthreads();
  if (__builtin_amdgcn_workitem_id_x() == 0) {
    __builtin_amdgcn_fence(__ATOMIC_RELEASE, "agent");
    asm volatile("s_waitcnt vmcnt(0)" ::: "memory");
    (void)__hip_atomic_fetch_add(ctr, 1u, __ATOMIC_RELAXED, __HIP_MEMORY_SCOPE_AGENT);
    unsigned sp = 0;
    while (__hip_atomic_load(ctr, __ATOMIC_RELAXED, __HIP_MEMORY_SCOPE_AGENT) < target) {
      __builtin_amdgcn_s_sleep(1);
      if (++sp > (1u << 24)) break;
    }
    __builtin_amdgcn_fence(__ATOMIC_ACQUIRE, "agent");
    asm volatile("s_waitcnt vmcnt(0)" ::: "memory");
  }
  __syncthreads();
}
DI int get_tid() { int t = __builtin_amdgcn_workitem_id_x(); asm volatile("" : "+v"(t)); return t; }
typedef float f32x2_t __attribute__((ext_vector_type(2)));
typedef __bf16 bf16x2_t __attribute__((ext_vector_type(2)));
DI unsigned pack2(float a, float b) { f32x2_t v = {a, b}; return __builtin_bit_cast(unsigned, __builtin_convertvector(v, bf16x2_t)); }
DI u16 f2bf(float x) { return (u16)(pack2(x, x) & 0xffffu); }
DI float bf2f(u16 b) { return __uint_as_float(((unsigned)b) << 16); }
DI float sigm(float v) { return __builtin_amdgcn_rcpf(1.f + __builtin_amdgcn_exp2f(-1.4426950408889634f * v)); }
DI float silu(float v) { return v * sigm(v); }
DI uint4 pack8(const float* v) { uint4 r; r.x = pack2(v[0], v[1]); r.y = pack2(v[2], v[3]); r.z = pack2(v[4], v[5]); r.w = pack2(v[6], v[7]); return r; }
DI void unpack8(uint4 r, float* v) {
  v[0] = __uint_as_float(r.x << 16); v[1] = __uint_as_float(r.x & 0xffff0000u);
  v[2] = __uint_as_float(r.y << 16); v[3] = __uint_as_float(r.y & 0xffff0000u);
  v[4] = __uint_as_float(r.z << 16); v[5] = __uint_as_float(r.z & 0xffff0000u);
  v[6] = __uint_as_float(r.w << 16); v[7] = __uint_as_float(r.w & 0xffff0000u);
}

template <bool PANEL>
DI void transpose_tile(const float* __restrict__ src, int R, int C, u16* __restrict__ dst, int tr, int tc, float* tile) {
  const int tid = get_tid();
  __syncthreads();
#pragma unroll
  for (int i = 0; i < 2; ++i) {
    const int r = (tid >> 4) + 32 * i, c4 = (tid & 15) * 4;
    const float4 v = *(const float4*)(src + (size_t)(tr * 64 + r) * C + tc * 64 + c4);
    tile[r * 65 + c4 + 0] = v.x; tile[r * 65 + c4 + 1] = v.y; tile[r * 65 + c4 + 2] = v.z; tile[r * 65 + c4 + 3] = v.w;
  }
  __syncthreads();
  {
    const int c = tid >> 3, r8 = (tid & 7) * 8;
    float v[8];
#pragma unroll
    for (int j = 0; j < 8; ++j) v[j] = tile[(r8 + j) * 65 + c];
    if (PANEL) *(uint4*)(dst + ((size_t)tr * C + tc * 64 + c) * 64 + r8) = pack8(v);
    else *(uint4*)(dst + (size_t)(tc * 64 + c) * R + tr * 64 + r8) = pack8(v);
  }
}

DI void rms_row(const float* __restrict__ src, const float* __restrict__ g, u16* __restrict__ dst, size_t ROWS, size_t r) {
  const int lane = get_tid() & 63;
  float4 v[4];
  float ss = 0.f;
#pragma unroll
  for (int i = 0; i < 4; ++i) {
    v[i] = *(const float4*)(src + i * 256 + lane * 4);
    ss += v[i].x * v[i].x + v[i].y * v[i].y + v[i].z * v[i].z + v[i].w * v[i].w;
  }
#pragma unroll
  for (int o = 32; o >= 1; o >>= 1) ss += __shfl_xor(ss, o);
  const float rstd = rsqrtf(ss * (1.f / 1024.f) + EPS);
#pragma unroll
  for (int i = 0; i < 4; ++i) {
    const float4 gg = *(const float4*)(g + i * 256 + lane * 4);
    uint2 o;
    o.x = pack2(v[i].x * rstd * gg.x, v[i].y * rstd * gg.y);
    o.y = pack2(v[i].z * rstd * gg.z, v[i].w * rstd * gg.w);
    *(uint2*)(dst + ((size_t)(i * 4 + (lane >> 4)) * ROWS + r) * 64 + (lane & 15) * 4) = o;
  }
}

DI void step_prep(const Params& p, unsigned char* smem) {
  float* tile = (float*)smem;
  for (int it = blockIdx.x; it < T_TR + T_ROWS; it += gridDim.x) {
    if (it < T_TR) {
      int j = it;
      if (j < 2816) { transpose_tile<true>(p.w_in, 1024, 11264, p.wt_in(), j % 16, j / 16, tile); continue; }
      j -= 2816;
      if (j < 1024) {
        const int k = j >> 8, jj = j & 255;
        const float* s = k == 0 ? p.w_proj_rnn : k == 1 ? p.w_proj_att : k == 2 ? p.w_proj_mem : p.w_out;
        u16* d = k == 0 ? p.wt_prnn() : k == 1 ? p.wt_patt() : k == 2 ? p.wt_pmem() : p.wt_out();
        transpose_tile<true>(s, 1024, 1024, d, jj % 16, jj / 16, tile);
        continue;
      }
      j -= 1024;
      if (j < 512) { transpose_tile<true>(p.w_mem_kv, 1024, 2048, p.wt_memkv(), j % 16, j / 16, tile); continue; }
      j -= 512;
      {
        const int mat = j >> 5, jj = j & 31, n = jj >> 2, tr = (jj >> 1) & 1, tc = jj & 1;
        transpose_tile<false>((mat ? p.lru_wx : p.lru_wa) + n * 16384, 128, 128, (mat ? p.wt_x() : p.wt_a()) + n * 16384, tr, tc, tile);
      }
    } else {
      const int r = (it - T_TR) * 8 + (get_tid() >> 6);
      if (r < 65536) rms_row(p.x + (size_t)r * 1024, p.norm_g, p.h(), 65536, r);
      else { const int m = r - 65536; rms_row(p.mem + (size_t)m * 1024, p.mem_norm_g, p.mem_n(), 4096, m); }
    }
  }
}

DI void zero_acc(f32x16 (&acc)[2][4]) {
#pragma unroll
  for (int a = 0; a < 2; ++a)
#pragma unroll
    for (int b = 0; b < 4; ++b)
#pragma unroll
      for (int r = 0; r < 16; ++r) acc[a][b][r] = 0.f;
}

DI void gemm_kloop(const u16* __restrict__ A, size_t aks, const u16* __restrict__ Bt, size_t bks, int K, f32x16 (&acc)[2][4],
                   unsigned char* smem) {
  u16* sA = (u16*)smem;
  const int tid = get_tid(), lane = tid & 63, wave = tid >> 6, wm = wave >> 1, wn = wave & 1;
  const int lr = tid >> 3, lc = (tid & 7) * 8;
  const u16* ga = A + (size_t)lr * 64 + lc;
  const u16* gb = Bt + (size_t)lr * 64 + lc;
  constexpr size_t sa64 = 4096, sb64 = 4096;
  u32x4 ra0 = *(const u32x4*)(ga), ra1 = *(const u32x4*)(ga + sa64), ra2 = *(const u32x4*)(ga + 2 * sa64), ra3 = *(const u32x4*)(ga + 3 * sa64);
  u32x4 rb0 = *(const u32x4*)(gb), rb1 = *(const u32x4*)(gb + sb64), rb2 = *(const u32x4*)(gb + 2 * sb64), rb3 = *(const u32x4*)(gb + 3 * sb64);
  const int nk = K >> 6;
  const int pa_off = (wm * 64 + (lane & 31)) * 72 + (lane >> 5) * 8;
  const int pb_off = 18432 + (wn * 128 + (lane & 31)) * 72 + (lane >> 5) * 8;
  const int wa_off = lr * 72 + lc;
  const int wb_off = 18432 + lr * 72 + lc;
  __syncthreads();
  {
    u16* d = sA + wa_off;
    *(u32x4*)(d) = ra0; *(u32x4*)(d + 64 * 72) = ra1; *(u32x4*)(d + 128 * 72) = ra2; *(u32x4*)(d + 192 * 72) = ra3;
    d = sA + wb_off;
    *(u32x4*)(d) = rb0; *(u32x4*)(d + 64 * 72) = rb1; *(u32x4*)(d + 128 * 72) = rb2; *(u32x4*)(d + 192 * 72) = rb3;
  }
  if (nk > 1) {
    ga += aks; gb += bks;
    ra0 = *(const u32x4*)(ga); ra1 = *(const u32x4*)(ga + sa64); ra2 = *(const u32x4*)(ga + 2 * sa64); ra3 = *(const u32x4*)(ga + 3 * sa64);
    rb0 = *(const u32x4*)(gb); rb1 = *(const u32x4*)(gb + sb64); rb2 = *(const u32x4*)(gb + 2 * sb64); rb3 = *(const u32x4*)(gb + 3 * sb64);
  }
  __syncthreads();
  for (int kt = 0; kt < nk; ++kt) {
    const int cur = (kt & 1) * 36864, nxt = 36864 - cur;
    const bool wr = kt + 1 < nk, ld = kt + 2 < nk;
    if (ld) { ga += aks; gb += bks; }
    const u16* pa = sA + cur + pa_off;
    const u16* pb = sA + cur + pb_off;
    u16* da = sA + nxt + wa_off;
    u16* db = sA + nxt + wb_off;
#pragma unroll
    for (int s = 0; s < 4; ++s) {
      if (wr) {
        if (s == 0) { *(u32x4*)(da) = ra0; *(u32x4*)(da + 64 * 72) = ra1; }
        if (s == 1) { *(u32x4*)(da + 128 * 72) = ra2; *(u32x4*)(da + 192 * 72) = ra3; }
        if (s == 2) { *(u32x4*)(db) = rb0; *(u32x4*)(db + 64 * 72) = rb1; }
        if (s == 3) { *(u32x4*)(db + 128 * 72) = rb2; *(u32x4*)(db + 192 * 72) = rb3; }
      }
      if (ld) {
        if (s == 0) { ra0 = *(const u32x4*)(ga); ra1 = *(const u32x4*)(ga + sa64); }
        if (s == 1) { ra2 = *(const u32x4*)(ga + 2 * sa64); ra3 = *(const u32x4*)(ga + 3 * sa64); }
        if (s == 2) { rb0 = *(const u32x4*)(gb); rb1 = *(const u32x4*)(gb + sb64); }
        if (s == 3) { rb2 = *(const u32x4*)(gb + 2 * sb64); rb3 = *(const u32x4*)(gb + 3 * sb64); }
      }
      const bf16x8 a0 = *(const bf16x8*)(pa + s * 16);
      const bf16x8 a1 = *(const bf16x8*)(pa + 32 * 72 + s * 16);
      const bf16x8 b0 = *(const bf16x8*)(pb + s * 16);
      const bf16x8 b1 = *(const bf16x8*)(pb + 32 * 72 + s * 16);
      const bf16x8 b2 = *(const bf16x8*)(pb + 64 * 72 + s * 16);
      const bf16x8 b3 = *(const bf16x8*)(pb + 96 * 72 + s * 16);
      acc[0][0] = __builtin_amdgcn_mfma_f32_32x32x16_bf16(a0, b0, acc[0][0], 0, 0, 0);
      acc[0][1] = __builtin_amdgcn_mfma_f32_32x32x16_bf16(a0, b1, acc[0][1], 0, 0, 0);
      acc[0][2] = __builtin_amdgcn_mfma_f32_32x32x16_bf16(a0, b2, acc[0][2], 0, 0, 0);
      acc[0][3] = __builtin_amdgcn_mfma_f32_32x32x16_bf16(a0, b3, acc[0][3], 0, 0, 0);
      acc[1][0] = __builtin_amdgcn_mfma_f32_32x32x16_bf16(a1, b0, acc[1][0], 0, 0, 0);
      acc[1][1] = __builtin_amdgcn_mfma_f32_32x32x16_bf16(a1, b1, acc[1][1], 0, 0, 0);
      acc[1][2] = __builtin_amdgcn_mfma_f32_32x32x16_bf16(a1, b2, acc[1][2], 0, 0, 0);
      acc[1][3] = __builtin_amdgcn_mfma_f32_32x32x16_bf16(a1, b3, acc[1][3], 0, 0, 0);
      __builtin_amdgcn_sched_barrier(0);
    }
    __syncthreads();
  }
}

template <typename F>
DI void wave_epilogue(const f32x16 (&acc)[2][4], unsigned char* smem, F f) {
  const int tid = get_tid(), lane = tid & 63, wave = tid >> 6;
  float* sW = (float*)smem + wave * (32 * 132);
#pragma unroll
  for (int mi = 0; mi < 2; ++mi) {
#pragma unroll
    for (int ni = 0; ni < 4; ++ni)
#pragma unroll
      for (int r = 0; r < 16; ++r) {
        const int row = (r & 3) + 8 * (r >> 2) + 4 * (lane >> 5);
        sW[row * 132 + ni * 32 + (lane & 31)] = acc[mi][ni][r];
      }
    __builtin_amdgcn_fence(__ATOMIC_RELEASE, "wavefront");
    __builtin_amdgcn_fence(__ATOMIC_ACQUIRE, "wavefront");
    f(mi, sW);
    __builtin_amdgcn_fence(__ATOMIC_RELEASE, "wavefront");
    __builtin_amdgcn_fence(__ATOMIC_ACQUIRE, "wavefront");
  }
}

template <typename F>
DI void slab_rows(const float* sW, F f) {
  const int lane = get_tid() & 63, rsub = lane >> 3, chunk = lane & 7;
#pragma unroll
  for (int i = 0; i < 4; ++i)
#pragma unroll
    for (int hf = 0; hf < 2; ++hf) {
      const int row = i * 8 + rsub, c = hf * 64 + chunk * 8;
      float v[8];
      const float4 a = *(const float4*)(sW + row * 132 + c), b = *(const float4*)(sW + row * 132 + c + 4);
      v[0] = a.x; v[1] = a.y; v[2] = a.z; v[3] = a.w; v[4] = b.x; v[5] = b.y; v[6] = b.z; v[7] = b.w;
      f(row, c, v, i);
    }
}

DI void slab_store_transposed(const float* sW, u16* __restrict__ dst, size_t ldd) {
  const int lane = get_tid() & 63;
#pragma unroll
  for (int dd = 0; dd < 2; ++dd)
#pragma unroll
    for (int j = 0; j < 4; ++j) {
      const int d = lane + 64 * dd;
      float v[8];
#pragma unroll
      for (int e = 0; e < 8; ++e) v[e] = sW[(j * 8 + e) * 132 + d];
      *(uint4*)(dst + (size_t)d * ldd + j * 8) = pack8(v);
    }
}

DI void step_memkv(const Params& p, unsigned char* smem) {
  for (int t = blockIdx.x; t < 16 * 8; t += gridDim.x) {
    const int mt = t % 16, nt = t / 16;
    f32x16 acc[2][4];
    zero_acc(acc);
    gemm_kloop(p.mem_n() + (size_t)mt * 256 * 64, (size_t)4096 * 64, p.wt_memkv() + (size_t)nt * 256 * 64, (size_t)2048 * 64, 1024, acc, smem);
    const int wave = get_tid() >> 6, wm = wave >> 1, wn = wave & 1;
    wave_epilogue(acc, smem, [&](int mi, const float* sW) {
      const int r0 = wm * 64 + mi * 32;
      if (nt < 4) {
        u16* dst = p.memk() + ((size_t)mt * 256 + r0) * 1024 + nt * 256 + wn * 128;
        slab_rows(sW, [&](int row, int c, const float* v, int i_) { *(uint4*)(dst + (size_t)row * 1024 + c) = pack8(v); });
      } else {
        const int hh = nt - 4;
        slab_store_transposed(sW, p.memvt() + ((size_t)(mt * 4 + hh) * 256 + wn * 128) * 256 + r0, 256);
      }
    });
  }
}

DI void memk_norm_row(const Params& p, int row) {
  const int lane = get_tid() & 63;
  u16* ptr = p.memk() + (size_t)row * 1024 + lane * 16;
  float v[16];
  unpack8(*(const uint4*)ptr, v);
  unpack8(*(const uint4*)(ptr + 8), v + 8);
  float ss = 0.f;
#pragma unroll
  for (int e = 0; e < 16; ++e) ss += v[e] * v[e];
#pragma unroll
  for (int o = 1; o <= 8; o <<= 1) ss += __shfl_xor(ss, o);
  const float sc = rsqrtf(ss * (1.f / 256.f) + EPS);
  const float* g = p.mem_k_norm_g + (lane & 15) * 16;
#pragma unroll
  for (int e = 0; e < 16; ++e) v[e] *= sc * g[e];
  *(uint4*)ptr = pack8(v);
  *(uint4*)(ptr + 8) = pack8(v + 8);
}

DI void step_gemm1(const Params& p, int pass, bool first, unsigned char* smem) {
  if (pass == 0 && first) {
    for (int it = blockIdx.x; it < 512; it += gridDim.x) memk_norm_row(p, it * 8 + (get_tid() >> 6));
  }
  const u16* A = p.h() + (size_t)pass * TOK * 64;
  constexpr int MT = TOK / 256;
  for (int t = blockIdx.x; t < MT * 44; t += gridDim.x) {
    const int mt = t % MT, nt = t / MT;
    f32x16 acc[2][4];
    zero_acc(acc);
    gemm_kloop(A + (size_t)mt * 256 * 64, (size_t)65536 * 64, p.wt_in() + (size_t)nt * 256 * 64, (size_t)11264 * 64, 1024, acc, smem);
    const int wave = get_tid() >> 6, wm = wave >> 1, wn = wave & 1;
    const int seg = nt >> 2, cb = (nt & 3) * 256 + wn * 128;
    wave_epilogue(acc, smem, [&](int mi, const float* sW) {
      const size_t rowbase = (size_t)mt * 256 + wm * 64 + mi * 32;
      if (seg == 0 || seg == 6) {
        u16* dst = (seg == 0 ? p.xr() : p.qm()) + rowbase * 1024 + cb;
        slab_rows(sW, [&](int row, int c, const float* v, int i_) { *(uint4*)(dst + (size_t)row * 1024 + c) = pack8(v); });
      } else if (seg == 1 || seg == 5 || seg == 7) {
        u16* dst = (seg == 1 ? p.grs() : seg == 5 ? p.gas() : p.gms()) + rowbase * 1024 + cb;
        slab_rows(sW, [&](int row, int c, const float* v, int i_) {
          float o[8];
#pragma unroll
          for (int e = 0; e < 8; ++e) o[e] = silu(v[e]);
          *(uint4*)(dst + (size_t)row * 1024 + c) = pack8(o);
        });
      } else if (seg == 2 || seg == 3) {
        float ss[4] = {0.f, 0.f, 0.f, 0.f};
        slab_rows(sW, [&](int row, int c, const float* v, int i_) {
#pragma unroll
          for (int e = 0; e < 8; ++e) ss[i_] += v[e] * v[e];
        });
        float sc[4];
#pragma unroll
        for (int q_ = 0; q_ < 4; ++q_) {
          float t_ = ss[q_];
          t_ += __shfl_xor(t_, 1); t_ += __shfl_xor(t_, 2); t_ += __shfl_xor(t_, 4);
          sc[q_] = rsqrtf(t_ * (1.f / 128.f) + EPS) * (seg == 2 ? 0.08838834764831845f * 1.4426950408889634f : 1.f);
        }
        const float* g = seg == 2 ? p.q_norm_g : p.k_norm_g;
        u16* dst = (seg == 2 ? p.qn() : p.kn()) + rowbase * 1024 + cb;
        slab_rows(sW, [&](int row, int c, const float* v, int i_) {
          float o[8];
          const float4 g0 = *(const float4*)(g + c), g1 = *(const float4*)(g + c + 4);
          const float s_ = sc[i_];
          o[0] = v[0] * s_ * g0.x; o[1] = v[1] * s_ * g0.y; o[2] = v[2] * s_ * g0.z; o[3] = v[3] * s_ * g0.w;
          o[4] = v[4] * s_ * g1.x; o[5] = v[5] * s_ * g1.y; o[6] = v[6] * s_ * g1.z; o[7] = v[7] * s_ * g1.w;
          *(uint4*)(dst + (size_t)row * 1024 + c) = pack8(o);
        });
      } else if (seg == 4) {
        const int bl = mt >> 4, s0 = (mt & 15) * 256 + wm * 64 + mi * 32, hh = cb >> 7;
        slab_store_transposed(sW, p.vt() + (size_t)(bl * 8 + hh) * 128 * 4096 + s0, 4096);
      } else {
        const int gc = (nt - 32) * 256 + wn * 128;
        const float* bm = p.b_merge + gc;
        u16* dst = p.gsig() + rowbase * 3072 + gc;
        slab_rows(sW, [&](int row, int c, const float* v, int i_) {
          float o[8];
          const float4 b0 = *(const float4*)(bm + c), b1 = *(const float4*)(bm + c + 4);
          o[0] = sigm(v[0] + b0.x); o[1] = sigm(v[1] + b0.y); o[2] = sigm(v[2] + b0.z); o[3] = sigm(v[3] + b0.w);
          o[4] = sigm(v[4] + b1.x); o[5] = sigm(v[5] + b1.y); o[6] = sigm(v[6] + b1.z); o[7] = sigm(v[7] + b1.w);
          *(uint4*)(dst + (size_t)row * 3072 + c) = pack8(o);
        });
      }
    });
  }
}

template <int HD, bool BAND>
DI void attn_core(const u16* __restrict__ Q, const u16* __restrict__ K, const u16* __restrict__ Vt, int ldv, int u0, int u1,
                  const float* __restrict__ bias_row, const float* __restrict__ qg,
                  u16* __restrict__ Out, size_t orow0, int okb, const u16* __restrict__ Gate, unsigned char* smem) {
  constexpr int KS = HD / 32, DB = HD / 16, LDK = HD + 8, NCH = HD / 64;
  u16* sK = (u16*)smem;
  u16* sV = (u16*)(smem + 64 * LDK * 2);
  float* sBias = (float*)(smem + 64 * LDK * 2 + HD * 72 * 2);
  const int tid = get_tid(), lane = tid & 63, w = tid >> 6, l15 = lane & 15, g = lane >> 4, sb = w >> 2, wq = w & 3;
  __syncthreads();
  if (BAND) { for (int i = tid; i < 513; i += 512) sBias[i] = bias_row[i] * 1.4426950408889634f; }
  const float bias_far = BAND ? bias_row[512] * 1.4426950408889634f : 0.f;
  bf16x8 qf[KS];
  {
    const u16* qrow = Q + (size_t)(w * 16 + l15) * 1024 + g * 8;
#pragma unroll
    for (int ks = 0; ks < KS; ++ks) qf[ks] = *(const bf16x8*)(qrow + ks * 32);
    if (!BAND) {
      float ss = 0.f;
#pragma unroll
      for (int ks = 0; ks < KS; ++ks) {
        float v[8];
        unpack8(__builtin_bit_cast(uint4, qf[ks]), v);
#pragma unroll
        for (int e = 0; e < 8; ++e) ss += v[e] * v[e];
      }
      ss += __shfl_xor(ss, 16);
      ss += __shfl_xor(ss, 32);
      const float sc = rsqrtf(ss * (1.f / HD) + EPS) * (0.0625f * 1.4426950408889634f);
#pragma unroll
      for (int ks = 0; ks < KS; ++ks) {
        float v[8];
        unpack8(__builtin_bit_cast(uint4, qf[ks]), v);
        const float4 g0 = *(const float4*)(qg + ks * 32 + g * 8), g1 = *(const float4*)(qg + ks * 32 + g * 8 + 4);
        v[0] *= sc * g0.x; v[1] *= sc * g0.y; v[2] *= sc * g0.z; v[3] *= sc * g0.w;
        v[4] *= sc * g1.x; v[5] *= sc * g1.y; v[6] *= sc * g1.z; v[7] *= sc * g1.w;
        qf[ks] = __builtin_bit_cast(bf16x8, pack8(v));
      }
    }
  }
  f32x4 o[DB];
#pragma unroll
  for (int db = 0; db < DB; ++db) o[db] = f32x4{0.f, 0.f, 0.f, 0.f};
  float m = -1e30f, lsum = 0.f;

  const int krow = tid >> 3, kpart = (tid & 7) * (HD / 8);
  u32x4 rkA[NCH], rvA[NCH], rkB[HD == 128 ? NCH : 1], rvB[HD == 128 ? NCH : 1];
  auto load_tile = [&](int u, auto& rk, auto& rv) {
    const u16* ksrc = K + ((size_t)u * 64 + krow) * 1024 + kpart;
#pragma unroll
    for (int i = 0; i < NCH; ++i) rk[i] = *(const u32x4*)(ksrc + i * 8);
#pragma unroll
    for (int i = 0; i < NCH; ++i) {
      const int id = tid + 512 * i, d = id >> 3, cc = id & 7;
      rv[i] = *(const u32x4*)(Vt + (size_t)d * ldv + u * 64 + cc * 8);
    }
  };
  auto store_tile = [&](const auto& rk, const auto& rv) {
#pragma unroll
    for (int i = 0; i < NCH; ++i) *(u32x4*)(sK + krow * LDK + kpart + i * 8) = rk[i];
#pragma unroll
    for (int i = 0; i < NCH; ++i) {
      const int id = tid + 512 * i, d = id >> 3, cc = id & 7;
      *(u32x4*)(sV + d * 72 + cc * 8) = rv[i];
    }
  };
  auto compute_tile = [&](int u) {
    if (BAND && (u < sb || u > sb + 8)) return;
    f32x4 s[4];
#pragma unroll
    for (int kb = 0; kb < 4; ++kb) {
      s[kb] = f32x4{0.f, 0.f, 0.f, 0.f};
#pragma unroll
      for (int ks = 0; ks < KS; ++ks) {
        const bf16x8 kf = *(const bf16x8*)(sK + (kb * 16 + l15) * LDK + ks * 32 + g * 8);
        s[kb] = __builtin_amdgcn_mfma_f32_16x16x32_bf16(kf, qf[ks], s[kb], 0, 0, 0);
      }
      if (HD > 128) __builtin_amdgcn_sched_barrier(0);
    }
    float mx = -1e30f;
    if (BAND) {
      if ((8 + sb - u) * 64 - 63 >= 256) {
#pragma unroll
        for (int kb = 0; kb < 4; ++kb)
#pragma unroll
          for (int i = 0; i < 4; ++i) s[kb][i] += bias_far;
      } else {
        const int dbase = (8 + sb - u) * 64 + (wq * 16 + l15) - g * 4 + 256;
#pragma unroll
        for (int kb = 0; kb < 4; ++kb)
#pragma unroll
          for (int i = 0; i < 4; ++i) s[kb][i] += sBias[min(dbase - (kb * 16 + i), 512)];
      }
    }
#pragma unroll
    for (int kb = 0; kb < 4; ++kb)
#pragma unroll
      for (int i = 0; i < 4; ++i) mx = fmaxf(mx, s[kb][i]);
    mx = fmaxf(mx, __shfl_xor(mx, 16));
    mx = fmaxf(mx, __shfl_xor(mx, 32));
    const float mn = fmaxf(m, mx);
    const float alpha = __builtin_amdgcn_exp2f(m - mn);
    m = mn;
    lsum *= alpha;
#pragma unroll
    for (int db = 0; db < DB; ++db) { o[db][0] *= alpha; o[db][1] *= alpha; o[db][2] *= alpha; o[db][3] *= alpha; }
    bf16x8 pf[2];
#pragma unroll
    for (int k2 = 0; k2 < 2; ++k2) {
      float pv[8];
#pragma unroll
      for (int i = 0; i < 4; ++i) {
        pv[i] = __builtin_amdgcn_exp2f(s[2 * k2][i] - mn);
        pv[4 + i] = __builtin_amdgcn_exp2f(s[2 * k2 + 1][i] - mn);
      }
#pragma unroll
      for (int e = 0; e < 8; ++e) lsum += pv[e];
      pf[k2] = __builtin_bit_cast(bf16x8, pack8(pv));
    }
#pragma unroll
    for (int db = 0; db < DB; ++db) {
#pragma unroll
      for (int k2 = 0; k2 < 2; ++k2) {
        const u16* vp = sV + (db * 16 + l15) * 72 + k2 * 32 + g * 4;
        const uint2 lo = *(const uint2*)vp, hi = *(const uint2*)(vp + 16);
        uint4 vv; vv.x = lo.x; vv.y = lo.y; vv.z = hi.x; vv.w = hi.y;
        o[db] = __builtin_amdgcn_mfma_f32_16x16x32_bf16(__builtin_bit_cast(bf16x8, vv), pf[k2], o[db], 0, 0, 0);
      }
      if (HD > 128 && (db & 3) == 3) __builtin_amdgcn_sched_barrier(0);
    }
  };
  load_tile(u0, rkA, rvA);
  if (HD == 128) {
    if (u0 + 1 < u1) load_tile(u0 + 1, rkB, rvB);
    for (int u = u0; u < u1; u += 2) {
      __syncthreads();
      store_tile(rkA, rvA);
      __syncthreads();
      if (u + 2 < u1) load_tile(u + 2, rkA, rvA);
      compute_tile(u);
      if (u + 1 < u1) {
        __syncthreads();
        store_tile(rkB, rvB);
        __syncthreads();
        if (u + 3 < u1) load_tile(u + 3, rkB, rvB);
        compute_tile(u + 1);
      }
    }
  } else {
    for (int u = u0; u < u1; ++u) {
      __syncthreads();
      store_tile(rkA, rvA);
      __syncthreads();
      if (u + 1 < u1) load_tile(u + 1, rkA, rvA);
      compute_tile(u);
    }
  }
  lsum += __shfl_xor(lsum, 16);
  lsum += __shfl_xor(lsum, 32);
  const float inv = 1.f / lsum;
  {
    const size_t ro = (size_t)(w * 16 + l15) * 1024 + g * 4;
#pragma unroll
    for (int db = 0; db < DB; ++db) {
      const uint2 gv = *(const uint2*)(Gate + ro + db * 16);
      uint2 ov;
      ov.x = pack2(o[db][0] * inv * __uint_as_float(gv.x << 16), o[db][1] * inv * __uint_as_float(gv.x & 0xffff0000u));
      ov.y = pack2(o[db][2] * inv * __uint_as_float(gv.y << 16), o[db][3] * inv * __uint_as_float(gv.y & 0xffff0000u));
      *(uint2*)(Out + ((size_t)((okb >> 6) + (db >> 2)) * TOK + orow0 + w * 16 + l15) * 64 + (db & 3) * 16 + g * 4) = ov;
    }
  }
}

DI void rnn_local_item(const Params& p, int bl, int c0, int n, unsigned char* smem) {
  const int tid = get_tid(), sbk = tid >> 8, tl = tid & 255, lane = tid & 63, w = tl >> 6, l15 = lane & 15, g = lane >> 4;
  unsigned char* sm = smem + sbk * 67584;
  float* sxc = (float*)sm;
  float* sa = (float*)(sm + 33792);
  u16* sxcb = (u16*)(sm + 33792);
  const int c = c0 + sbk;
  const int ch0 = n * 128;
  const size_t tok0 = (size_t)bl * 4096 + c * 64;
  __syncthreads();
  {
    const int c8 = (tl & 15) * 8, t4 = (tl >> 4) * 4;
    const u16* src = p.xr() + tok0 * 1024 + ch0 + c8;
    uint4 xr_[7];
#pragma unroll
    for (int j = 0; j < 7; ++j) {
      const int t = t4 - 3 + j;
      if (c * 64 + t >= 0) xr_[j] = *(const uint4*)(src + (ptrdiff_t)t * 1024);
      else xr_[j] = uint4{0u, 0u, 0u, 0u};
    }
    float wv[4][8], cbv[8];
#pragma unroll
    for (int k = 0; k < 4; ++k) {
      const float4 w0 = *(const float4*)(p.conv_w + k * 1024 + ch0 + c8), w1 = *(const float4*)(p.conv_w + k * 1024 + ch0 + c8 + 4);
      wv[k][0] = w0.x; wv[k][1] = w0.y; wv[k][2] = w0.z; wv[k][3] = w0.w; wv[k][4] = w1.x; wv[k][5] = w1.y; wv[k][6] = w1.z; wv[k][7] = w1.w;
    }
    {
      const float4 b0 = *(const float4*)(p.conv_b + ch0 + c8), b1 = *(const float4*)(p.conv_b + ch0 + c8 + 4);
      cbv[0] = b0.x; cbv[1] = b0.y; cbv[2] = b0.z; cbv[3] = b0.w; cbv[4] = b1.x; cbv[5] = b1.y; cbv[6] = b1.z; cbv[7] = b1.w;
    }
    float xf[7][8];
#pragma unroll
    for (int j = 0; j < 7; ++j) unpack8(xr_[j], xf[j]);
#pragma unroll
    for (int tt = 0; tt < 4; ++tt) {
      float xc[8];
#pragma unroll
      for (int e = 0; e < 8; ++e)
        xc[e] = wv[0][e] * xf[tt][e] + wv[1][e] * xf[tt + 1][e] + wv[2][e] * xf[tt + 2][e] + wv[3][e] * xf[tt + 3][e] + cbv[e];
      float* d = sxc + (t4 + tt) * 132 + c8;
      *(float4*)d = float4{xc[0], xc[1], xc[2], xc[3]};
      *(float4*)(d + 4) = float4{xc[4], xc[5], xc[6], xc[7]};
      *(uint4*)(sxcb + (t4 + tt) * 136 + c8) = pack8(xc);
    }
  }
  __syncthreads();
  f32x4 accR[4][2], accI[4][2];
#pragma unroll
  for (int tb = 0; tb < 4; ++tb)
#pragma unroll
    for (int jb = 0; jb < 2; ++jb) { accR[tb][jb] = f32x4{0.f, 0.f, 0.f, 0.f}; accI[tb][jb] = f32x4{0.f, 0.f, 0.f, 0.f}; }
  {
    bf16x8 bR[2][4], bI[2][4];
#pragma unroll
    for (int jb = 0; jb < 2; ++jb)
#pragma unroll
      for (int ks = 0; ks < 4; ++ks) {
        const size_t off = (size_t)n * 16384 + (size_t)(32 * w + jb * 16 + l15) * 128 + ks * 32 + g * 8;
        bR[jb][ks] = *(const bf16x8*)(p.wt_a() + off);
        bI[jb][ks] = *(const bf16x8*)(p.wt_x() + off);
      }
#pragma unroll
    for (int tb = 0; tb < 4; ++tb)
#pragma unroll
      for (int ks = 0; ks < 4; ++ks) {
        const bf16x8 af = *(const bf16x8*)(sxcb + (tb * 16 + l15) * 136 + ks * 32 + g * 8);
#pragma unroll
        for (int jb = 0; jb < 2; ++jb) {
          accR[tb][jb] = __builtin_amdgcn_mfma_f32_16x16x32_bf16(af, bR[jb][ks], accR[tb][jb], 0, 0, 0);
          accI[tb][jb] = __builtin_amdgcn_mfma_f32_16x16x32_bf16(af, bI[jb][ks], accI[tb][jb], 0, 0, 0);
        }
      }
  }
  __syncthreads();
#pragma unroll
  for (int jb = 0; jb < 2; ++jb) {
    const int ch = 32 * w + jb * 16 + l15;
    const float ba = p.lru_ba[ch0 + ch], bx = p.lru_bx[ch0 + ch];
    const float sp = log1pf(expf(-p.lru_lambda[ch0 + ch]));
#pragma unroll
    for (int tb = 0; tb < 4; ++tb)
#pragma unroll
      for (int r = 0; r < 4; ++r) {
        const int t = tb * 16 + g * 4 + r;
        const float rg = sigm(accR[tb][jb][r] + ba), ig = sigm(accI[tb][jb][r] + bx);
        const float la = -8.f * rg * sp;
        const float a = __expf(la);
        const float mult = __builtin_amdgcn_sqrtf(fmaxf(1.f - __expf(2.f * la), 0.f));
        const float xc = sxc[t * 132 + ch];
        sa[t * 132 + ch] = a;
        sxc[t * 132 + ch] = mult * (ig * xc);
      }
  }
  __syncthreads();
  {
    const int ch = tl & 127, half = tl >> 7, tb = half * 32;
    float hh = 0.f, A = 1.f;
#pragma unroll 8
    for (int t = tb; t < tb + 32; ++t) {
      const float a = sa[t * 132 + ch];
      hh = a * hh + sxc[t * 132 + ch];
      A *= a;
      sxc[t * 132 + ch] = hh;
      sa[t * 132 + ch] = A;
    }
    __syncthreads();
  }
  {
    const int c8 = (tl & 15) * 8, r0 = tl >> 4;
    float cH[8], cA[8];
    {
      const float4 h0 = *(const float4*)(sxc + 31 * 132 + c8), h1 = *(const float4*)(sxc + 31 * 132 + c8 + 4);
      const float4 a0 = *(const float4*)(sa + 31 * 132 + c8), a1 = *(const float4*)(sa + 31 * 132 + c8 + 4);
      cH[0] = h0.x; cH[1] = h0.y; cH[2] = h0.z; cH[3] = h0.w; cH[4] = h1.x; cH[5] = h1.y; cH[6] = h1.z; cH[7] = h1.w;
      cA[0] = a0.x; cA[1] = a0.y; cA[2] = a0.z; cA[3] = a0.w; cA[4] = a1.x; cA[5] = a1.y; cA[6] = a1.z; cA[7] = a1.w;
    }
#pragma unroll
    for (int i = 0; i < 4; ++i) {
      const int row = r0 + 16 * i;
      const float4 h0 = *(const float4*)(sxc + row * 132 + c8), h1 = *(const float4*)(sxc + row * 132 + c8 + 4);
      const float4 a0 = *(const float4*)(sa + row * 132 + c8), a1 = *(const float4*)(sa + row * 132 + c8 + 4);
      float hv[8] = {h0.x, h0.y, h0.z, h0.w, h1.x, h1.y, h1.z, h1.w};
      float av[8] = {a0.x, a0.y, a0.z, a0.w, a1.x, a1.y, a1.z, a1.w};
      if (i >= 2) {
#pragma unroll
        for (int e = 0; e < 8; ++e) { hv[e] += av[e] * cH[e]; av[e] *= cA[e]; }
      }
      const size_t o = (tok0 + row) * 1024 + ch0 + c8;
      *(uint4*)(p.hloc() + o) = pack8(hv);
      *(uint4*)(p.cuma() + o) = pack8(av);
      if (row == 63) {
        float* da = p.chA() + ((size_t)bl * 64 + c) * 1024 + ch0 + c8;
        float* dh = p.chH() + ((size_t)bl * 64 + c) * 1024 + ch0 + c8;
        *(float4*)da = float4{av[0], av[1], av[2], av[3]}; *(float4*)(da + 4) = float4{av[4], av[5], av[6], av[7]};
        *(float4*)dh = float4{hv[0], hv[1], hv[2], hv[3]}; *(float4*)(dh + 4) = float4{hv[4], hv[5], hv[6], hv[7]};
      }
    }
  }
}

DI void step_mix(const Params& p, int pass, unsigned char* smem) {
  constexpr int NB = GB * 32 * 8, NM = GB * 32 * 4, NR = GB * 32 * 8;
  for (int it = blockIdx.x; it < NB + NM + NR; it += gridDim.x) {
    if (it < NM) {
      const int hh = it & 3, tt = (it >> 2) & 31, bl = it >> 7;
      const int bgl = pass * GB + bl;
      const size_t tok = (size_t)bl * 4096 + tt * 128;
      attn_core<256, false>(p.qm() + tok * 1024 + hh * 256, p.memk() + (size_t)bgl * 256 * 1024 + hh * 256,
                            p.memvt() + (size_t)(bgl * 4 + hh) * 256 * 256, 256, 0, 4, nullptr, p.mem_q_norm_g,
                            p.mem_g(), tok, hh * 256, p.gms() + tok * 1024 + hh * 256, smem);
    } else if (it < NM + NB) {
      const int idx = it - NM;
      const int hh = idx & 7, cc = (idx >> 3) & 31, bl = idx >> 8;
      const int c0 = 2 * ((cc + 8 * bl) & 31);
      const size_t tok = (size_t)bl * 4096 + c0 * 64;
      const int u0 = c0 >= 8 ? 0 : 8 - c0;
      const u16* K0 = p.kn() + ((ptrdiff_t)bl * 4096 + (ptrdiff_t)(c0 - 8) * 64) * 1024 + hh * 128;
      const u16* V0 = p.vt() + (size_t)(bl * 8 + hh) * 128 * 4096 + (ptrdiff_t)(c0 - 8) * 64;
      attn_core<128, true>(p.qn() + tok * 1024 + hh * 128, K0, V0, 4096, u0, 10, p.rel_bias + hh * 513, nullptr,
                           p.att_g(), tok, hh * 128, p.gas() + tok * 1024 + hh * 128, smem);
    } else {
      const int idx = it - NM - NB;
      const int n = idx & 7, cp = (idx >> 3) & 31, bl = idx >> 8;
      rnn_local_item(p, bl, 2 * cp, n, smem);
    }
  }
}

DI void step_rnnfin(const Params& p, unsigned char* smem) {
  constexpr int NR = GB * 64 * 8;
  float* sP = (float*)smem;
  const int tid = get_tid(), ch = tid & 127, q = tid >> 7;
  for (int it = blockIdx.x; it < NR; it += gridDim.x) {
    const int n = it & 7, c = (it >> 3) & 63, bl = it >> 9;
    const int ch0 = n * 128;
    float Aq = 1.f, Hq = 0.f;
    {
      const float* pa = p.chA() + ((size_t)bl * 64) * 1024 + ch0 + ch;
      const float* ph = p.chH() + ((size_t)bl * 64) * 1024 + ch0 + ch;
      float av[16], hv[16];
#pragma unroll
      for (int j = 0; j < 16; ++j) {
        const int k = q * 16 + j;
        const int kk = k < c ? k : 0;
        av[j] = pa[(size_t)kk * 1024];
        hv[j] = ph[(size_t)kk * 1024];
        if (k >= c) { av[j] = 1.f; hv[j] = 0.f; }
      }
#pragma unroll
      for (int j = 0; j < 16; ++j) { Hq = Hq * av[j] + hv[j]; Aq *= av[j]; }
    }
    __syncthreads();
    sP[(q * 2 + 0) * 128 + ch] = Aq;
    sP[(q * 2 + 1) * 128 + ch] = Hq;
    __syncthreads();
    if (tid < 128) {
      float carry = 0.f;
#pragma unroll
      for (int qq = 0; qq < 4; ++qq) carry = carry * sP[(qq * 2 + 0) * 128 + ch] + sP[(qq * 2 + 1) * 128 + ch];
      sP[1024 + ch] = carry;
    }
    __syncthreads();
    {
      const int c8 = (tid & 15) * 8;
      float cr[8];
      {
        const float4 c0 = *(const float4*)(sP + 1024 + c8), c1 = *(const float4*)(sP + 1024 + c8 + 4);
        cr[0] = c0.x; cr[1] = c0.y; cr[2] = c0.z; cr[3] = c0.w; cr[4] = c1.x; cr[5] = c1.y; cr[6] = c1.z; cr[7] = c1.w;
      }
#pragma unroll
      for (int i = 0; i < 2; ++i) {
        const int row = (tid >> 4) + 32 * i;
        const size_t tokr = (size_t)bl * 4096 + c * 64 + row;
        const size_t o = tokr * 1024 + ch0 + c8;
        float hl[8], cu[8], gr[8], ov[8];
        unpack8(*(const uint4*)(p.hloc() + o), hl);
        unpack8(*(const uint4*)(p.cuma() + o), cu);
        unpack8(*(const uint4*)(p.grs() + o), gr);
#pragma unroll
        for (int e = 0; e < 8; ++e) ov[e] = (hl[e] + cu[e] * cr[e]) * gr[e];
        *(uint4*)(p.rnn_g() + ((size_t)((ch0 + c8) >> 6) * TOK + tokr) * 64 + ((ch0 + c8) & 63)) = pack8(ov);
      }
    }
  }
}

DI void step_proj(const Params& p, unsigned char* smem) {
  constexpr int MT = TOK / 256;
  u16* ytmp = p.ytmp();
  for (int t = blockIdx.x; t < MT * 4; t += gridDim.x) {
    const int mt = t % MT, nt = t / MT;
    const int wave = get_tid() >> 6, wm = wave >> 1, wn = wave & 1;
#pragma unroll 1
    for (int b = 0; b < 3; ++b) {
      const u16* A = (b == 0 ? p.rnn_g() : b == 1 ? p.att_g() : p.mem_g()) + (size_t)mt * 256 * 64;
      const u16* W = (b == 0 ? p.wt_prnn() : b == 1 ? p.wt_patt() : p.wt_pmem()) + (size_t)nt * 256 * 64;
      f32x16 acc[2][4];
      zero_acc(acc);
      gemm_kloop(A, (size_t)TOK * 64, W, (size_t)1024 * 64, 1024, acc, smem);
      wave_epilogue(acc, smem, [&](int mi, const float* sW) {
        const size_t rowbase = (size_t)mt * 256 + wm * 64 + mi * 32;
        const int cb = nt * 256 + wn * 128;
        const u16* gs = p.gsig() + rowbase * 3072 + b * 1024 + cb;
        u16* yt = ytmp + ((size_t)(t * 8 + wave) * 2 + mi) * 4096 + (get_tid() & 63) * 8;
        u16* yo = p.y();
        slab_rows(sW, [&](int row, int c, const float* v, int i_) {
          float gv[8], o[8];
          unpack8(*(const uint4*)(gs + (size_t)row * 3072 + c), gv);
          u16* yp = yt + (i_ * 2 + (c >> 6)) * 512;
          if (b == 0) {
#pragma unroll
            for (int e = 0; e < 8; ++e) o[e] = v[e] * gv[e];
          } else {
            float yv_[8];
            unpack8(*(const uint4*)yp, yv_);
#pragma unroll
            for (int e = 0; e < 8; ++e) o[e] = yv_[e] + v[e] * gv[e];
          }
          if (b < 2) {
            *(uint4*)yp = pack8(o);
          } else {
            *(uint4*)(yo + ((size_t)((cb + c) >> 6) * TOK + rowbase + row) * 64 + ((cb + c) & 63)) = pack8(o);
          }
        });
      });
    }
  }
}

DI void step_out(const Params& p, int pass, unsigned char* smem) {
  constexpr int MT = TOK / 256;
  for (int t = blockIdx.x; t < MT * 4; t += gridDim.x) {
    const int mt = t % MT, nt = t / MT;
    f32x16 acc[2][4];
    zero_acc(acc);
    gemm_kloop(p.y() + (size_t)mt * 256 * 64, (size_t)TOK * 64, p.wt_out() + (size_t)nt * 256 * 64, (size_t)1024 * 64, 1024, acc, smem);
    const int wave = get_tid() >> 6, wm = wave >> 1, wn = wave & 1;
    wave_epilogue(acc, smem, [&](int mi, const float* sW) {
      const size_t gbase = ((size_t)pass * TOK + (size_t)mt * 256 + wm * 64 + mi * 32) * 1024 + nt * 256 + wn * 128;
      const float* xs = p.x + gbase;
      float* dst = p.out + gbase;
      slab_rows(sW, [&](int row, int c, const float* v, int i_) {
        const float4 x0 = *(const float4*)(xs + (size_t)row * 1024 + c), x1 = *(const float4*)(xs + (size_t)row * 1024 + c + 4);
        float4 o0, o1;
        o0.x = x0.x + v[0]; o0.y = x0.y + v[1]; o0.z = x0.z + v[2]; o0.w = x0.w + v[3];
        o1.x = x1.x + v[4]; o1.y = x1.y + v[5]; o1.z = x1.z + v[6]; o1.w = x1.w + v[7];
        *(float4*)(dst + (size_t)row * 1024 + c) = o0;
        *(float4*)(dst + (size_t)row * 1024 + c + 4) = o1;
      });
    });
  }
}

DI void run_phase(const Params& p, int pass, int ph, bool first, unsigned char* smem) {
  if (ph == 0) step_gemm1(p, pass, first, smem);
  else if (ph == 1) step_mix(p, pass, smem);
  else if (ph == 2) step_rnnfin(p, smem);
  else if (ph == 3) step_proj(p, smem);
  else step_out(p, pass, smem);
}

__global__ void __launch_bounds__(512) mega_kernel(Params p_in) {
  __shared__ __attribute__((aligned(16))) unsigned char smem[SMEM_BYTES];
  cg::grid_group grid = cg::this_grid();
  const Params& p = p_in;
  unsigned* bar = (unsigned*)(p.ws + OFF_bar);
  unsigned nbar = 0;
  for (int step = p.step_lo; step < p.step_hi; ++step) {
    if (step == 0) step_prep(p, smem);
    else if (step == 1) step_memkv(p, smem);
    else {
      const int pass = (step - 2) / 5, ph = (step - 2) % 5;
#ifdef DUP_PH
      if (ph == DUP_PH) { run_phase(p, pass, ph, true, smem); ++nbar; fast_barrier(bar, nbar * gridDim.x); run_phase(p, pass, ph, false, smem); }
      else
#endif
      run_phase(p, pass, ph, true, smem);
    }
    if (step + 1 < p.step_hi) {
      if (p.step_hi < 0) grid.sync();
      if (step >= 2 && (step - 2) % 5 == 4) {   }
      else { ++nbar; fast_barrier(bar, nbar * gridDim.x); }
    }
  }
}

extern "C" void kernel_launch(void* const* d_in, const int* in_sizes, int n_in, void* d_out, int out_size, void* d_ws,
                              size_t ws_size, hipStream_t stream) {
  static int grid_blocks = 0;
  if (!grid_blocks) {
    int dev = 0, cus = 0, per_cu = 0;
    (void)hipGetDevice(&dev);
    (void)hipDeviceGetAttribute(&cus, hipDeviceAttributeMultiprocessorCount, dev);
    (void)hipOccupancyMaxActiveBlocksPerMultiprocessor(&per_cu, mega_kernel, 512, 0);
    if (per_cu > 1) per_cu = 1;
    if (per_cu < 1) per_cu = 1;
    grid_blocks = cus * per_cu;
  }
  Params p{};
  const float* const* in = (const float* const*)d_in;
  p.x = in[0]; p.mem = in[1]; p.norm_g = in[2]; p.mem_norm_g = in[3]; p.w_in = in[4]; p.b_merge = in[5]; p.conv_w = in[6];
  p.conv_b = in[7]; p.lru_wa = in[8]; p.lru_ba = in[9]; p.lru_wx = in[10]; p.lru_bx = in[11]; p.lru_lambda = in[12];
  p.q_norm_g = in[13]; p.k_norm_g = in[14]; p.rel_bias = in[15]; p.w_mem_kv = in[16]; p.mem_q_norm_g = in[17];
  p.mem_k_norm_g = in[18]; p.w_proj_rnn = in[19]; p.w_proj_att = in[20]; p.w_proj_mem = in[21]; p.w_out = in[22];
  p.out = (float*)d_out;
  p.ws = (unsigned char*)d_ws;
  if (WS_NEED > ws_size) { fprintf(stderr, "workspace too small: need %llu have %zu\n", WS_NEED, ws_size); return; }
  p.step_lo = 0; p.step_hi = 2 + 5 * NPASS;
  (void)hipMemsetAsync((unsigned char*)d_ws + OFF_bar, 0, 256, stream);
  void* args[] = {&p};
  hipError_t e = hipLaunchCooperativeKernel((void*)mega_kernel, dim3(grid_blocks), dim3(512), args, 0, stream);
  if (e != hipSuccess) fprintf(stderr, "cooperative launch failed: %s (grid %d)\n", hipGetErrorString(e), grid_blocks);
}
```

```cpp
#include <hip/hip_runtime.h>
#include <hip/hip_cooperative_groups.h>
#include <cstdio>
#include <cstddef>
namespace cg = cooperative_groups;

#define DI __device__ __forceinline__
typedef unsigned short u16;
using bf16x8 = __attribute__((ext_vector_type(8))) short;
using f32x4  = __attribute__((ext_vector_type(4))) float;
using f32x16 = __attribute__((ext_vector_type(16))) float;
using u32x4  = __attribute__((ext_vector_type(4))) unsigned;

constexpr int SEQ = 4096;
constexpr int GB = 4;
constexpr int NPASS = 4;
constexpr int TOK = GB * SEQ;
constexpr int SMEM_BYTES = 147456;
constexpr int T_TR = 2816 + 1024 + 512 + 64;
constexpr int T_ROWS = 8192 + 512;
constexpr float EPS = 1e-6f;

constexpr unsigned long long ACT = (unsigned long long)TOK * 1024 * 2;
constexpr unsigned long long OFF_wt_in = 0ull;
constexpr unsigned long long OFF_wt_prnn = OFF_wt_in + ((11264ull*1024*2 + 255ull) & ~255ull);
constexpr unsigned long long OFF_wt_patt = OFF_wt_prnn + ((1024ull*1024*2 + 255ull) & ~255ull);
constexpr unsigned long long OFF_wt_pmem = OFF_wt_patt + ((1024ull*1024*2 + 255ull) & ~255ull);
constexpr unsigned long long OFF_wt_out = OFF_wt_pmem + ((1024ull*1024*2 + 255ull) & ~255ull);
constexpr unsigned long long OFF_wt_memkv = OFF_wt_out + ((1024ull*1024*2 + 255ull) & ~255ull);
constexpr unsigned long long OFF_wt_a = OFF_wt_memkv + ((2048ull*1024*2 + 255ull) & ~255ull);
constexpr unsigned long long OFF_wt_x = OFF_wt_a + ((8ull*128*128*2 + 255ull) & ~255ull);
constexpr unsigned long long OFF_h = OFF_wt_x + ((8ull*128*128*2 + 255ull) & ~255ull);
constexpr unsigned long long OFF_mem_n = OFF_h + ((65536ull*1024*2 + 255ull) & ~255ull);
constexpr unsigned long long OFF_memk = OFF_mem_n + ((4096ull*1024*2 + 255ull) & ~255ull);
constexpr unsigned long long OFF_memvt = OFF_memk + ((4096ull*1024*2 + 255ull) & ~255ull);
constexpr unsigned long long OFF_xr = OFF_memvt + ((4096ull*1024*2 + 255ull) & ~255ull);
constexpr unsigned long long OFF_grs = OFF_xr + ((ACT + 255ull) & ~255ull);
constexpr unsigned long long OFF_qn = OFF_grs + ((ACT + 255ull) & ~255ull);
constexpr unsigned long long OFF_kn = OFF_qn + ((ACT + 255ull) & ~255ull);
constexpr unsigned long long OFF_vt = OFF_kn + ((ACT + 255ull) & ~255ull);
constexpr unsigned long long OFF_gas = OFF_vt + ((ACT + 255ull) & ~255ull);
constexpr unsigned long long OFF_qm = OFF_gas + ((ACT + 255ull) & ~255ull);
constexpr unsigned long long OFF_gms = OFF_qm + ((ACT + 255ull) & ~255ull);
constexpr unsigned long long OFF_gsig = OFF_gms + ((ACT + 255ull) & ~255ull);
constexpr unsigned long long OFF_hloc = OFF_gsig + ((ACT*3 + 255ull) & ~255ull);
constexpr unsigned long long OFF_cuma = OFF_hloc + ((ACT*2 + 255ull) & ~255ull);
constexpr unsigned long long OFF_chA = OFF_cuma + ((ACT*2 + 255ull) & ~255ull);
constexpr unsigned long long OFF_chH = OFF_chA + (((unsigned long long)GB*64*1024*4 + 255ull) & ~255ull);
constexpr unsigned long long OFF_rnn_g = OFF_chH + (((unsigned long long)GB*64*1024*4 + 255ull) & ~255ull);
constexpr unsigned long long OFF_att_g = OFF_rnn_g + ((ACT + 255ull) & ~255ull);
constexpr unsigned long long OFF_mem_g = OFF_att_g + ((ACT + 255ull) & ~255ull);
constexpr unsigned long long OFF_y = OFF_mem_g + ((ACT + 255ull) & ~255ull);
constexpr unsigned long long OFF_bar = OFF_y + ((ACT + 255ull) & ~255ull);
constexpr unsigned long long WS_NEED = OFF_bar + 4096ull;
DI unsigned char* oq(unsigned char* w) { asm volatile("" : "+s"(w)); return w; }
struct Params {
  const float *x, *mem, *norm_g, *mem_norm_g, *w_in, *b_merge, *conv_w, *conv_b, *lru_wa, *lru_ba, *lru_wx, *lru_bx,
      *lru_lambda, *q_norm_g, *k_norm_g, *rel_bias, *w_mem_kv, *mem_q_norm_g, *mem_k_norm_g, *w_proj_rnn, *w_proj_att,
      *w_proj_mem, *w_out;
  float* out;
  unsigned char* ws;
  int step_lo, step_hi;
  DI u16* wt_in() const { return (u16*)(ws + OFF_wt_in); }
  DI u16* wt_prnn() const { return (u16*)(ws + OFF_wt_prnn); }
  DI u16* wt_patt() const { return (u16*)(ws + OFF_wt_patt); }
  DI u16* wt_pmem() const { return (u16*)(ws + OFF_wt_pmem); }
  DI u16* wt_out() const { return (u16*)(ws + OFF_wt_out); }
  DI u16* wt_memkv() const { return (u16*)(ws + OFF_wt_memkv); }
  DI u16* wt_a() const { return (u16*)(ws + OFF_wt_a); }
  DI u16* wt_x() const { return (u16*)(ws + OFF_wt_x); }
  DI u16* h() const { return (u16*)(ws + OFF_h); }
  DI u16* mem_n() const { return (u16*)(ws + OFF_mem_n); }
  DI u16* memk() const { return (u16*)(ws + OFF_memk); }
  DI u16* memvt() const { return (u16*)(ws + OFF_memvt); }
  DI u16* xr() const { return (u16*)(ws + OFF_xr); }
  DI u16* grs() const { return (u16*)(ws + OFF_grs); }
  DI u16* qn() const { return (u16*)(ws + OFF_qn); }
  DI u16* kn() const { return (u16*)(ws + OFF_kn); }
  DI u16* vt() const { return (u16*)(ws + OFF_vt); }
  DI u16* gas() const { return (u16*)(ws + OFF_gas); }
  DI u16* qm() const { return (u16*)(ws + OFF_qm); }
  DI u16* gms() const { return (u16*)(ws + OFF_gms); }
  DI u16* gsig() const { return (u16*)(ws + OFF_gsig); }
  DI u16* hloc() const { return (u16*)(ws + OFF_hloc); }
  DI u16* ytmp() const { return (u16*)(ws + OFF_hloc); }
  DI u16* cuma() const { return (u16*)(ws + OFF_cuma); }
  DI float* chA() const { return (float*)(ws + OFF_chA); }
  DI float* chH() const { return (float*)(ws + OFF_chH); }
  DI u16* rnn_g() const { return (u16*)(ws + OFF_rnn_g); }
  DI u16* att_g() const { return (u16*)(ws + OFF_att_g); }
  DI u16* mem_g() const { return (u16*)(ws + OFF_mem_g); }
  DI u16* y() const { return (u16*)(ws + OFF_y); }
};

#define XB_XCNT(j) (32 * (1 + (j)))
#define XB_XSUB(j) (32 * (9 + (j)))
#define XB_XGEN(j) (32 * (17 + (j)))
#define XB_TOP (32 * 25)
#define XB_TOPGEN (32 * 26)
DI unsigned xb_ld(unsigned* p) { return __hip_atomic_load(p, __ATOMIC_RELAXED, __HIP_MEMORY_SCOPE_AGENT); }
DI unsigned xb_add(unsigned* p, unsigned v) { return __hip_atomic_fetch_add(p, v, __ATOMIC_RELAXED, __HIP_MEMORY_SCOPE_AGENT); }
DI void xcd_barrier(unsigned* bar, unsigned xcc, volatile unsigned* st) {
  asm volatile("s_waitcnt vmcnt(0)" ::: "memory");
  __syncthreads();
  if (__builtin_amdgcn_workitem_id_x() == 0) {
    unsigned nloc = st[0], nx = st[1];
    if (nloc == 0u) {
      const unsigned G = gridDim.x;
      unsigned sp = 0;
      for (;;) {
        unsigned sum = 0, cnt = 0, mine = 0;
        for (unsigned j = 0; j < 8; ++j) { const unsigned c = xb_ld(bar + XB_XCNT(j)); sum += c; cnt += c > 0u ? 1u : 0u; mine = j == xcc ? c : mine; }
        nloc = mine; nx = cnt;
        if (sum == G) break;
        __builtin_amdgcn_s_sleep(1);
        if (++sp > (1u << 22)) break;
      }
      if (nloc == 0u) nloc = 1u;
      if (nx == 0u) nx = 1u;
      st[0] = nloc; st[1] = nx;
    }
    const unsigned old = xb_add(bar + XB_XSUB(xcc), 1u);
    const unsigned gen = old / nloc;
    if (old + 1u == (gen + 1u) * nloc) {
      __builtin_amdgcn_fence(__ATOMIC_RELEASE, "agent");
      asm volatile("s_waitcnt vmcnt(0)" ::: "memory");
      const unsigned og = xb_add(bar + XB_TOP, 1u);
      const unsigned tg = og / nx;
      if (og + 1u == (tg + 1u) * nx) (void)xb_add(bar + XB_TOPGEN, 1u);
      else { unsigned sp = 0; while (xb_ld(bar + XB_TOPGEN) == tg) { __builtin_amdgcn_s_sleep(1); if (++sp > (1u << 24)) break; } }
      __builtin_amdgcn_fence(__ATOMIC_ACQUIRE, "agent");
      (void)xb_add(bar + XB_XGEN(xcc), 1u);
      asm volatile("s_waitcnt vmcnt(0)" ::: "memory");
    } else {
      unsigned sp = 0;
      while (xb_ld(bar + XB_XGEN(xcc)) == gen) { __builtin_amdgcn_s_sleep(1); if (++sp > (1u << 24)) break; }
      __builtin_amdgcn_fence(__ATOMIC_ACQUIRE, "agent");
      asm volatile("s_waitcnt vmcnt(0)" ::: "memory");
    }
  }
  __syncthreads();
}
DI int get_tid() { int t = __builtin_amdgcn_workitem_id_x(); asm volatile("" : "+v"(t)); return t; }
typedef float f32x2_t __attribute__((ext_vector_type(2)));
typedef __bf16 bf16x2_t __attribute__((ext_vector_type(2)));
DI unsigned pack2(float a, float b) { f32x2_t v = {a, b}; return __builtin_bit_cast(unsigned, __builtin_convertvector(v, bf16x2_t)); }
DI u16 f2bf(float x) { return (u16)(pack2(x, x) & 0xffffu); }
DI float bf2f(u16 b) { return __uint_as_float(((unsigned)b) << 16); }
DI float sigm(float v) { return __builtin_amdgcn_rcpf(1.f + __builtin_amdgcn_exp2f(-1.4426950408889634f * v)); }
DI float silu(float v) { return v * sigm(v); }
DI uint4 pack8(const float* v) { uint4 r; r.x = pack2(v[0], v[1]); r.y = pack2(v[2], v[3]); r.z = pack2(v[4], v[5]); r.w = pack2(v[6], v[7]); return r; }
DI void unpack8(uint4 r, float* v) {
  v[0] = __uint_as_float(r.x << 16); v[1] = __uint_as_float(r.x & 0xffff0000u);
  v[2] = __uint_as_float(r.y << 16); v[3] = __uint_as_float(r.y & 0xffff0000u);
  v[4] = __uint_as_float(r.z << 16); v[5] = __uint_as_float(r.z & 0xffff0000u);
  v[6] = __uint_as_float(r.w << 16); v[7] = __uint_as_float(r.w & 0xffff0000u);
}

template <bool PANEL>
DI void transpose_tile(const float* __restrict__ src, int R, int C, u16* __restrict__ dst, int tr, int tc, float* tile) {
  const int tid = get_tid();
  __syncthreads();
#pragma unroll
  for (int i = 0; i < 2; ++i) {
    const int r = (tid >> 4) + 32 * i, c4 = (tid & 15) * 4;
    const float4 v = *(const float4*)(src + (size_t)(tr * 64 + r) * C + tc * 64 + c4);
    tile[r * 65 + c4 + 0] = v.x; tile[r * 65 + c4 + 1] = v.y; tile[r * 65 + c4 + 2] = v.z; tile[r * 65 + c4 + 3] = v.w;
  }
  __syncthreads();
  {
    const int c = tid >> 3, r8 = (tid & 7) * 8;
    float v[8];
#pragma unroll
    for (int j = 0; j < 8; ++j) v[j] = tile[(r8 + j) * 65 + c];
    if (PANEL) *(uint4*)(dst + ((size_t)tr * C + tc * 64 + c) * 64 + r8) = pack8(v);
    else *(uint4*)(dst + (size_t)(tc * 64 + c) * R + tr * 64 + r8) = pack8(v);
  }
}

DI void rms_row(const float* __restrict__ src, const float* __restrict__ g, u16* __restrict__ dst, size_t ROWS, size_t r) {
  const int lane = get_tid() & 63;
  float4 v[4];
  float ss = 0.f;
#pragma unroll
  for (int i = 0; i < 4; ++i) {
    v[i] = *(const float4*)(src + i * 256 + lane * 4);
    ss += v[i].x * v[i].x + v[i].y * v[i].y + v[i].z * v[i].z + v[i].w * v[i].w;
  }
#pragma unroll
  for (int o = 32; o >= 1; o >>= 1) ss += __shfl_xor(ss, o);
  const float rstd = rsqrtf(ss * (1.f / 1024.f) + EPS);
#pragma unroll
  for (int i = 0; i < 4; ++i) {
    const float4 gg = *(const float4*)(g + i * 256 + lane * 4);
    uint2 o;
    o.x = pack2(v[i].x * rstd * gg.x, v[i].y * rstd * gg.y);
    o.y = pack2(v[i].z * rstd * gg.z, v[i].w * rstd * gg.w);
    *(uint2*)(dst + ((size_t)(i * 4 + (lane >> 4)) * ROWS + r) * 64 + (lane & 15) * 4) = o;
  }
}

DI void step_prep(const Params& p, unsigned char* smem) {
  float* tile = (float*)smem;
  for (int it = blockIdx.x; it < T_TR + T_ROWS; it += gridDim.x) {
    if (it < T_TR) {
      int j = it;
      if (j < 2816) { transpose_tile<true>(p.w_in, 1024, 11264, p.wt_in(), j % 16, j / 16, tile); continue; }
      j -= 2816;
      if (j < 1024) {
        const int k = j >> 8, jj = j & 255;
        const float* s = k == 0 ? p.w_proj_rnn : k == 1 ? p.w_proj_att : k == 2 ? p.w_proj_mem : p.w_out;
        u16* d = k == 0 ? p.wt_prnn() : k == 1 ? p.wt_patt() : k == 2 ? p.wt_pmem() : p.wt_out();
        transpose_tile<true>(s, 1024, 1024, d, jj % 16, jj / 16, tile);
        continue;
      }
      j -= 1024;
      if (j < 512) { transpose_tile<true>(p.w_mem_kv, 1024, 2048, p.wt_memkv(), j % 16, j / 16, tile); continue; }
      j -= 512;
      {
        const int mat = j >> 5, jj = j & 31, n = jj >> 2, tr = (jj >> 1) & 1, tc = jj & 1;
        transpose_tile<false>((mat ? p.lru_wx : p.lru_wa) + n * 16384, 128, 128, (mat ? p.wt_x() : p.wt_a()) + n * 16384, tr, tc, tile);
      }
    } else {
      const int r = (it - T_TR) * 8 + (get_tid() >> 6);
      if (r < 65536) rms_row(p.x + (size_t)r * 1024, p.norm_g, p.h(), 65536, r);
      else { const int m = r - 65536; rms_row(p.mem + (size_t)m * 1024, p.mem_norm_g, p.mem_n(), 4096, m); }
    }
  }
}

DI void zero_acc(f32x16 (&acc)[2][4]) {
#pragma unroll
  for (int a = 0; a < 2; ++a)
#pragma unroll
    for (int b = 0; b < 4; ++b)
#pragma unroll
      for (int r = 0; r < 16; ++r) acc[a][b][r] = 0.f;
}

DI void gemm_kloop(const u16* __restrict__ A, size_t aks, const u16* __restrict__ Bt, size_t bks, int K, f32x16 (&acc)[2][4],
                   unsigned char* smem) {
  u16* sA = (u16*)smem;
  const int tid = get_tid(), lane = tid & 63, wave = tid >> 6, wm = wave >> 1, wn = wave & 1;
  const int lr = tid >> 3, lc = (tid & 7) * 8;
  const u16* ga = A + (size_t)lr * 64 + lc;
  const u16* gb = Bt + (size_t)lr * 64 + lc;
  constexpr size_t sa64 = 4096, sb64 = 4096;
  u32x4 ra0 = *(const u32x4*)(ga), ra1 = *(const u32x4*)(ga + sa64), ra2 = *(const u32x4*)(ga + 2 * sa64), ra3 = *(const u32x4*)(ga + 3 * sa64);
  u32x4 rb0 = *(const u32x4*)(gb), rb1 = *(const u32x4*)(gb + sb64), rb2 = *(const u32x4*)(gb + 2 * sb64), rb3 = *(const u32x4*)(gb + 3 * sb64);
  const int nk = K >> 6;
  const int pa_off = (wm * 64 + (lane & 31)) * 72 + (lane >> 5) * 8;
  const int pb_off = 18432 + (wn * 128 + (lane & 31)) * 72 + (lane >> 5) * 8;
  const int wa_off = lr * 72 + lc;
  const int wb_off = 18432 + lr * 72 + lc;
  __syncthreads();
  {
    u16* d = sA + wa_off;
    *(u32x4*)(d) = ra0; *(u32x4*)(d + 64 * 72) = ra1; *(u32x4*)(d + 128 * 72) = ra2; *(u32x4*)(d + 192 * 72) = ra3;
    d = sA + wb_off;
    *(u32x4*)(d) = rb0; *(u32x4*)(d + 64 * 72) = rb1; *(u32x4*)(d + 128 * 72) = rb2; *(u32x4*)(d + 192 * 72) = rb3;
  }
  if (nk > 1) {
    ga += aks; gb += bks;
    ra0 = *(const u32x4*)(ga); ra1 = *(const u32x4*)(ga + sa64); ra2 = *(const u32x4*)(ga + 2 * sa64); ra3 = *(const u32x4*)(ga + 3 * sa64);
    rb0 = *(const u32x4*)(gb); rb1 = *(const u32x4*)(gb + sb64); rb2 = *(const u32x4*)(gb + 2 * sb64); rb3 = *(const u32x4*)(gb + 3 * sb64);
  }
  __syncthreads();
  for (int kt = 0; kt < nk; ++kt) {
    const int cur = (kt & 1) * 36864, nxt = 36864 - cur;
    const bool wr = kt + 1 < nk, ld = kt + 2 < nk;
    if (ld) { ga += aks; gb += bks; }
    const u16* pa = sA + cur + pa_off;
    const u16* pb = sA + cur + pb_off;
    u16* da = sA + nxt + wa_off;
    u16* db = sA + nxt + wb_off;
#pragma unroll
    for (int s = 0; s < 4; ++s) {
      if (wr) {
        if (s == 0) { *(u32x4*)(da) = ra0; *(u32x4*)(da + 64 * 72) = ra1; }
        if (s == 1) { *(u32x4*)(da + 128 * 72) = ra2; *(u32x4*)(da + 192 * 72) = ra3; }
        if (s == 2) { *(u32x4*)(db) = rb0; *(u32x4*)(db + 64 * 72) = rb1; }
        if (s == 3) { *(u32x4*)(db + 128 * 72) = rb2; *(u32x4*)(db + 192 * 72) = rb3; }
      }
      if (ld) {
        if (s == 0) { ra0 = *(const u32x4*)(ga); ra1 = *(const u32x4*)(ga + sa64); }
        if (s == 1) { ra2 = *(const u32x4*)(ga + 2 * sa64); ra3 = *(const u32x4*)(ga + 3 * sa64); }
        if (s == 2) { rb0 = *(const u32x4*)(gb); rb1 = *(const u32x4*)(gb + sb64); }
        if (s == 3) { rb2 = *(const u32x4*)(gb + 2 * sb64); rb3 = *(const u32x4*)(gb + 3 * sb64); }
      }
      const bf16x8 a0 = *(const bf16x8*)(pa + s * 16);
      const bf16x8 a1 = *(const bf16x8*)(pa + 32 * 72 + s * 16);
      const bf16x8 b0 = *(const bf16x8*)(pb + s * 16);
      const bf16x8 b1 = *(const bf16x8*)(pb + 32 * 72 + s * 16);
      const bf16x8 b2 = *(const bf16x8*)(pb + 64 * 72 + s * 16);
      const bf16x8 b3 = *(const bf16x8*)(pb + 96 * 72 + s * 16);
      acc[0][0] = __builtin_amdgcn_mfma_f32_32x32x16_bf16(a0, b0, acc[0][0], 0, 0, 0);
      acc[0][1] = __builtin_amdgcn_mfma_f32_32x32x16_bf16(a0, b1, acc[0][1], 0, 0, 0);
      acc[0][2] = __builtin_amdgcn_mfma_f32_32x32x16_bf16(a0, b2, acc[0][2], 0, 0, 0);
      acc[0][3] = __builtin_amdgcn_mfma_f32_32x32x16_bf16(a0, b3, acc[0][3], 0, 0, 0);
      acc[1][0] = __builtin_amdgcn_mfma_f32_32x32x16_bf16(a1, b0, acc[1][0], 0, 0, 0);
      acc[1][1] = __builtin_amdgcn_mfma_f32_32x32x16_bf16(a1, b1, acc[1][1], 0, 0, 0);
      acc[1][2] = __builtin_amdgcn_mfma_f32_32x32x16_bf16(a1, b2, acc[1][2], 0, 0, 0);
      acc[1][3] = __builtin_amdgcn_mfma_f32_32x32x16_bf16(a1, b3, acc[1][3], 0, 0, 0);
      __builtin_amdgcn_sched_barrier(0);
    }
    __syncthreads();
  }
}

template <typename F>
DI void wave_epilogue(const f32x16 (&acc)[2][4], unsigned char* smem, F f) {
  const int tid = get_tid(), lane = tid & 63, wave = tid >> 6;
  float* sW = (float*)smem + wave * (32 * 132);
#pragma unroll
  for (int mi = 0; mi < 2; ++mi) {
#pragma unroll
    for (int ni = 0; ni < 4; ++ni)
#pragma unroll
      for (int r = 0; r < 16; ++r) {
        const int row = (r & 3) + 8 * (r >> 2) + 4 * (lane >> 5);
        sW[row * 132 + ni * 32 + (lane & 31)] = acc[mi][ni][r];
      }
    __builtin_amdgcn_fence(__ATOMIC_RELEASE, "wavefront");
    __builtin_amdgcn_fence(__ATOMIC_ACQUIRE, "wavefront");
    f(mi, sW);
    __builtin_amdgcn_fence(__ATOMIC_RELEASE, "wavefront");
    __builtin_amdgcn_fence(__ATOMIC_ACQUIRE, "wavefront");
  }
}

template <typename P, typename F>
DI void wave_epilogue_pre(const f32x16 (&acc)[2][4], unsigned char* smem, P pre, F f) {
  const int tid = get_tid(), lane = tid & 63, wave = tid >> 6;
  float* sW = (float*)smem + wave * (32 * 132);
#pragma unroll
  for (int mi = 0; mi < 2; ++mi) {
    pre(mi);
#pragma unroll
    for (int ni = 0; ni < 4; ++ni)
#pragma unroll
      for (int r = 0; r < 16; ++r) {
        const int row = (r & 3) + 8 * (r >> 2) + 4 * (lane >> 5);
        sW[row * 132 + ni * 32 + (lane & 31)] = acc[mi][ni][r];
      }
    __builtin_amdgcn_fence(__ATOMIC_RELEASE, "wavefront");
    __builtin_amdgcn_fence(__ATOMIC_ACQUIRE, "wavefront");
    f(mi, sW);
    __builtin_amdgcn_fence(__ATOMIC_RELEASE, "wavefront");
    __builtin_amdgcn_fence(__ATOMIC_ACQUIRE, "wavefront");
  }
}

template <typename F>
DI void slab_rows(const float* sW, F f) {
  const int lane = get_tid() & 63, rsub = lane >> 3, chunk = lane & 7;
#pragma unroll
  for (int i = 0; i < 4; ++i)
#pragma unroll
    for (int hf = 0; hf < 2; ++hf) {
      const int row = i * 8 + rsub, c = hf * 64 + chunk * 8;
      float v[8];
      const float4 a = *(const float4*)(sW + row * 132 + c), b = *(const float4*)(sW + row * 132 + c + 4);
      v[0] = a.x; v[1] = a.y; v[2] = a.z; v[3] = a.w; v[4] = b.x; v[5] = b.y; v[6] = b.z; v[7] = b.w;
      f(row, c, v, i);
    }
}

DI void slab_store_transposed(const float* sW, u16* __restrict__ dst, size_t ldd) {
  const int lane = get_tid() & 63;
#pragma unroll
  for (int dd = 0; dd < 2; ++dd)
#pragma unroll
    for (int j = 0; j < 4; ++j) {
      const int d = lane + 64 * dd;
      float v[8];
#pragma unroll
      for (int e = 0; e < 8; ++e) v[e] = sW[(j * 8 + e) * 132 + d];
      *(uint4*)(dst + (size_t)d * ldd + j * 8) = pack8(v);
    }
}

DI void step_memkv(const Params& p, unsigned char* smem) {
  for (int t = blockIdx.x; t < 16 * 8; t += gridDim.x) {
    const int mt = t % 16, nt = t / 16;
    f32x16 acc[2][4];
    zero_acc(acc);
    gemm_kloop(p.mem_n() + (size_t)mt * 256 * 64, (size_t)4096 * 64, p.wt_memkv() + (size_t)nt * 256 * 64, (size_t)2048 * 64, 1024, acc, smem);
    const int wave = get_tid() >> 6, wm = wave >> 1, wn = wave & 1;
    wave_epilogue(acc, smem, [&](int mi, const float* sW) {
      const int r0 = wm * 64 + mi * 32;
      if (nt < 4) {
        u16* dst = p.memk() + ((size_t)mt * 256 + r0) * 1024 + nt * 256 + wn * 128;
        slab_rows(sW, [&](int row, int c, const float* v, int i_) { *(uint4*)(dst + (size_t)row * 1024 + c) = pack8(v); });
      } else {
        const int hh = nt - 4;
        slab_store_transposed(sW, p.memvt() + ((size_t)(mt * 4 + hh) * 256 + wn * 128) * 256 + r0, 256);
      }
    });
  }
}

DI void memk_norm_row(const Params& p, int row) {
  const int lane = get_tid() & 63;
  u16* ptr = p.memk() + (size_t)row * 1024 + lane * 16;
  float v[16];
  unpack8(*(const uint4*)ptr, v);
  unpack8(*(const uint4*)(ptr + 8), v + 8);
  float ss = 0.f;
#pragma unroll
  for (int e = 0; e < 16; ++e) ss += v[e] * v[e];
#pragma unroll
  for (int o = 1; o <= 8; o <<= 1) ss += __shfl_xor(ss, o);
  const float sc = rsqrtf(ss * (1.f / 256.f) + EPS);
  const float* g = p.mem_k_norm_g + (lane & 15) * 16;
#pragma unroll
  for (int e = 0; e < 16; ++e) v[e] *= sc * g[e];
  *(uint4*)ptr = pack8(v);
  *(uint4*)(ptr + 8) = pack8(v + 8);
}

DI void step_gemm1(const Params& p, int pass, bool first, unsigned char* smem) {
  if (pass == 0 && first) {
    for (int it = blockIdx.x; it < 512; it += gridDim.x) memk_norm_row(p, it * 8 + (get_tid() >> 6));
  }
  const u16* A = p.h() + (size_t)pass * TOK * 64;
  constexpr int MT = TOK / 256;
  for (int t = blockIdx.x; t < MT * 44; t += gridDim.x) {
    const int mt = t % MT, nt = t / MT;
    f32x16 acc[2][4];
    zero_acc(acc);
    gemm_kloop(A + (size_t)mt * 256 * 64, (size_t)65536 * 64, p.wt_in() + (size_t)nt * 256 * 64, (size_t)11264 * 64, 1024, acc, smem);
    const int wave = get_tid() >> 6, wm = wave >> 1, wn = wave & 1;
    const int seg = nt >> 2, cb = (nt & 3) * 256 + wn * 128;
    wave_epilogue(acc, smem, [&](int mi, const float* sW) {
      const size_t rowbase = (size_t)mt * 256 + wm * 64 + mi * 32;
      if (seg == 0 || seg == 6) {
        u16* dst = (seg == 0 ? p.xr() : p.qm()) + rowbase * 1024 + cb;
        slab_rows(sW, [&](int row, int c, const float* v, int i_) { *(uint4*)(dst + (size_t)row * 1024 + c) = pack8(v); });
      } else if (seg == 1 || seg == 5 || seg == 7) {
        u16* dst = (seg == 1 ? p.grs() : seg == 5 ? p.gas() : p.gms()) + rowbase * 1024 + cb;
        slab_rows(sW, [&](int row, int c, const float* v, int i_) {
          float o[8];
#pragma unroll
          for (int e = 0; e < 8; ++e) o[e] = silu(v[e]);
          *(uint4*)(dst + (size_t)row * 1024 + c) = pack8(o);
        });
      } else if (seg == 2 || seg == 3) {
        float ss[4] = {0.f, 0.f, 0.f, 0.f};
        slab_rows(sW, [&](int row, int c, const float* v, int i_) {
#pragma unroll
          for (int e = 0; e < 8; ++e) ss[i_] += v[e] * v[e];
        });
        float sc[4];
#pragma unroll
        for (int q_ = 0; q_ < 4; ++q_) {
          float t_ = ss[q_];
          t_ += __shfl_xor(t_, 1); t_ += __shfl_xor(t_, 2); t_ += __shfl_xor(t_, 4);
          sc[q_] = rsqrtf(t_ * (1.f / 128.f) + EPS) * (seg == 2 ? 0.08838834764831845f * 1.4426950408889634f : 1.f);
        }
        const float* g = seg == 2 ? p.q_norm_g : p.k_norm_g;
        float4 gq_[2][2];
        { const int ch_ = (get_tid() & 7) * 8; gq_[0][0] = *(const float4*)(g + ch_); gq_[0][1] = *(const float4*)(g + ch_ + 4); gq_[1][0] = *(const float4*)(g + 64 + ch_); gq_[1][1] = *(const float4*)(g + 64 + ch_ + 4); }
        u16* dst = (seg == 2 ? p.qn() : p.kn()) + rowbase * 1024 + cb;
        slab_rows(sW, [&](int row, int c, const float* v, int i_) {
          float o[8];
          const float4 g0 = gq_[c >> 6][0], g1 = gq_[c >> 6][1];
          const float s_ = sc[i_];
          o[0] = v[0] * s_ * g0.x; o[1] = v[1] * s_ * g0.y; o[2] = v[2] * s_ * g0.z; o[3] = v[3] * s_ * g0.w;
          o[4] = v[4] * s_ * g1.x; o[5] = v[5] * s_ * g1.y; o[6] = v[6] * s_ * g1.z; o[7] = v[7] * s_ * g1.w;
          *(uint4*)(dst + (size_t)row * 1024 + c) = pack8(o);
        });
      } else if (seg == 4) {
        const int bl = mt >> 4, s0 = (mt & 15) * 256 + wm * 64 + mi * 32, hh = cb >> 7;
        slab_store_transposed(sW, p.vt() + (size_t)(bl * 8 + hh) * 128 * 4096 + s0, 4096);
      } else {
        const int gc = (nt - 32) * 256 + wn * 128;
        const float* bm = p.b_merge + gc;
        float4 bq_[2][2];
        { const int ch_ = (get_tid() & 7) * 8; bq_[0][0] = *(const float4*)(bm + ch_); bq_[0][1] = *(const float4*)(bm + ch_ + 4); bq_[1][0] = *(const float4*)(bm + 64 + ch_); bq_[1][1] = *(const float4*)(bm + 64 + ch_ + 4); }
        u16* dst = p.gsig() + rowbase * 3072 + gc;
        slab_rows(sW, [&](int row, int c, const float* v, int i_) {
          float o[8];
          const float4 b0 = bq_[c >> 6][0], b1 = bq_[c >> 6][1];
          o[0] = sigm(v[0] + b0.x); o[1] = sigm(v[1] + b0.y); o[2] = sigm(v[2] + b0.z); o[3] = sigm(v[3] + b0.w);
          o[4] = sigm(v[4] + b1.x); o[5] = sigm(v[5] + b1.y); o[6] = sigm(v[6] + b1.z); o[7] = sigm(v[7] + b1.w);
          *(uint4*)(dst + (size_t)row * 3072 + c) = pack8(o);
        });
      }
    });
  }
}

template <int HD, bool BAND>
DI void attn_core(const u16* __restrict__ Q, const u16* __restrict__ K, const u16* __restrict__ Vt, int ldv, int u0, int u1,
                  const float* __restrict__ bias_row, const float* __restrict__ qg,
                  u16* __restrict__ Out, size_t orow0, int okb, const u16* __restrict__ Gate, unsigned char* smem) {
  constexpr int KS = HD / 32, DB = HD / 16, LDK = HD + 8, NCH = HD / 64;
  u16* sK = (u16*)smem;
  u16* sV = (u16*)(smem + 64 * LDK * 2);
  float* sBias = (float*)(smem + 64 * LDK * 2 + HD * 72 * 2);
  const int tid = get_tid(), lane = tid & 63, w = tid >> 6, l15 = lane & 15, g = lane >> 4, sb = w >> 2, wq = w & 3;
  __syncthreads();
  if (BAND) { for (int i = tid; i < 513; i += 512) sBias[i] = bias_row[i] * 1.4426950408889634f; }
  const float bias_far = BAND ? bias_row[512] * 1.4426950408889634f : 0.f;
  bf16x8 qf[KS];
  {
    const u16* qrow = Q + (size_t)(w * 16 + l15) * 1024 + g * 8;
#pragma unroll
    for (int ks = 0; ks < KS; ++ks) qf[ks] = *(const bf16x8*)(qrow + ks * 32);
    if (!BAND) {
      float ss = 0.f;
#pragma unroll
      for (int ks = 0; ks < KS; ++ks) {
        float v[8];
        unpack8(__builtin_bit_cast(uint4, qf[ks]), v);
#pragma unroll
        for (int e = 0; e < 8; ++e) ss += v[e] * v[e];
      }
      ss += __shfl_xor(ss, 16);
      ss += __shfl_xor(ss, 32);
      const float sc = rsqrtf(ss * (1.f / HD) + EPS) * (0.0625f * 1.4426950408889634f);
#pragma unroll
      for (int ks = 0; ks < KS; ++ks) {
        float v[8];
        unpack8(__builtin_bit_cast(uint4, qf[ks]), v);
        const float4 g0 = *(const float4*)(qg + ks * 32 + g * 8), g1 = *(const float4*)(qg + ks * 32 + g * 8 + 4);
        v[0] *= sc * g0.x; v[1] *= sc * g0.y; v[2] *= sc * g0.z; v[3] *= sc * g0.w;
        v[4] *= sc * g1.x; v[5] *= sc * g1.y; v[6] *= sc * g1.z; v[7] *= sc * g1.w;
        qf[ks] = __builtin_bit_cast(bf16x8, pack8(v));
      }
    }
  }
  f32x4 o[DB];
#pragma unroll
  for (int db = 0; db < DB; ++db) o[db] = f32x4{0.f, 0.f, 0.f, 0.f};
  float m = -1e30f, lsum = 0.f;

  const int krow = tid >> 3, kpart = (tid & 7) * (HD / 8);
  u32x4 rkA[NCH], rvA[NCH], rkB[HD == 128 ? NCH : 1], rvB[HD == 128 ? NCH : 1];
  auto load_tile = [&](int u, auto& rk, auto& rv) {
    const u16* ksrc = K + ((size_t)u * 64 + krow) * 1024 + kpart;
#pragma unroll
    for (int i = 0; i < NCH; ++i) rk[i] = *(const u32x4*)(ksrc + i * 8);
#pragma unroll
    for (int i = 0; i < NCH; ++i) {
      const int id = tid + 512 * i, d = id >> 3, cc = id & 7;
      rv[i] = *(const u32x4*)(Vt + (size_t)d * ldv + u * 64 + cc * 8);
    }
  };
  auto store_tile = [&](const auto& rk, const auto& rv) {
#pragma unroll
    for (int i = 0; i < NCH; ++i) *(u32x4*)(sK + krow * LDK + kpart + i * 8) = rk[i];
#pragma unroll
    for (int i = 0; i < NCH; ++i) {
      const int id = tid + 512 * i, d = id >> 3, cc = id & 7;
      *(u32x4*)(sV + d * 72 + cc * 8) = rv[i];
    }
  };
  auto compute_tile = [&](int u) {
    if (BAND && (u < sb || u > sb + 8)) return;
    f32x4 s[4];
#pragma unroll
    for (int kb = 0; kb < 4; ++kb) {
      s[kb] = f32x4{0.f, 0.f, 0.f, 0.f};
#pragma unroll
      for (int ks = 0; ks < KS; ++ks) {
        const bf16x8 kf = *(const bf16x8*)(sK + (kb * 16 + l15) * LDK + ks * 32 + g * 8);
        s[kb] = __builtin_amdgcn_mfma_f32_16x16x32_bf16(kf, qf[ks], s[kb], 0, 0, 0);
      }
      if (HD > 128) __builtin_amdgcn_sched_barrier(0);
    }
    float mx = -1e30f;
    if (BAND) {
      if ((8 + sb - u) * 64 - 63 >= 256) {
#pragma unroll
        for (int kb = 0; kb < 4; ++kb)
#pragma unroll
          for (int i = 0; i < 4; ++i) s[kb][i] += bias_far;
      } else {
        const int dbase = (8 + sb - u) * 64 + (wq * 16 + l15) - g * 4 + 256;
#pragma unroll
        for (int kb = 0; kb < 4; ++kb)
#pragma unroll
          for (int i = 0; i < 4; ++i) s[kb][i] += sBias[min(dbase - (kb * 16 + i), 512)];
      }
    }
#pragma unroll
    for (int kb = 0; kb < 4; ++kb)
#pragma unroll
      for (int i = 0; i < 4; ++i) mx = fmaxf(mx, s[kb][i]);
    mx = fmaxf(mx, __shfl_xor(mx, 16));
    mx = fmaxf(mx, __shfl_xor(mx, 32));
    const float mn = fmaxf(m, mx);
    const float alpha = __builtin_amdgcn_exp2f(m - mn);
    m = mn;
    lsum *= alpha;
#pragma unroll
    for (int db = 0; db < DB; ++db) { o[db][0] *= alpha; o[db][1] *= alpha; o[db][2] *= alpha; o[db][3] *= alpha; }
    bf16x8 pf[2];
#pragma unroll
    for (int k2 = 0; k2 < 2; ++k2) {
      float pv[8];
#pragma unroll
      for (int i = 0; i < 4; ++i) {
        pv[i] = __builtin_amdgcn_exp2f(s[2 * k2][i] - mn);
        pv[4 + i] = __builtin_amdgcn_exp2f(s[2 * k2 + 1][i] - mn);
      }
#pragma unroll
      for (int e = 0; e < 8; ++e) lsum += pv[e];
      pf[k2] = __builtin_bit_cast(bf16x8, pack8(pv));
    }
#pragma unroll
    for (int db = 0; db < DB; ++db) {
#pragma unroll
      for (int k2 = 0; k2 < 2; ++k2) {
        const u16* vp = sV + (db * 16 + l15) * 72 + k2 * 32 + g * 4;
        const uint2 lo = *(const uint2*)vp, hi = *(const uint2*)(vp + 16);
        uint4 vv; vv.x = lo.x; vv.y = lo.y; vv.z = hi.x; vv.w = hi.y;
        o[db] = __builtin_amdgcn_mfma_f32_16x16x32_bf16(__builtin_bit_cast(bf16x8, vv), pf[k2], o[db], 0, 0, 0);
      }
      if (HD > 128 && (db & 3) == 3) __builtin_amdgcn_sched_barrier(0);
    }
  };
  load_tile(u0, rkA, rvA);
  if (HD == 128) {
    if (u0 + 1 < u1) load_tile(u0 + 1, rkB, rvB);
    for (int u = u0; u < u1; u += 2) {
      __syncthreads();
      store_tile(rkA, rvA);
      __syncthreads();
      if (u + 2 < u1) load_tile(u + 2, rkA, rvA);
      compute_tile(u);
      if (u + 1 < u1) {
        __syncthreads();
        store_tile(rkB, rvB);
        __syncthreads();
        if (u + 3 < u1) load_tile(u + 3, rkB, rvB);
        compute_tile(u + 1);
      }
    }
  } else {
    for (int u = u0; u < u1; ++u) {
      __syncthreads();
      store_tile(rkA, rvA);
      __syncthreads();
      if (u + 1 < u1) load_tile(u + 1, rkA, rvA);
      compute_tile(u);
    }
  }
  lsum += __shfl_xor(lsum, 16);
  lsum += __shfl_xor(lsum, 32);
  const float inv = 1.f / lsum;
  {
    const size_t ro = (size_t)(w * 16 + l15) * 1024 + g * 4;
    uint2 gall[DB];
#pragma unroll
    for (int db = 0; db < DB; ++db) gall[db] = *(const uint2*)(Gate + ro + db * 16);
#pragma unroll
    for (int db = 0; db < DB; ++db) {
      const uint2 gv = gall[db];
      uint2 ov;
      ov.x = pack2(o[db][0] * inv * __uint_as_float(gv.x << 16), o[db][1] * inv * __uint_as_float(gv.x & 0xffff0000u));
      ov.y = pack2(o[db][2] * inv * __uint_as_float(gv.y << 16), o[db][3] * inv * __uint_as_float(gv.y & 0xffff0000u));
      *(uint2*)(Out + ((size_t)((okb >> 6) + (db >> 2)) * TOK + orow0 + w * 16 + l15) * 64 + (db & 3) * 16 + g * 4) = ov;
    }
  }
}

DI void band_core(const u16* __restrict__ Q, const u16* __restrict__ K, const u16* __restrict__ Vt, int u0,
                  const float* __restrict__ bias_row, u16* __restrict__ Out, size_t orow0, int okb, const u16* __restrict__ Gate,
                  unsigned char* smem) {
  constexpr int HD = 128, KS = 4, DB = 8, LDK = HD + 8, NCH = 2, U1 = 12;
  u16* sK = (u16*)smem;
  u16* sV = (u16*)(smem + 64 * LDK * 2);
  float* sBias = (float*)(smem + 64 * LDK * 2 + HD * 72 * 2);
  const int tid = get_tid(), lane = tid & 63, w = tid >> 6, l15 = lane & 15, g = lane >> 4, sbq = w >> 1, wh = w & 1;
  __syncthreads();
  for (int i = tid; i < 513; i += 512) sBias[i] = bias_row[i] * 1.4426950408889634f;
  const float bias_far = bias_row[512] * 1.4426950408889634f;
  bf16x8 qf[2][KS];
#pragma unroll
  for (int qb = 0; qb < 2; ++qb) {
    const u16* qrow = Q + (size_t)(w * 32 + qb * 16 + l15) * 1024 + g * 8;
#pragma unroll
    for (int ks = 0; ks < KS; ++ks) qf[qb][ks] = *(const bf16x8*)(qrow + ks * 32);
  }
  f32x4 o[2][DB];
#pragma unroll
  for (int qb = 0; qb < 2; ++qb)
#pragma unroll
    for (int db = 0; db < DB; ++db) o[qb][db] = f32x4{0.f, 0.f, 0.f, 0.f};
  float m[2] = {-1e30f, -1e30f}, lsum[2] = {0.f, 0.f};

  const int krow = tid >> 3, kpart = (tid & 7) * (HD / 8);
  u32x4 rkA[NCH], rvA[NCH], rkB[NCH], rvB[NCH];
  auto load_tile = [&](int u, u32x4 (&rk)[NCH], u32x4 (&rv)[NCH]) {
    const u16* ksrc = K + ((size_t)u * 64 + krow) * 1024 + kpart;
#pragma unroll
    for (int i = 0; i < NCH; ++i) rk[i] = *(const u32x4*)(ksrc + i * 8);
#pragma unroll
    for (int i = 0; i < NCH; ++i) {
      const int id = tid + 512 * i, d = id >> 3, cc = id & 7;
      rv[i] = *(const u32x4*)(Vt + (size_t)d * 4096 + u * 64 + cc * 8);
    }
  };
  auto store_tile = [&](const u32x4 (&rk)[NCH], const u32x4 (&rv)[NCH]) {
#pragma unroll
    for (int i = 0; i < NCH; ++i) *(u32x4*)(sK + krow * LDK + kpart + i * 8) = rk[i];
#pragma unroll
    for (int i = 0; i < NCH; ++i) {
      const int id = tid + 512 * i, d = id >> 3, cc = id & 7;
      *(u32x4*)(sV + d * 72 + cc * 8) = rv[i];
    }
  };
  auto compute_tile = [&](int u) {
    if (u < sbq || u > sbq + 8) return;
    f32x4 s[2][4];
#pragma unroll
    for (int kb = 0; kb < 4; ++kb) {
      s[0][kb] = f32x4{0.f, 0.f, 0.f, 0.f};
      s[1][kb] = f32x4{0.f, 0.f, 0.f, 0.f};
#pragma unroll
      for (int ks = 0; ks < KS; ++ks) {
        const bf16x8 kf = *(const bf16x8*)(sK + (kb * 16 + l15) * LDK + ks * 32 + g * 8);
        s[0][kb] = __builtin_amdgcn_mfma_f32_16x16x32_bf16(kf, qf[0][ks], s[0][kb], 0, 0, 0);
        s[1][kb] = __builtin_amdgcn_mfma_f32_16x16x32_bf16(kf, qf[1][ks], s[1][kb], 0, 0, 0);
      }
    }
    bf16x8 pf[2][2];
#pragma unroll
    for (int qb = 0; qb < 2; ++qb) {
      if ((8 + sbq - u) * 64 - 63 >= 256) {
#pragma unroll
        for (int kb = 0; kb < 4; ++kb)
#pragma unroll
          for (int i = 0; i < 4; ++i) s[qb][kb][i] += bias_far;
      } else {
        const int dbase = (8 + sbq - u) * 64 + (wh * 32 + qb * 16 + l15) - g * 4 + 256;
#pragma unroll
        for (int kb = 0; kb < 4; ++kb)
#pragma unroll
          for (int i = 0; i < 4; ++i) s[qb][kb][i] += sBias[min(dbase - (kb * 16 + i), 512)];
      }
      float mx = -1e30f;
#pragma unroll
      for (int kb = 0; kb < 4; ++kb)
#pragma unroll
        for (int i = 0; i < 4; ++i) mx = fmaxf(mx, s[qb][kb][i]);
      mx = fmaxf(mx, __shfl_xor(mx, 16));
      mx = fmaxf(mx, __shfl_xor(mx, 32));
      const float mn = fmaxf(m[qb], mx);
      const float alpha = __builtin_amdgcn_exp2f(m[qb] - mn);
      m[qb] = mn;
      lsum[qb] *= alpha;
#pragma unroll
      for (int db = 0; db < DB; ++db) { o[qb][db][0] *= alpha; o[qb][db][1] *= alpha; o[qb][db][2] *= alpha; o[qb][db][3] *= alpha; }
#pragma unroll
      for (int k2 = 0; k2 < 2; ++k2) {
        float pv[8];
#pragma unroll
        for (int i = 0; i < 4; ++i) {
          pv[i] = __builtin_amdgcn_exp2f(s[qb][2 * k2][i] - mn);
          pv[4 + i] = __builtin_amdgcn_exp2f(s[qb][2 * k2 + 1][i] - mn);
        }
#pragma unroll
        for (int e = 0; e < 8; ++e) lsum[qb] += pv[e];
        pf[qb][k2] = __builtin_bit_cast(bf16x8, pack8(pv));
      }
    }
#pragma unroll
    for (int db = 0; db < DB; ++db) {
#pragma unroll
      for (int k2 = 0; k2 < 2; ++k2) {
        const u16* vp = sV + (db * 16 + l15) * 72 + k2 * 32 + g * 4;
        const uint2 lo = *(const uint2*)vp, hi = *(const uint2*)(vp + 16);
        uint4 vv; vv.x = lo.x; vv.y = lo.y; vv.z = hi.x; vv.w = hi.y;
        const bf16x8 vf = __builtin_bit_cast(bf16x8, vv);
        o[0][db] = __builtin_amdgcn_mfma_f32_16x16x32_bf16(vf, pf[0][k2], o[0][db], 0, 0, 0);
        o[1][db] = __builtin_amdgcn_mfma_f32_16x16x32_bf16(vf, pf[1][k2], o[1][db], 0, 0, 0);
      }
    }
  };
  load_tile(u0, rkA, rvA);
  if (u0 + 1 < U1) load_tile(u0 + 1, rkB, rvB);
  for (int u = u0; u < U1; u += 2) {
    __syncthreads();
    store_tile(rkA, rvA);
    __syncthreads();
    if (u + 2 < U1) load_tile(u + 2, rkA, rvA);
    compute_tile(u);
    if (u + 1 < U1) {
      __syncthreads();
      store_tile(rkB, rvB);
      __syncthreads();
      if (u + 3 < U1) load_tile(u + 3, rkB, rvB);
      compute_tile(u + 1);
    }
  }
#pragma unroll
  for (int qb = 0; qb < 2; ++qb) {
    float ls = lsum[qb];
    ls += __shfl_xor(ls, 16);
    ls += __shfl_xor(ls, 32);
    const float inv = 1.f / ls;
    const int r = w * 32 + qb * 16 + l15;
    const size_t ro = (size_t)r * 1024 + g * 4;
    uint2 gall[DB];
#pragma unroll
    for (int db = 0; db < DB; ++db) gall[db] = *(const uint2*)(Gate + ro + db * 16);
#pragma unroll
    for (int db = 0; db < DB; ++db) {
      const uint2 gv = gall[db];
      uint2 ov;
      ov.x = pack2(o[qb][db][0] * inv * __uint_as_float(gv.x << 16), o[qb][db][1] * inv * __uint_as_float(gv.x & 0xffff0000u));
      ov.y = pack2(o[qb][db][2] * inv * __uint_as_float(gv.y << 16), o[qb][db][3] * inv * __uint_as_float(gv.y & 0xffff0000u));
      *(uint2*)(Out + ((size_t)((okb >> 6) + (db >> 2)) * TOK + orow0 + r) * 64 + (db & 3) * 16 + g * 4) = ov;
    }
  }
}

DI void rnn_local_item(const Params& p, int bl, int c0, int n, const bf16x8 (&bR)[2][4], const bf16x8 (&bI)[2][4], unsigned char* smem) {
  const int tid = get_tid(), sbk = tid >> 8, tl = tid & 255, lane = tid & 63, w = tl >> 6, l15 = lane & 15, g = lane >> 4;
  unsigned char* sm = smem + sbk * 67584;
  float* sxc = (float*)sm;
  float* sa = (float*)(sm + 33792);
  u16* sxcb = (u16*)(sm + 33792);
  const int c = c0 + sbk;
  const int ch0 = n * 128;
  const size_t tok0 = (size_t)bl * 4096 + c * 64;
  __syncthreads();
  {
    const int c8 = (tl & 15) * 8, t4 = (tl >> 4) * 4;
    const u16* src = p.xr() + tok0 * 1024 + ch0 + c8;
    uint4 xr_[7];
#pragma unroll
    for (int j = 0; j < 7; ++j) {
      const int t = t4 - 3 + j;
      if (c * 64 + t >= 0) xr_[j] = *(const uint4*)(src + (ptrdiff_t)t * 1024);
      else xr_[j] = uint4{0u, 0u, 0u, 0u};
    }
    float wv[4][8], cbv[8];
#pragma unroll
    for (int k = 0; k < 4; ++k) {
      const float4 w0 = *(const float4*)(p.conv_w + k * 1024 + ch0 + c8), w1 = *(const float4*)(p.conv_w + k * 1024 + ch0 + c8 + 4);
      wv[k][0] = w0.x; wv[k][1] = w0.y; wv[k][2] = w0.z; wv[k][3] = w0.w; wv[k][4] = w1.x; wv[k][5] = w1.y; wv[k][6] = w1.z; wv[k][7] = w1.w;
    }
    {
      const float4 b0 = *(const float4*)(p.conv_b + ch0 + c8), b1 = *(const float4*)(p.conv_b + ch0 + c8 + 4);
      cbv[0] = b0.x; cbv[1] = b0.y; cbv[2] = b0.z; cbv[3] = b0.w; cbv[4] = b1.x; cbv[5] = b1.y; cbv[6] = b1.z; cbv[7] = b1.w;
    }
    float xf[7][8];
#pragma unroll
    for (int j = 0; j < 7; ++j) unpack8(xr_[j], xf[j]);
#pragma unroll
    for (int tt = 0; tt < 4; ++tt) {
      float xc[8];
#pragma unroll
      for (int e = 0; e < 8; ++e)
        xc[e] = wv[0][e] * xf[tt][e] + wv[1][e] * xf[tt + 1][e] + wv[2][e] * xf[tt + 2][e] + wv[3][e] * xf[tt + 3][e] + cbv[e];
      float* d = sxc + (t4 + tt) * 132 + c8;
      *(float4*)d = float4{xc[0], xc[1], xc[2], xc[3]};
      *(float4*)(d + 4) = float4{xc[4], xc[5], xc[6], xc[7]};
      *(uint4*)(sxcb + (t4 + tt) * 136 + c8) = pack8(xc);
    }
  }
  __syncthreads();
  f32x4 accR[4][2], accI[4][2];
#pragma unroll
  for (int tb = 0; tb < 4; ++tb)
#pragma unroll
    for (int jb = 0; jb < 2; ++jb) { accR[tb][jb] = f32x4{0.f, 0.f, 0.f, 0.f}; accI[tb][jb] = f32x4{0.f, 0.f, 0.f, 0.f}; }
  {
#pragma unroll
    for (int tb = 0; tb < 4; ++tb)
#pragma unroll
      for (int ks = 0; ks < 4; ++ks) {
        const bf16x8 af = *(const bf16x8*)(sxcb + (tb * 16 + l15) * 136 + ks * 32 + g * 8);
#pragma unroll
        for (int jb = 0; jb < 2; ++jb) {
          accR[tb][jb] = __builtin_amdgcn_mfma_f32_16x16x32_bf16(af, bR[jb][ks], accR[tb][jb], 0, 0, 0);
          accI[tb][jb] = __builtin_amdgcn_mfma_f32_16x16x32_bf16(af, bI[jb][ks], accI[tb][jb], 0, 0, 0);
        }
      }
  }
  __syncthreads();
#pragma unroll
  for (int jb = 0; jb < 2; ++jb) {
    const int ch = 32 * w + jb * 16 + l15;
    const float ba = p.lru_ba[ch0 + ch], bx = p.lru_bx[ch0 + ch];
    const float sp = log1pf(expf(-p.lru_lambda[ch0 + ch]));
#pragma unroll
    for (int tb = 0; tb < 4; ++tb)
#pragma unroll
      for (int r = 0; r < 4; ++r) {
        const int t = tb * 16 + g * 4 + r;
        const float rg = sigm(accR[tb][jb][r] + ba), ig = sigm(accI[tb][jb][r] + bx);
        const float la = -8.f * rg * sp;
        const float a = __expf(la);
        const float mult = __builtin_amdgcn_sqrtf(fmaxf(1.f - __expf(2.f * la), 0.f));
        const float xc = sxc[t * 132 + ch];
        sa[t * 132 + ch] = a;
        sxc[t * 132 + ch] = mult * (ig * xc);
      }
  }
  __syncthreads();
  {
    const int ch = tl & 127, half = tl >> 7, tb = half * 32;
    float hh = 0.f, A = 1.f;
#pragma unroll 8
    for (int t = tb; t < tb + 32; ++t) {
      const float a = sa[t * 132 + ch];
      hh = a * hh + sxc[t * 132 + ch];
      A *= a;
      sxc[t * 132 + ch] = hh;
      sa[t * 132 + ch] = A;
    }
    __syncthreads();
  }
  {
    const int c8 = (tl & 15) * 8, r0 = tl >> 4;
    float cH[8], cA[8];
    {
      const float4 h0 = *(const float4*)(sxc + 31 * 132 + c8), h1 = *(const float4*)(sxc + 31 * 132 + c8 + 4);
      const float4 a0 = *(const float4*)(sa + 31 * 132 + c8), a1 = *(const float4*)(sa + 31 * 132 + c8 + 4);
      cH[0] = h0.x; cH[1] = h0.y; cH[2] = h0.z; cH[3] = h0.w; cH[4] = h1.x; cH[5] = h1.y; cH[6] = h1.z; cH[7] = h1.w;
      cA[0] = a0.x; cA[1] = a0.y; cA[2] = a0.z; cA[3] = a0.w; cA[4] = a1.x; cA[5] = a1.y; cA[6] = a1.z; cA[7] = a1.w;
    }
#pragma unroll
    for (int i = 0; i < 4; ++i) {
      const int row = r0 + 16 * i;
      const float4 h0 = *(const float4*)(sxc + row * 132 + c8), h1 = *(const float4*)(sxc + row * 132 + c8 + 4);
      const float4 a0 = *(const float4*)(sa + row * 132 + c8), a1 = *(const float4*)(sa + row * 132 + c8 + 4);
      float hv[8] = {h0.x, h0.y, h0.z, h0.w, h1.x, h1.y, h1.z, h1.w};
      float av[8] = {a0.x, a0.y, a0.z, a0.w, a1.x, a1.y, a1.z, a1.w};
      if (i >= 2) {
#pragma unroll
        for (int e = 0; e < 8; ++e) { hv[e] += av[e] * cH[e]; av[e] *= cA[e]; }
      }
      const size_t o = (tok0 + row) * 1024 + ch0 + c8;
      *(uint4*)(p.hloc() + o) = pack8(hv);
      *(uint4*)(p.cuma() + o) = pack8(av);
      if (row == 63) {
        float* da = p.chA() + ((size_t)bl * 64 + c) * 1024 + ch0 + c8;
        float* dh = p.chH() + ((size_t)bl * 64 + c) * 1024 + ch0 + c8;
        *(float4*)da = float4{av[0], av[1], av[2], av[3]}; *(float4*)(da + 4) = float4{av[4], av[5], av[6], av[7]};
        *(float4*)dh = float4{hv[0], hv[1], hv[2], hv[3]}; *(float4*)(dh + 4) = float4{hv[4], hv[5], hv[6], hv[7]};
      }
    }
  }
}

DI void step_mix(const Params& p, int pass, unsigned char* smem) {
  constexpr int NB = GB * 16 * 8, NM = GB * 32 * 4, NR = GB * 32 * 8;
  const bool rnn_first = ((blockIdx.x >> 3) & 1) != 0;
#pragma unroll 1
  for (int part = 0; part < 2; ++part) {
  if ((part == 0) != rnn_first) {
  for (int it = blockIdx.x; it < NB + NM; it += gridDim.x) {
    if (it < NM) {
      const int hh = it & 3, tt = (it >> 2) & 31, bl = it >> 7;
      const int bgl = pass * GB + bl;
      const size_t tok = (size_t)bl * 4096 + tt * 128;
      attn_core<256, false>(p.qm() + tok * 1024 + hh * 256, p.memk() + (size_t)bgl * 256 * 1024 + hh * 256,
                            p.memvt() + (size_t)(bgl * 4 + hh) * 256 * 256, 256, 0, 4, nullptr, p.mem_q_norm_g,
                            p.mem_g(), tok, hh * 256, p.gms() + tok * 1024 + hh * 256, smem);
    } else if (it < NM + NB) {
      const int idx = it - NM;
      const int hh = idx & 7, cq = (idx >> 3) & 15, bl = idx >> 7;
      const int c0 = 4 * ((cq + 4 * bl) & 15);
      const size_t tok = (size_t)bl * 4096 + c0 * 64;
      const int u0 = c0 >= 8 ? 0 : 8 - c0;
      const u16* K0 = p.kn() + ((ptrdiff_t)bl * 4096 + (ptrdiff_t)(c0 - 8) * 64) * 1024 + hh * 128;
      const u16* V0 = p.vt() + (size_t)(bl * 8 + hh) * 128 * 4096 + (ptrdiff_t)(c0 - 8) * 64;
      band_core(p.qn() + tok * 1024 + hh * 128, K0, V0, u0, p.rel_bias + hh * 513, p.att_g(), tok, hh * 128,
                p.gas() + tok * 1024 + hh * 128, smem);
    }
  }
  } else {
  int it = NB + NM + blockIdx.x;
  if (it < NB + NM + NR) {
    const int n = (it - NM - NB) & 7;
    const int tid = get_tid(), lane = tid & 63, w = (tid & 255) >> 6, l15 = lane & 15, g = lane >> 4;
    bf16x8 bR[2][4], bI[2][4];
#pragma unroll
    for (int jb = 0; jb < 2; ++jb)
#pragma unroll
      for (int ks = 0; ks < 4; ++ks) {
        const size_t off = (size_t)n * 16384 + (size_t)(32 * w + jb * 16 + l15) * 128 + ks * 32 + g * 8;
        bR[jb][ks] = *(const bf16x8*)(p.wt_a() + off);
        bI[jb][ks] = *(const bf16x8*)(p.wt_x() + off);
      }
    for (; it < NB + NM + NR; it += gridDim.x) {
      const int idx = it - NM - NB;
      const int cp = (idx >> 3) & 31, bl = idx >> 8;
      rnn_local_item(p, bl, 2 * cp, n, bR, bI, smem);
    }
  }
  }
  }
}

DI void step_rnnfin(const Params& p, unsigned char* smem) {
  float* sP = (float*)smem;
  const int tid = get_tid(), c8 = (tid & 127) * 8, q = tid >> 7;
  for (int it = blockIdx.x; it < GB * 64; it += gridDim.x) {
    const int c = it & 63, bl = it >> 6;
    float Aq[8], Hq[8];
#pragma unroll
    for (int e = 0; e < 8; ++e) { Aq[e] = 1.f; Hq[e] = 0.f; }
    {
      const float* pa = p.chA() + ((size_t)bl * 64) * 1024 + c8;
      const float* ph = p.chH() + ((size_t)bl * 64) * 1024 + c8;
#pragma unroll 4
      for (int j = 0; j < 16; ++j) {
        const int k = q * 16 + j;
        const int kk = k < c ? k : 0;
        float4 a0 = *(const float4*)(pa + (size_t)kk * 1024), a1 = *(const float4*)(pa + (size_t)kk * 1024 + 4);
        float4 h0 = *(const float4*)(ph + (size_t)kk * 1024), h1 = *(const float4*)(ph + (size_t)kk * 1024 + 4);
        if (k >= c) { a0 = float4{1.f, 1.f, 1.f, 1.f}; a1 = a0; h0 = float4{0.f, 0.f, 0.f, 0.f}; h1 = h0; }
        Hq[0] = Hq[0] * a0.x + h0.x; Hq[1] = Hq[1] * a0.y + h0.y; Hq[2] = Hq[2] * a0.z + h0.z; Hq[3] = Hq[3] * a0.w + h0.w;
        Hq[4] = Hq[4] * a1.x + h1.x; Hq[5] = Hq[5] * a1.y + h1.y; Hq[6] = Hq[6] * a1.z + h1.z; Hq[7] = Hq[7] * a1.w + h1.w;
        Aq[0] *= a0.x; Aq[1] *= a0.y; Aq[2] *= a0.z; Aq[3] *= a0.w; Aq[4] *= a1.x; Aq[5] *= a1.y; Aq[6] *= a1.z; Aq[7] *= a1.w;
      }
    }
    __syncthreads();
    {
      float* dA = sP + (q * 2 + 0) * 1024 + c8;
      float* dH = sP + (q * 2 + 1) * 1024 + c8;
      *(float4*)dA = float4{Aq[0], Aq[1], Aq[2], Aq[3]}; *(float4*)(dA + 4) = float4{Aq[4], Aq[5], Aq[6], Aq[7]};
      *(float4*)dH = float4{Hq[0], Hq[1], Hq[2], Hq[3]}; *(float4*)(dH + 4) = float4{Hq[4], Hq[5], Hq[6], Hq[7]};
    }
    __syncthreads();
    float cr[8];
#pragma unroll
    for (int e = 0; e < 8; ++e) cr[e] = 0.f;
#pragma unroll
    for (int qq = 0; qq < 4; ++qq) {
      const float* sa_ = sP + (qq * 2 + 0) * 1024 + c8;
      const float* sh_ = sP + (qq * 2 + 1) * 1024 + c8;
      const float4 a0 = *(const float4*)sa_, a1 = *(const float4*)(sa_ + 4), h0 = *(const float4*)sh_, h1 = *(const float4*)(sh_ + 4);
      cr[0] = cr[0] * a0.x + h0.x; cr[1] = cr[1] * a0.y + h0.y; cr[2] = cr[2] * a0.z + h0.z; cr[3] = cr[3] * a0.w + h0.w;
      cr[4] = cr[4] * a1.x + h1.x; cr[5] = cr[5] * a1.y + h1.y; cr[6] = cr[6] * a1.z + h1.z; cr[7] = cr[7] * a1.w + h1.w;
    }
    const size_t tok = (size_t)bl * 4096 + c * 64 + q * 16;
    u16* dst = p.rnn_g() + ((size_t)(c8 >> 6) * TOK + tok) * 64 + (c8 & 63);
#pragma unroll 4
    for (int t = 0; t < 16; ++t) {
      const size_t o = (tok + t) * 1024 + c8;
      float hl[8], cu[8], gr[8], ov[8];
      unpack8(*(const uint4*)(p.hloc() + o), hl);
      unpack8(*(const uint4*)(p.cuma() + o), cu);
      unpack8(*(const uint4*)(p.grs() + o), gr);
#pragma unroll
      for (int e = 0; e < 8; ++e) ov[e] = (hl[e] + cu[e] * cr[e]) * gr[e];
      *(uint4*)(dst + (size_t)t * 64) = pack8(ov);
    }
  }
}

DI void step_proj(const Params& p, unsigned char* smem) {
  constexpr int MT = TOK / 256;
  u16* ytmp = p.ytmp();
  for (int t = blockIdx.x; t < MT * 4; t += gridDim.x) {
    const int mt = t % MT, nt = t / MT;
    const int wave = get_tid() >> 6, wm = wave >> 1, wn = wave & 1;
#pragma unroll 1
    for (int b = 0; b < 3; ++b) {
      const u16* A = (b == 0 ? p.rnn_g() : b == 1 ? p.att_g() : p.mem_g()) + (size_t)mt * 256 * 64;
      const u16* W = (b == 0 ? p.wt_prnn() : b == 1 ? p.wt_patt() : p.wt_pmem()) + (size_t)nt * 256 * 64;
      f32x16 acc[2][4];
      zero_acc(acc);
      gemm_kloop(A, (size_t)TOK * 64, W, (size_t)1024 * 64, 1024, acc, smem);
      uint4 gpre[8], ypre[8];
      const int lane_ = get_tid() & 63, rsub_ = lane_ >> 3, chunk_ = lane_ & 7;
      wave_epilogue_pre(acc, smem, [&](int mi) {
        const size_t rowbase = (size_t)mt * 256 + wm * 64 + mi * 32;
        const u16* gs = p.gsig() + rowbase * 3072 + b * 1024 + nt * 256 + wn * 128;
        const u16* yt = ytmp + ((size_t)(t * 8 + wave) * 2 + mi) * 4096 + lane_ * 8;
#pragma unroll
        for (int i = 0; i < 4; ++i)
#pragma unroll
          for (int hf = 0; hf < 2; ++hf) {
            gpre[i * 2 + hf] = *(const uint4*)(gs + (size_t)(i * 8 + rsub_) * 3072 + hf * 64 + chunk_ * 8);
            if (b != 0) ypre[i * 2 + hf] = *(const uint4*)(yt + (i * 2 + hf) * 512);
          }
      }, [&](int mi, const float* sW) {
        const size_t rowbase = (size_t)mt * 256 + wm * 64 + mi * 32;
        const int cb = nt * 256 + wn * 128;
        const u16* gs = p.gsig() + rowbase * 3072 + b * 1024 + cb;
        u16* yt = ytmp + ((size_t)(t * 8 + wave) * 2 + mi) * 4096 + (get_tid() & 63) * 8;
        u16* yo = p.y();
        slab_rows(sW, [&](int row, int c, const float* v, int i_) {
          float gv[8], o[8];
          unpack8(gpre[i_ * 2 + (c >> 6)], gv);
          u16* yp = yt + (i_ * 2 + (c >> 6)) * 512;
          if (b == 0) {
#pragma unroll
            for (int e = 0; e < 8; ++e) o[e] = v[e] * gv[e];
          } else {
            float yv_[8];
            unpack8(ypre[i_ * 2 + (c >> 6)], yv_);
#pragma unroll
            for (int e = 0; e < 8; ++e) o[e] = yv_[e] + v[e] * gv[e];
          }
          if (b < 2) {
            *(uint4*)yp = pack8(o);
          } else {
            *(uint4*)(yo + ((size_t)((cb + c) >> 6) * TOK + rowbase + row) * 64 + ((cb + c) & 63)) = pack8(o);
          }
        });
      });
    }
  }
}

DI void step_out(const Params& p, int pass, unsigned char* smem) {
  constexpr int MT = TOK / 256;
  for (int t = blockIdx.x; t < MT * 4; t += gridDim.x) {
    const int mt = t % MT, nt = t / MT;
    f32x16 acc[2][4];
    zero_acc(acc);
    gemm_kloop(p.y() + (size_t)mt * 256 * 64, (size_t)TOK * 64, p.wt_out() + (size_t)nt * 256 * 64, (size_t)1024 * 64, 1024, acc, smem);
    const int wave = get_tid() >> 6, wm = wave >> 1, wn = wave & 1;
    float4 xpre[8][2];
    const int lane_ = get_tid() & 63, rsub_ = lane_ >> 3, chunk_ = lane_ & 7;
    wave_epilogue_pre(acc, smem, [&](int mi) {
      const float* xs = p.x + ((size_t)pass * TOK + (size_t)mt * 256 + wm * 64 + mi * 32) * 1024 + nt * 256 + wn * 128;
#pragma unroll
      for (int i = 0; i < 4; ++i)
#pragma unroll
        for (int hf = 0; hf < 2; ++hf) {
          const float* s_ = xs + (size_t)(i * 8 + rsub_) * 1024 + hf * 64 + chunk_ * 8;
          xpre[i * 2 + hf][0] = *(const float4*)s_;
          xpre[i * 2 + hf][1] = *(const float4*)(s_ + 4);
        }
    }, [&](int mi, const float* sW) {
      const size_t gbase = ((size_t)pass * TOK + (size_t)mt * 256 + wm * 64 + mi * 32) * 1024 + nt * 256 + wn * 128;
      float* dst = p.out + gbase;
      slab_rows(sW, [&](int row, int c, const float* v, int i_) {
        const float4 x0 = xpre[i_ * 2 + (c >> 6)][0], x1 = xpre[i_ * 2 + (c >> 6)][1];
        float4 o0, o1;
        o0.x = x0.x + v[0]; o0.y = x0.y + v[1]; o0.z = x0.z + v[2]; o0.w = x0.w + v[3];
        o1.x = x1.x + v[4]; o1.y = x1.y + v[5]; o1.z = x1.z + v[6]; o1.w = x1.w + v[7];
        *(float4*)(dst + (size_t)row * 1024 + c) = o0;
        *(float4*)(dst + (size_t)row * 1024 + c + 4) = o1;
      });
    });
  }
}

DI void run_phase(const Params& p, int pass, int ph, bool first, unsigned char* smem) {
  if (ph == 0) step_gemm1(p, pass, first, smem);
  else if (ph == 1) step_mix(p, pass, smem);
  else if (ph == 2) step_rnnfin(p, smem);
  else if (ph == 3) step_proj(p, smem);
  else step_out(p, pass, smem);
}

__global__ void __launch_bounds__(512) mega_kernel(Params p_in) {
  __shared__ __attribute__((aligned(16))) unsigned char smem[SMEM_BYTES];
  cg::grid_group grid = cg::this_grid();
  const Params& p = p_in;
  unsigned* bar = (unsigned*)(p.ws + OFF_bar);
  unsigned nbar = 0;
  __shared__ unsigned s_xb[4];
  const unsigned xcc = (unsigned)__builtin_amdgcn_s_getreg((3 << 11) | 20) & 7u;
  if (__builtin_amdgcn_workitem_id_x() == 0) { s_xb[0] = 0u; s_xb[1] = 0u; (void)xb_add(bar + XB_XCNT(xcc), 1u); }
  __syncthreads();
  for (int step = p.step_lo; step < p.step_hi; ++step) {
    if (step == 0) step_prep(p, smem);
    else if (step == 1) step_memkv(p, smem);
    else {
      const int pass = (step - 2) / 5, ph = (step - 2) % 5;
#ifdef DUP_PH
      if (ph == DUP_PH) { run_phase(p, pass, ph, true, smem); ++nbar; xcd_barrier(bar, xcc, s_xb); run_phase(p, pass, ph, false, smem); }
      else
#endif
      run_phase(p, pass, ph, true, smem);
    }
    if (step + 1 < p.step_hi) {
      if (p.step_hi < 0) grid.sync();
      if (step >= 2 && (step - 2) % 5 == 4) {   }
      else { ++nbar; xcd_barrier(bar, xcc, s_xb); }
    }
  }
}

extern "C" void kernel_launch(void* const* d_in, const int* in_sizes, int n_in, void* d_out, int out_size, void* d_ws,
                              size_t ws_size, hipStream_t stream) {
  static int grid_blocks = 0;
  if (!grid_blocks) {
    int dev = 0, cus = 0, per_cu = 0;
    (void)hipGetDevice(&dev);
    (void)hipDeviceGetAttribute(&cus, hipDeviceAttributeMultiprocessorCount, dev);
    (void)hipOccupancyMaxActiveBlocksPerMultiprocessor(&per_cu, mega_kernel, 512, 0);
    if (per_cu > 1) per_cu = 1;
    if (per_cu < 1) per_cu = 1;
    grid_blocks = (cus * per_cu) & ~7;
  }
  Params p{};
  const float* const* in = (const float* const*)d_in;
  p.x = in[0]; p.mem = in[1]; p.norm_g = in[2]; p.mem_norm_g = in[3]; p.w_in = in[4]; p.b_merge = in[5]; p.conv_w = in[6];
  p.conv_b = in[7]; p.lru_wa = in[8]; p.lru_ba = in[9]; p.lru_wx = in[10]; p.lru_bx = in[11]; p.lru_lambda = in[12];
  p.q_norm_g = in[13]; p.k_norm_g = in[14]; p.rel_bias = in[15]; p.w_mem_kv = in[16]; p.mem_q_norm_g = in[17];
  p.mem_k_norm_g = in[18]; p.w_proj_rnn = in[19]; p.w_proj_att = in[20]; p.w_proj_mem = in[21]; p.w_out = in[22];
  p.out = (float*)d_out;
  p.ws = (unsigned char*)d_ws;
  if (WS_NEED > ws_size) { fprintf(stderr, "workspace too small: need %llu have %zu\n", WS_NEED, ws_size); return; }
  p.step_lo = 0; p.step_hi = 2 + 5 * NPASS;
  (void)hipMemsetAsync((unsigned char*)d_ws + OFF_bar, 0, 4096, stream);
  void* args[] = {&p};
  hipError_t e = hipLaunchCooperativeKernel((void*)mega_kernel, dim3(grid_blocks), dim3(512), args, 0, stream);
  if (e != hipSuccess) fprintf(stderr, "cooperative launch failed: %s (grid %d)\n", hipGetErrorString(e), grid_blocks);
}
```

```cpp
#include <hip/hip_runtime.h>
#include <hip/hip_cooperative_groups.h>
#include <cstdio>
#include <cstddef>
namespace cg = cooperative_groups;

#define DI __device__ __forceinline__
typedef unsigned short u16;
using bf16x8 = __attribute__((ext_vector_type(8))) short;
using f32x4  = __attribute__((ext_vector_type(4))) float;
using f32x16 = __attribute__((ext_vector_type(16))) float;
using u32x4  = __attribute__((ext_vector_type(4))) unsigned;

constexpr int SEQ = 4096;
constexpr int GB = 4;
constexpr int NPASS = 4;
constexpr int TOK = GB * SEQ;
constexpr int SMEM_BYTES = 147456;
constexpr int T_TR = 2816 + 1024 + 512 + 64;
constexpr int T_ROWS = 8192 + 512;
constexpr float EPS = 1e-6f;

constexpr unsigned long long ACT = (unsigned long long)TOK * 1024 * 2;
constexpr unsigned long long OFF_wt_in = 0ull;
constexpr unsigned long long OFF_wt_prnn = OFF_wt_in + ((11264ull*1024*2 + 255ull) & ~255ull);
constexpr unsigned long long OFF_wt_patt = OFF_wt_prnn + ((1024ull*1024*2 + 255ull) & ~255ull);
constexpr unsigned long long OFF_wt_pmem = OFF_wt_patt + ((1024ull*1024*2 + 255ull) & ~255ull);
constexpr unsigned long long OFF_wt_out = OFF_wt_pmem + ((1024ull*1024*2 + 255ull) & ~255ull);
constexpr unsigned long long OFF_wt_memkv = OFF_wt_out + ((1024ull*1024*2 + 255ull) & ~255ull);
constexpr unsigned long long OFF_wt_a = OFF_wt_memkv + ((2048ull*1024*2 + 255ull) & ~255ull);
constexpr unsigned long long OFF_wt_x = OFF_wt_a + ((8ull*128*128*2 + 255ull) & ~255ull);
constexpr unsigned long long OFF_h = OFF_wt_x + ((8ull*128*128*2 + 255ull) & ~255ull);
constexpr unsigned long long OFF_mem_n = OFF_h + ((65536ull*1024*2 + 255ull) & ~255ull);
constexpr unsigned long long OFF_memk = OFF_mem_n + ((4096ull*1024*2 + 255ull) & ~255ull);
constexpr unsigned long long OFF_memvt = OFF_memk + ((4096ull*1024*2 + 255ull) & ~255ull);
constexpr unsigned long long OFF_xr = OFF_memvt + ((4096ull*1024*2 + 255ull) & ~255ull);
constexpr unsigned long long OFF_grs = OFF_xr + ((ACT + 255ull) & ~255ull);
constexpr unsigned long long OFF_qn = OFF_grs + ((ACT + 255ull) & ~255ull);
constexpr unsigned long long OFF_kn = OFF_qn + ((ACT + 255ull) & ~255ull);
constexpr unsigned long long OFF_vt = OFF_kn + ((ACT + 255ull) & ~255ull);
constexpr unsigned long long OFF_gas = OFF_vt + ((ACT + 255ull) & ~255ull);
constexpr unsigned long long OFF_qm = OFF_gas + ((ACT + 255ull) & ~255ull);
constexpr unsigned long long OFF_gms = OFF_qm + ((ACT + 255ull) & ~255ull);
constexpr unsigned long long OFF_gsig = OFF_gms + ((ACT + 255ull) & ~255ull);
constexpr unsigned long long OFF_hloc = OFF_gsig + ((ACT*3 + 255ull) & ~255ull);
constexpr unsigned long long OFF_cuma = OFF_hloc + ((ACT*2 + 255ull) & ~255ull);
constexpr unsigned long long OFF_chA = OFF_cuma + ((ACT*2 + 255ull) & ~255ull);
constexpr unsigned long long OFF_chH = OFF_chA + (((unsigned long long)GB*64*1024*4 + 255ull) & ~255ull);
constexpr unsigned long long OFF_rnn_g = OFF_chH + (((unsigned long long)GB*64*1024*4 + 255ull) & ~255ull);
constexpr unsigned long long OFF_att_g = OFF_rnn_g + ((ACT + 255ull) & ~255ull);
constexpr unsigned long long OFF_mem_g = OFF_att_g + ((ACT + 255ull) & ~255ull);
constexpr unsigned long long OFF_y = OFF_mem_g + ((ACT + 255ull) & ~255ull);
constexpr unsigned long long OFF_bar = OFF_y + ((ACT + 255ull) & ~255ull);
constexpr unsigned long long WS_NEED = OFF_bar + 4096ull;
DI unsigned char* oq(unsigned char* w) { asm volatile("" : "+s"(w)); return w; }
struct Params {
  const float *x, *mem, *norm_g, *mem_norm_g, *w_in, *b_merge, *conv_w, *conv_b, *lru_wa, *lru_ba, *lru_wx, *lru_bx,
      *lru_lambda, *q_norm_g, *k_norm_g, *rel_bias, *w_mem_kv, *mem_q_norm_g, *mem_k_norm_g, *w_proj_rnn, *w_proj_att,
      *w_proj_mem, *w_out;
  float* out;
  unsigned char* ws;
  int step_lo, step_hi;
  DI u16* wt_in() const { return (u16*)(ws + OFF_wt_in); }
  DI u16* wt_prnn() const { return (u16*)(ws + OFF_wt_prnn); }
  DI u16* wt_patt() const { return (u16*)(ws + OFF_wt_patt); }
  DI u16* wt_pmem() const { return (u16*)(ws + OFF_wt_pmem); }
  DI u16* wt_out() const { return (u16*)(ws + OFF_wt_out); }
  DI u16* wt_memkv() const { return (u16*)(ws + OFF_wt_memkv); }
  DI u16* wt_a() const { return (u16*)(ws + OFF_wt_a); }
  DI u16* wt_x() const { return (u16*)(ws + OFF_wt_x); }
  DI u16* h() const { return (u16*)(ws + OFF_h); }
  DI u16* mem_n() const { return (u16*)(ws + OFF_mem_n); }
  DI u16* memk() const { return (u16*)(ws + OFF_memk); }
  DI u16* memvt() const { return (u16*)(ws + OFF_memvt); }
  DI u16* xr() const { return (u16*)(ws + OFF_xr); }
  DI u16* grs() const { return (u16*)(ws + OFF_grs); }
  DI u16* qn() const { return (u16*)(ws + OFF_qn); }
  DI u16* kn() const { return (u16*)(ws + OFF_kn); }
  DI u16* vt() const { return (u16*)(ws + OFF_vt); }
  DI u16* gas() const { return (u16*)(ws + OFF_gas); }
  DI u16* qm() const { return (u16*)(ws + OFF_qm); }
  DI u16* gms() const { return (u16*)(ws + OFF_gms); }
  DI u16* gsig() const { return (u16*)(ws + OFF_gsig); }
  DI u16* hloc() const { return (u16*)(ws + OFF_hloc); }
  DI u16* ytmp() const { return (u16*)(ws + OFF_hloc); }
  DI u16* cuma() const { return (u16*)(ws + OFF_cuma); }
  DI float* chA() const { return (float*)(ws + OFF_chA); }
  DI float* chH() const { return (float*)(ws + OFF_chH); }
  DI u16* rnn_g() const { return (u16*)(ws + OFF_rnn_g); }
  DI u16* att_g() const { return (u16*)(ws + OFF_att_g); }
  DI u16* mem_g() const { return (u16*)(ws + OFF_mem_g); }
  DI u16* y() const { return (u16*)(ws + OFF_y); }
};

#define XB_XCNT(j) (32 * (1 + (j)))
#define XB_XSUB(j) (32 * (9 + (j)))
#define XB_XGEN(j) (32 * (17 + (j)))
#define XB_TOP (32 * 25)
#define XB_TOPGEN (32 * 26)
DI unsigned xb_ld(unsigned* p) { return __hip_atomic_load(p, __ATOMIC_RELAXED, __HIP_MEMORY_SCOPE_AGENT); }
DI unsigned xb_add(unsigned* p, unsigned v) { return __hip_atomic_fetch_add(p, v, __ATOMIC_RELAXED, __HIP_MEMORY_SCOPE_AGENT); }
DI void xcd_barrier(unsigned* bar, unsigned xcc, volatile unsigned* st) {
  asm volatile("s_waitcnt vmcnt(0)" ::: "memory");
  __syncthreads();
  if (__builtin_amdgcn_workitem_id_x() == 0) {
    unsigned nloc = st[0], nx = st[1];
    if (nloc == 0u) {
      const unsigned G = gridDim.x;
      unsigned sp = 0;
      for (;;) {
        unsigned sum = 0, cnt = 0, mine = 0;
        for (unsigned j = 0; j < 8; ++j) { const unsigned c = xb_ld(bar + XB_XCNT(j)); sum += c; cnt += c > 0u ? 1u : 0u; mine = j == xcc ? c : mine; }
        nloc = mine; nx = cnt;
        if (sum == G) break;
        __builtin_amdgcn_s_sleep(1);
        if (++sp > (1u << 22)) break;
      }
      if (nloc == 0u) nloc = 1u;
      if (nx == 0u) nx = 1u;
      st[0] = nloc; st[1] = nx;
    }
    const unsigned old = xb_add(bar + XB_XSUB(xcc), 1u);
    const unsigned gen = old / nloc;
    if (old + 1u == (gen + 1u) * nloc) {
      __builtin_amdgcn_fence(__ATOMIC_RELEASE, "agent");
      asm volatile("s_waitcnt vmcnt(0)" ::: "memory");
      const unsigned og = xb_add(bar + XB_TOP, 1u);
      const unsigned tg = og / nx;
      if (og + 1u == (tg + 1u) * nx) (void)xb_add(bar + XB_TOPGEN, 1u);
      else { unsigned sp = 0; while (xb_ld(bar + XB_TOPGEN) == tg) { __builtin_amdgcn_s_sleep(1); if (++sp > (1u << 24)) break; } }
      __builtin_amdgcn_fence(__ATOMIC_ACQUIRE, "agent");
      (void)xb_add(bar + XB_XGEN(xcc), 1u);
      asm volatile("s_waitcnt vmcnt(0)" ::: "memory");
    } else {
      unsigned sp = 0;
      while (xb_ld(bar + XB_XGEN(xcc)) == gen) { __builtin_amdgcn_s_sleep(1); if (++sp > (1u << 24)) break; }
      __builtin_amdgcn_fence(__ATOMIC_ACQUIRE, "agent");
      asm volatile("s_waitcnt vmcnt(0)" ::: "memory");
    }
  }
  __syncthreads();
}
DI int get_tid() { int t = __builtin_amdgcn_workitem_id_x(); asm volatile("" : "+v"(t)); return t; }
typedef float f32x2_t __attribute__((ext_vector_type(2)));
typedef __bf16 bf16x2_t __attribute__((ext_vector_type(2)));
DI unsigned pack2(float a, float b) { f32x2_t v = {a, b}; return __builtin_bit_cast(unsigned, __builtin_convertvector(v, bf16x2_t)); }
DI u16 f2bf(float x) { return (u16)(pack2(x, x) & 0xffffu); }
DI float bf2f(u16 b) { return __uint_as_float(((unsigned)b) << 16); }
DI float sigm(float v) { return __builtin_amdgcn_rcpf(1.f + __builtin_amdgcn_exp2f(-1.4426950408889634f * v)); }
DI float silu(float v) { return v * sigm(v); }
DI uint4 pack8(const float* v) { uint4 r; r.x = pack2(v[0], v[1]); r.y = pack2(v[2], v[3]); r.z = pack2(v[4], v[5]); r.w = pack2(v[6], v[7]); return r; }
DI void unpack8(uint4 r, float* v) {
  v[0] = __uint_as_float(r.x << 16); v[1] = __uint_as_float(r.x & 0xffff0000u);
  v[2] = __uint_as_float(r.y << 16); v[3] = __uint_as_float(r.y & 0xffff0000u);
  v[4] = __uint_as_float(r.z << 16); v[5] = __uint_as_float(r.z & 0xffff0000u);
  v[6] = __uint_as_float(r.w << 16); v[7] = __uint_as_float(r.w & 0xffff0000u);
}

template <bool PANEL>
DI void transpose_tile(const float* __restrict__ src, int R, int C, u16* __restrict__ dst, int tr, int tc, float* tile) {
  const int tid = get_tid();
  __syncthreads();
#pragma unroll
  for (int i = 0; i < 2; ++i) {
    const int r = (tid >> 4) + 32 * i, c4 = (tid & 15) * 4;
    const float4 v = *(const float4*)(src + (size_t)(tr * 64 + r) * C + tc * 64 + c4);
    tile[r * 65 + c4 + 0] = v.x; tile[r * 65 + c4 + 1] = v.y; tile[r * 65 + c4 + 2] = v.z; tile[r * 65 + c4 + 3] = v.w;
  }
  __syncthreads();
  {
    const int c = tid >> 3, r8 = (tid & 7) * 8;
    float v[8];
#pragma unroll
    for (int j = 0; j < 8; ++j) v[j] = tile[(r8 + j) * 65 + c];
    if (PANEL) *(uint4*)(dst + ((size_t)tr * C + tc * 64 + c) * 64 + r8) = pack8(v);
    else *(uint4*)(dst + (size_t)(tc * 64 + c) * R + tr * 64 + r8) = pack8(v);
  }
}

DI void rms_row(const float* __restrict__ src, const float* __restrict__ g, u16* __restrict__ dst, size_t ROWS, size_t r) {
  const int lane = get_tid() & 63;
  float4 v[4];
  float ss = 0.f;
#pragma unroll
  for (int i = 0; i < 4; ++i) {
    v[i] = *(const float4*)(src + i * 256 + lane * 4);
    ss += v[i].x * v[i].x + v[i].y * v[i].y + v[i].z * v[i].z + v[i].w * v[i].w;
  }
#pragma unroll
  for (int o = 32; o >= 1; o >>= 1) ss += __shfl_xor(ss, o);
  const float rstd = rsqrtf(ss * (1.f / 1024.f) + EPS);
#pragma unroll
  for (int i = 0; i < 4; ++i) {
    const float4 gg = *(const float4*)(g + i * 256 + lane * 4);
    uint2 o;
    o.x = pack2(v[i].x * rstd * gg.x, v[i].y * rstd * gg.y);
    o.y = pack2(v[i].z * rstd * gg.z, v[i].w * rstd * gg.w);
    *(uint2*)(dst + ((size_t)(i * 4 + (lane >> 4)) * ROWS + r) * 64 + (lane & 15) * 4) = o;
  }
}

DI void step_prep(const Params& p, unsigned char* smem) {
  float* tile = (float*)smem;
  for (int it = blockIdx.x; it < T_TR + T_ROWS; it += gridDim.x) {
    if (it < T_TR) {
      int j = it;
      if (j < 2816) { transpose_tile<true>(p.w_in, 1024, 11264, p.wt_in(), j % 16, j / 16, tile); continue; }
      j -= 2816;
      if (j < 1024) {
        const int k = j >> 8, jj = j & 255;
        const float* s = k == 0 ? p.w_proj_rnn : k == 1 ? p.w_proj_att : k == 2 ? p.w_proj_mem : p.w_out;
        u16* d = k == 0 ? p.wt_prnn() : k == 1 ? p.wt_patt() : k == 2 ? p.wt_pmem() : p.wt_out();
        transpose_tile<true>(s, 1024, 1024, d, jj % 16, jj / 16, tile);
        continue;
      }
      j -= 1024;
      if (j < 512) { transpose_tile<true>(p.w_mem_kv, 1024, 2048, p.wt_memkv(), j % 16, j / 16, tile); continue; }
      j -= 512;
      {
        const int mat = j >> 5, jj = j & 31, n = jj >> 2, tr = (jj >> 1) & 1, tc = jj & 1;
        transpose_tile<false>((mat ? p.lru_wx : p.lru_wa) + n * 16384, 128, 128, (mat ? p.wt_x() : p.wt_a()) + n * 16384, tr, tc, tile);
      }
    } else {
      const int r = (it - T_TR) * 8 + (get_tid() >> 6);
      if (r < 65536) rms_row(p.x + (size_t)r * 1024, p.norm_g, p.h(), 65536, r);
      else { const int m = r - 65536; rms_row(p.mem + (size_t)m * 1024, p.mem_norm_g, p.mem_n(), 4096, m); }
    }
  }
}

DI void zero_acc(f32x16 (&acc)[2][4]) {
#pragma unroll
  for (int a = 0; a < 2; ++a)
#pragma unroll
    for (int b = 0; b < 4; ++b)
#pragma unroll
      for (int r = 0; r < 16; ++r) acc[a][b][r] = 0.f;
}

DI void gemm_kloop(const u16* __restrict__ A, size_t aks, const u16* __restrict__ Bt, size_t bks, int K, f32x16 (&acc)[2][4],
                   unsigned char* smem) {
  u16* sA = (u16*)smem;
  const int tid = get_tid(), lane = tid & 63, wave = tid >> 6, wm = wave >> 1, wn = wave & 1;
  const int lr = tid >> 3, lc = (tid & 7) * 8;
  const u16* ga = A + (size_t)lr * 64 + lc;
  const u16* gb = Bt + (size_t)lr * 64 + lc;
  constexpr size_t sa64 = 4096, sb64 = 4096;
  u32x4 ra0 = *(const u32x4*)(ga), ra1 = *(const u32x4*)(ga + sa64), ra2 = *(const u32x4*)(ga + 2 * sa64), ra3 = *(const u32x4*)(ga + 3 * sa64);
  u32x4 rb0 = *(const u32x4*)(gb), rb1 = *(const u32x4*)(gb + sb64), rb2 = *(const u32x4*)(gb + 2 * sb64), rb3 = *(const u32x4*)(gb + 3 * sb64);
  const int nk = K >> 6;
  const int pa_off = (wm * 64 + (lane & 31)) * 72 + (lane >> 5) * 8;
  const int pb_off = 18432 + (wn * 128 + (lane & 31)) * 72 + (lane >> 5) * 8;
  const int wa_off = lr * 72 + lc;
  const int wb_off = 18432 + lr * 72 + lc;
  __syncthreads();
  {
    u16* d = sA + wa_off;
    *(u32x4*)(d) = ra0; *(u32x4*)(d + 64 * 72) = ra1; *(u32x4*)(d + 128 * 72) = ra2; *(u32x4*)(d + 192 * 72) = ra3;
    d = sA + wb_off;
    *(u32x4*)(d) = rb0; *(u32x4*)(d + 64 * 72) = rb1; *(u32x4*)(d + 128 * 72) = rb2; *(u32x4*)(d + 192 * 72) = rb3;
  }
  if (nk > 1) {
    ga += aks; gb += bks;
    ra0 = *(const u32x4*)(ga); ra1 = *(const u32x4*)(ga + sa64); ra2 = *(const u32x4*)(ga + 2 * sa64); ra3 = *(const u32x4*)(ga + 3 * sa64);
    rb0 = *(const u32x4*)(gb); rb1 = *(const u32x4*)(gb + sb64); rb2 = *(const u32x4*)(gb + 2 * sb64); rb3 = *(const u32x4*)(gb + 3 * sb64);
  }
  __syncthreads();
  for (int kt = 0; kt < nk; ++kt) {
    const int cur = (kt & 1) * 36864, nxt = 36864 - cur;
    const bool wr = kt + 1 < nk, ld = kt + 2 < nk;
    if (ld) { ga += aks; gb += bks; }
    const u16* pa = sA + cur + pa_off;
    const u16* pb = sA + cur + pb_off;
    u16* da = sA + nxt + wa_off;
    u16* db = sA + nxt + wb_off;
#pragma unroll
    for (int s = 0; s < 4; ++s) {
      if (wr) {
        if (s == 0) { *(u32x4*)(da) = ra0; *(u32x4*)(da + 64 * 72) = ra1; }
        if (s == 1) { *(u32x4*)(da + 128 * 72) = ra2; *(u32x4*)(da + 192 * 72) = ra3; }
        if (s == 2) { *(u32x4*)(db) = rb0; *(u32x4*)(db + 64 * 72) = rb1; }
        if (s == 3) { *(u32x4*)(db + 128 * 72) = rb2; *(u32x4*)(db + 192 * 72) = rb3; }
      }
      if (ld) {
        if (s == 0) { ra0 = *(const u32x4*)(ga); ra1 = *(const u32x4*)(ga + sa64); }
        if (s == 1) { ra2 = *(const u32x4*)(ga + 2 * sa64); ra3 = *(const u32x4*)(ga + 3 * sa64); }
        if (s == 2) { rb0 = *(const u32x4*)(gb); rb1 = *(const u32x4*)(gb + sb64); }
        if (s == 3) { rb2 = *(const u32x4*)(gb + 2 * sb64); rb3 = *(const u32x4*)(gb + 3 * sb64); }
      }
      const bf16x8 a0 = *(const bf16x8*)(pa + s * 16);
      const bf16x8 a1 = *(const bf16x8*)(pa + 32 * 72 + s * 16);
      const bf16x8 b0 = *(const bf16x8*)(pb + s * 16);
      const bf16x8 b1 = *(const bf16x8*)(pb + 32 * 72 + s * 16);
      const bf16x8 b2 = *(const bf16x8*)(pb + 64 * 72 + s * 16);
      const bf16x8 b3 = *(const bf16x8*)(pb + 96 * 72 + s * 16);
      acc[0][0] = __builtin_amdgcn_mfma_f32_32x32x16_bf16(a0, b0, acc[0][0], 0, 0, 0);
      acc[0][1] = __builtin_amdgcn_mfma_f32_32x32x16_bf16(a0, b1, acc[0][1], 0, 0, 0);
      acc[0][2] = __builtin_amdgcn_mfma_f32_32x32x16_bf16(a0, b2, acc[0][2], 0, 0, 0);
      acc[0][3] = __builtin_amdgcn_mfma_f32_32x32x16_bf16(a0, b3, acc[0][3], 0, 0, 0);
      acc[1][0] = __builtin_amdgcn_mfma_f32_32x32x16_bf16(a1, b0, acc[1][0], 0, 0, 0);
      acc[1][1] = __builtin_amdgcn_mfma_f32_32x32x16_bf16(a1, b1, acc[1][1], 0, 0, 0);
      acc[1][2] = __builtin_amdgcn_mfma_f32_32x32x16_bf16(a1, b2, acc[1][2], 0, 0, 0);
      acc[1][3] = __builtin_amdgcn_mfma_f32_32x32x16_bf16(a1, b3, acc[1][3], 0, 0, 0);
      __builtin_amdgcn_sched_barrier(0);
    }
    __syncthreads();
  }
}

template <typename F>
DI void wave_epilogue(const f32x16 (&acc)[2][4], unsigned char* smem, F f) {
  const int tid = get_tid(), lane = tid & 63, wave = tid >> 6;
  float* sW = (float*)smem + wave * (32 * 132);
#pragma unroll
  for (int mi = 0; mi < 2; ++mi) {
#pragma unroll
    for (int ni = 0; ni < 4; ++ni)
#pragma unroll
      for (int r = 0; r < 16; ++r) {
        const int row = (r & 3) + 8 * (r >> 2) + 4 * (lane >> 5);
        sW[row * 132 + ni * 32 + (lane & 31)] = acc[mi][ni][r];
      }
    __builtin_amdgcn_fence(__ATOMIC_RELEASE, "wavefront");
    __builtin_amdgcn_fence(__ATOMIC_ACQUIRE, "wavefront");
    f(mi, sW);
    __builtin_amdgcn_fence(__ATOMIC_RELEASE, "wavefront");
    __builtin_amdgcn_fence(__ATOMIC_ACQUIRE, "wavefront");
  }
}

template <typename P, typename F>
DI void wave_epilogue_pre(const f32x16 (&acc)[2][4], unsigned char* smem, P pre, F f) {
  const int tid = get_tid(), lane = tid & 63, wave = tid >> 6;
  float* sW = (float*)smem + wave * (32 * 132);
#pragma unroll
  for (int mi = 0; mi < 2; ++mi) {
    pre(mi);
#pragma unroll
    for (int ni = 0; ni < 4; ++ni)
#pragma unroll
      for (int r = 0; r < 16; ++r) {
        const int row = (r & 3) + 8 * (r >> 2) + 4 * (lane >> 5);
        sW[row * 132 + ni * 32 + (lane & 31)] = acc[mi][ni][r];
      }
    __builtin_amdgcn_fence(__ATOMIC_RELEASE, "wavefront");
    __builtin_amdgcn_fence(__ATOMIC_ACQUIRE, "wavefront");
    f(mi, sW);
    __builtin_amdgcn_fence(__ATOMIC_RELEASE, "wavefront");
    __builtin_amdgcn_fence(__ATOMIC_ACQUIRE, "wavefront");
  }
}

template <typename F>
DI void slab_rows(const float* sW, F f) {
  const int lane = get_tid() & 63, rsub = lane >> 3, chunk = lane & 7;
#pragma unroll
  for (int i = 0; i < 4; ++i)
#pragma unroll
    for (int hf = 0; hf < 2; ++hf) {
      const int row = i * 8 + rsub, c = hf * 64 + chunk * 8;
      float v[8];
      const float4 a = *(const float4*)(sW + row * 132 + c), b = *(const float4*)(sW + row * 132 + c + 4);
      v[0] = a.x; v[1] = a.y; v[2] = a.z; v[3] = a.w; v[4] = b.x; v[5] = b.y; v[6] = b.z; v[7] = b.w;
      f(row, c, v, i);
    }
}

DI void slab_store_transposed(const float* sW, u16* __restrict__ dst, size_t ldd) {
  const int lane = get_tid() & 63;
#pragma unroll
  for (int dd = 0; dd < 2; ++dd)
#pragma unroll
    for (int j = 0; j < 4; ++j) {
      const int d = lane + 64 * dd;
      float v[8];
#pragma unroll
      for (int e = 0; e < 8; ++e) v[e] = sW[(j * 8 + e) * 132 + d];
      *(uint4*)(dst + (size_t)d * ldd + j * 8) = pack8(v);
    }
}

DI void step_memkv(const Params& p, unsigned char* smem) {
  for (int t = blockIdx.x; t < 16 * 8; t += gridDim.x) {
    const int mt = t % 16, nt = t / 16;
    f32x16 acc[2][4];
    zero_acc(acc);
    gemm_kloop(p.mem_n() + (size_t)mt * 256 * 64, (size_t)4096 * 64, p.wt_memkv() + (size_t)nt * 256 * 64, (size_t)2048 * 64, 1024, acc, smem);
    const int wave = get_tid() >> 6, wm = wave >> 1, wn = wave & 1;
    wave_epilogue(acc, smem, [&](int mi, const float* sW) {
      const int r0 = wm * 64 + mi * 32;
      if (nt < 4) {
        u16* dst = p.memk() + ((size_t)mt * 256 + r0) * 1024 + nt * 256 + wn * 128;
        slab_rows(sW, [&](int row, int c, const float* v, int i_) { *(uint4*)(dst + (size_t)row * 1024 + c) = pack8(v); });
      } else {
        const int hh = nt - 4;
        slab_store_transposed(sW, p.memvt() + ((size_t)(mt * 4 + hh) * 256 + wn * 128) * 256 + r0, 256);
      }
    });
  }
}

DI void memk_norm_row(const Params& p, int row) {
  const int lane = get_tid() & 63;
  u16* ptr = p.memk() + (size_t)row * 1024 + lane * 16;
  float v[16];
  unpack8(*(const uint4*)ptr, v);
  unpack8(*(const uint4*)(ptr + 8), v + 8);
  float ss = 0.f;
#pragma unroll
  for (int e = 0; e < 16; ++e) ss += v[e] * v[e];
#pragma unroll
  for (int o = 1; o <= 8; o <<= 1) ss += __shfl_xor(ss, o);
  const float sc = rsqrtf(ss * (1.f / 256.f) + EPS);
  const float* g = p.mem_k_norm_g + (lane & 15) * 16;
#pragma unroll
  for (int e = 0; e < 16; ++e) v[e] *= sc * g[e];
  *(uint4*)ptr = pack8(v);
  *(uint4*)(ptr + 8) = pack8(v + 8);
}

DI void step_gemm1(const Params& p, int pass, bool first, unsigned char* smem) {
  if (pass == 0 && first) {
    for (int it = blockIdx.x; it < 512; it += gridDim.x) memk_norm_row(p, it * 8 + (get_tid() >> 6));
  }
  const u16* A = p.h() + (size_t)pass * TOK * 64;
  constexpr int MT = TOK / 256;
  for (int t = blockIdx.x; t < MT * 44; t += gridDim.x) {
    const int mt = t % MT, nt = t / MT;
    f32x16 acc[2][4];
    zero_acc(acc);
    gemm_kloop(A + (size_t)mt * 256 * 64, (size_t)65536 * 64, p.wt_in() + (size_t)nt * 256 * 64, (size_t)11264 * 64, 1024, acc, smem);
    const int wave = get_tid() >> 6, wm = wave >> 1, wn = wave & 1;
    const int seg = nt >> 2, cb = (nt & 3) * 256 + wn * 128;
    wave_epilogue(acc, smem, [&](int mi, const float* sW) {
      const size_t rowbase = (size_t)mt * 256 + wm * 64 + mi * 32;
      if (seg == 0 || seg == 6) {
        u16* dst = (seg == 0 ? p.xr() : p.qm()) + rowbase * 1024 + cb;
        slab_rows(sW, [&](int row, int c, const float* v, int i_) { *(uint4*)(dst + (size_t)row * 1024 + c) = pack8(v); });
      } else if (seg == 1 || seg == 5 || seg == 7) {
        u16* dst = (seg == 1 ? p.grs() : seg == 5 ? p.gas() : p.gms()) + rowbase * 1024 + cb;
        slab_rows(sW, [&](int row, int c, const float* v, int i_) {
          float o[8];
#pragma unroll
          for (int e = 0; e < 8; ++e) o[e] = silu(v[e]);
          *(uint4*)(dst + (size_t)row * 1024 + c) = pack8(o);
        });
      } else if (seg == 2 || seg == 3) {
        float ss[4] = {0.f, 0.f, 0.f, 0.f};
        slab_rows(sW, [&](int row, int c, const float* v, int i_) {
#pragma unroll
          for (int e = 0; e < 8; ++e) ss[i_] += v[e] * v[e];
        });
        float sc[4];
#pragma unroll
        for (int q_ = 0; q_ < 4; ++q_) {
          float t_ = ss[q_];
          t_ += __shfl_xor(t_, 1); t_ += __shfl_xor(t_, 2); t_ += __shfl_xor(t_, 4);
          sc[q_] = rsqrtf(t_ * (1.f / 128.f) + EPS) * (seg == 2 ? 0.08838834764831845f * 1.4426950408889634f : 1.f);
        }
        const float* g = seg == 2 ? p.q_norm_g : p.k_norm_g;
        float4 gq_[2][2];
        { const int ch_ = (get_tid() & 7) * 8; gq_[0][0] = *(const float4*)(g + ch_); gq_[0][1] = *(const float4*)(g + ch_ + 4); gq_[1][0] = *(const float4*)(g + 64 + ch_); gq_[1][1] = *(const float4*)(g + 64 + ch_ + 4); }
        u16* dst = (seg == 2 ? p.qn() : p.kn()) + rowbase * 1024 + cb;
        slab_rows(sW, [&](int row, int c, const float* v, int i_) {
          float o[8];
          const float4 g0 = gq_[c >> 6][0], g1 = gq_[c >> 6][1];
          const float s_ = sc[i_];
          o[0] = v[0] * s_ * g0.x; o[1] = v[1] * s_ * g0.y; o[2] = v[2] * s_ * g0.z; o[3] = v[3] * s_ * g0.w;
          o[4] = v[4] * s_ * g1.x; o[5] = v[5] * s_ * g1.y; o[6] = v[6] * s_ * g1.z; o[7] = v[7] * s_ * g1.w;
          *(uint4*)(dst + (size_t)row * 1024 + c) = pack8(o);
        });
      } else if (seg == 4) {
        const int bl = mt >> 4, s0 = (mt & 15) * 256 + wm * 64 + mi * 32, hh = cb >> 7;
        slab_store_transposed(sW, p.vt() + (size_t)(bl * 8 + hh) * 128 * 4096 + s0, 4096);
      } else {
        const int gc = (nt - 32) * 256 + wn * 128;
        const float* bm = p.b_merge + gc;
        float4 bq_[2][2];
        { const int ch_ = (get_tid() & 7) * 8; bq_[0][0] = *(const float4*)(bm + ch_); bq_[0][1] = *(const float4*)(bm + ch_ + 4); bq_[1][0] = *(const float4*)(bm + 64 + ch_); bq_[1][1] = *(const float4*)(bm + 64 + ch_ + 4); }
        u16* dst = p.gsig() + rowbase * 3072 + gc;
        slab_rows(sW, [&](int row, int c, const float* v, int i_) {
          float o[8];
          const float4 b0 = bq_[c >> 6][0], b1 = bq_[c >> 6][1];
          o[0] = sigm(v[0] + b0.x); o[1] = sigm(v[1] + b0.y); o[2] = sigm(v[2] + b0.z); o[3] = sigm(v[3] + b0.w);
          o[4] = sigm(v[4] + b1.x); o[5] = sigm(v[5] + b1.y); o[6] = sigm(v[6] + b1.z); o[7] = sigm(v[7] + b1.w);
          *(uint4*)(dst + (size_t)row * 3072 + c) = pack8(o);
        });
      }
    });
  }
}

template <int HD, bool BAND>
DI void attn_core(const u16* __restrict__ Q, const u16* __restrict__ K, const u16* __restrict__ Vt, int ldv, int u0, int u1,
                  const float* __restrict__ bias_row, const float* __restrict__ qg,
                  u16* __restrict__ Out, size_t orow0, int okb, const u16* __restrict__ Gate, unsigned char* smem) {
  constexpr int KS = HD / 32, DB = HD / 16, LDK = HD + 8, NCH = HD / 64;
  u16* sK = (u16*)smem;
  u16* sV = (u16*)(smem + 64 * LDK * 2);
  float* sBias = (float*)(smem + 64 * LDK * 2 + HD * 72 * 2);
  const int tid = get_tid(), lane = tid & 63, w = tid >> 6, l15 = lane & 15, g = lane >> 4, sb = w >> 2, wq = w & 3;
  __syncthreads();
  if (BAND) { for (int i = tid; i < 513; i += 512) sBias[i] = bias_row[i] * 1.4426950408889634f; }
  const float bias_far = BAND ? bias_row[512] * 1.4426950408889634f : 0.f;
  bf16x8 qf[KS];
  {
    const u16* qrow = Q + (size_t)(w * 16 + l15) * 1024 + g * 8;
#pragma unroll
    for (int ks = 0; ks < KS; ++ks) qf[ks] = *(const bf16x8*)(qrow + ks * 32);
    if (!BAND) {
      float ss = 0.f;
#pragma unroll
      for (int ks = 0; ks < KS; ++ks) {
        float v[8];
        unpack8(__builtin_bit_cast(uint4, qf[ks]), v);
#pragma unroll
        for (int e = 0; e < 8; ++e) ss += v[e] * v[e];
      }
      ss += __shfl_xor(ss, 16);
      ss += __shfl_xor(ss, 32);
      const float sc = rsqrtf(ss * (1.f / HD) + EPS) * (0.0625f * 1.4426950408889634f);
#pragma unroll
      for (int ks = 0; ks < KS; ++ks) {
        float v[8];
        unpack8(__builtin_bit_cast(uint4, qf[ks]), v);
        const float4 g0 = *(const float4*)(qg + ks * 32 + g * 8), g1 = *(const float4*)(qg + ks * 32 + g * 8 + 4);
        v[0] *= sc * g0.x; v[1] *= sc * g0.y; v[2] *= sc * g0.z; v[3] *= sc * g0.w;
        v[4] *= sc * g1.x; v[5] *= sc * g1.y; v[6] *= sc * g1.z; v[7] *= sc * g1.w;
        qf[ks] = __builtin_bit_cast(bf16x8, pack8(v));
      }
    }
  }
  f32x4 o[DB];
#pragma unroll
  for (int db = 0; db < DB; ++db) o[db] = f32x4{0.f, 0.f, 0.f, 0.f};
  float m = -1e30f, lsum = 0.f;

  const int krow = tid >> 3, kpart = (tid & 7) * (HD / 8);
  u32x4 rkA[NCH], rvA[NCH], rkB[HD == 128 ? NCH : 1], rvB[HD == 128 ? NCH : 1];
  auto load_tile = [&](int u, auto& rk, auto& rv) {
    const u16* ksrc = K + ((size_t)u * 64 + krow) * 1024 + kpart;
#pragma unroll
    for (int i = 0; i < NCH; ++i) rk[i] = *(const u32x4*)(ksrc + i * 8);
#pragma unroll
    for (int i = 0; i < NCH; ++i) {
      const int id = tid + 512 * i, d = id >> 3, cc = id & 7;
      rv[i] = *(const u32x4*)(Vt + (size_t)d * ldv + u * 64 + cc * 8);
    }
  };
  auto store_tile = [&](const auto& rk, const auto& rv) {
#pragma unroll
    for (int i = 0; i < NCH; ++i) *(u32x4*)(sK + krow * LDK + kpart + i * 8) = rk[i];
#pragma unroll
    for (int i = 0; i < NCH; ++i) {
      const int id = tid + 512 * i, d = id >> 3, cc = id & 7;
      *(u32x4*)(sV + d * 72 + cc * 8) = rv[i];
    }
  };
  auto compute_tile = [&](int u) {
    if (BAND && (u < sb || u > sb + 8)) return;
    f32x4 s[4];
#pragma unroll
    for (int kb = 0; kb < 4; ++kb) {
      s[kb] = f32x4{0.f, 0.f, 0.f, 0.f};
#pragma unroll
      for (int ks = 0; ks < KS; ++ks) {
        const bf16x8 kf = *(const bf16x8*)(sK + (kb * 16 + l15) * LDK + ks * 32 + g * 8);
        s[kb] = __builtin_amdgcn_mfma_f32_16x16x32_bf16(kf, qf[ks], s[kb], 0, 0, 0);
      }
      if (HD > 128) __builtin_amdgcn_sched_barrier(0);
    }
    float mx = -1e30f;
    if (BAND) {
      if ((8 + sb - u) * 64 - 63 >= 256) {
#pragma unroll
        for (int kb = 0; kb < 4; ++kb)
#pragma unroll
          for (int i = 0; i < 4; ++i) s[kb][i] += bias_far;
      } else {
        const int dbase = (8 + sb - u) * 64 + (wq * 16 + l15) - g * 4 + 256;
#pragma unroll
        for (int kb = 0; kb < 4; ++kb)
#pragma unroll
          for (int i = 0; i < 4; ++i) s[kb][i] += sBias[min(dbase - (kb * 16 + i), 512)];
      }
    }
#pragma unroll
    for (int kb = 0; kb < 4; ++kb)
#pragma unroll
      for (int i = 0; i < 4; ++i) mx = fmaxf(mx, s[kb][i]);
    mx = fmaxf(mx, __shfl_xor(mx, 16));
    mx = fmaxf(mx, __shfl_xor(mx, 32));
    const float mn = fmaxf(m, mx);
    const float alpha = __builtin_amdgcn_exp2f(m - mn);
    m = mn;
    lsum *= alpha;
#pragma unroll
    for (int db = 0; db < DB; ++db) { o[db][0] *= alpha; o[db][1] *= alpha; o[db][2] *= alpha; o[db][3] *= alpha; }
    bf16x8 pf[2];
#pragma unroll
    for (int k2 = 0; k2 < 2; ++k2) {
      float pv[8];
#pragma unroll
      for (int i = 0; i < 4; ++i) {
        pv[i] = __builtin_amdgcn_exp2f(s[2 * k2][i] - mn);
        pv[4 + i] = __builtin_amdgcn_exp2f(s[2 * k2 + 1][i] - mn);
      }
#pragma unroll
      for (int e = 0; e < 8; ++e) lsum += pv[e];
      pf[k2] = __builtin_bit_cast(bf16x8, pack8(pv));
    }
#pragma unroll
    for (int db = 0; db < DB; ++db) {
#pragma unroll
      for (int k2 = 0; k2 < 2; ++k2) {
        const u16* vp = sV + (db * 16 + l15) * 72 + k2 * 32 + g * 4;
        const uint2 lo = *(const uint2*)vp, hi = *(const uint2*)(vp + 16);
        uint4 vv; vv.x = lo.x; vv.y = lo.y; vv.z = hi.x; vv.w = hi.y;
        o[db] = __builtin_amdgcn_mfma_f32_16x16x32_bf16(__builtin_bit_cast(bf16x8, vv), pf[k2], o[db], 0, 0, 0);
      }
      if (HD > 128 && (db & 3) == 3) __builtin_amdgcn_sched_barrier(0);
    }
  };
  load_tile(u0, rkA, rvA);
  if (HD == 128) {
    if (u0 + 1 < u1) load_tile(u0 + 1, rkB, rvB);
    for (int u = u0; u < u1; u += 2) {
      __syncthreads();
      store_tile(rkA, rvA);
      __syncthreads();
      if (u + 2 < u1) load_tile(u + 2, rkA, rvA);
      compute_tile(u);
      if (u + 1 < u1) {
        __syncthreads();
        store_tile(rkB, rvB);
        __syncthreads();
        if (u + 3 < u1) load_tile(u + 3, rkB, rvB);
        compute_tile(u + 1);
      }
    }
  } else {
    for (int u = u0; u < u1; ++u) {
      __syncthreads();
      store_tile(rkA, rvA);
      __syncthreads();
      if (u + 1 < u1) load_tile(u + 1, rkA, rvA);
      compute_tile(u);
    }
  }
  lsum += __shfl_xor(lsum, 16);
  lsum += __shfl_xor(lsum, 32);
  const float inv = 1.f / lsum;
  {
    const size_t ro = (size_t)(w * 16 + l15) * 1024 + g * 4;
    uint2 gall[DB];
#pragma unroll
    for (int db = 0; db < DB; ++db) gall[db] = *(const uint2*)(Gate + ro + db * 16);
#pragma unroll
    for (int db = 0; db < DB; ++db) {
      const uint2 gv = gall[db];
      uint2 ov;
      ov.x = pack2(o[db][0] * inv * __uint_as_float(gv.x << 16), o[db][1] * inv * __uint_as_float(gv.x & 0xffff0000u));
      ov.y = pack2(o[db][2] * inv * __uint_as_float(gv.y << 16), o[db][3] * inv * __uint_as_float(gv.y & 0xffff0000u));
      *(uint2*)(Out + ((size_t)((okb >> 6) + (db >> 2)) * TOK + orow0 + w * 16 + l15) * 64 + (db & 3) * 16 + g * 4) = ov;
    }
  }
}

DI void band_core(const u16* __restrict__ Q, const u16* __restrict__ K, const u16* __restrict__ Vt, int u0,
                  const float* __restrict__ bias_row, u16* __restrict__ Out, size_t orow0, int okb, const u16* __restrict__ Gate,
                  unsigned char* smem) {
  constexpr int HD = 128, KS = 4, DB = 8, LDK = HD + 8, NCH = 2, U1 = 12;
  u16* sK = (u16*)smem;
  u16* sV = (u16*)(smem + 64 * LDK * 2);
  float* sBias = (float*)(smem + 64 * LDK * 2 + HD * 72 * 2);
  const int tid = get_tid(), lane = tid & 63, w = tid >> 6, l15 = lane & 15, g = lane >> 4, sbq = w >> 1, wh = w & 1;
  __syncthreads();
  for (int i = tid; i < 513; i += 512) sBias[i] = bias_row[i] * 1.4426950408889634f;
  const float bias_far = bias_row[512] * 1.4426950408889634f;
  bf16x8 qf[2][KS];
#pragma unroll
  for (int qb = 0; qb < 2; ++qb) {
    const u16* qrow = Q + (size_t)(w * 32 + qb * 16 + l15) * 1024 + g * 8;
#pragma unroll
    for (int ks = 0; ks < KS; ++ks) qf[qb][ks] = *(const bf16x8*)(qrow + ks * 32);
  }
  f32x4 o[2][DB];
#pragma unroll
  for (int qb = 0; qb < 2; ++qb)
#pragma unroll
    for (int db = 0; db < DB; ++db) o[qb][db] = f32x4{0.f, 0.f, 0.f, 0.f};
  float m[2] = {-1e30f, -1e30f}, lsum[2] = {0.f, 0.f};

  const int krow = tid >> 3, kpart = (tid & 7) * (HD / 8);
  u32x4 rkA[NCH], rvA[NCH], rkB[NCH], rvB[NCH];
  auto load_tile = [&](int u, u32x4 (&rk)[NCH], u32x4 (&rv)[NCH]) {
    const u16* ksrc = K + ((size_t)u * 64 + krow) * 1024 + kpart;
#pragma unroll
    for (int i = 0; i < NCH; ++i) rk[i] = *(const u32x4*)(ksrc + i * 8);
#pragma unroll
    for (int i = 0; i < NCH; ++i) {
      const int id = tid + 512 * i, d = id >> 3, cc = id & 7;
      rv[i] = *(const u32x4*)(Vt + (size_t)d * 4096 + u * 64 + cc * 8);
    }
  };
  auto store_tile = [&](const u32x4 (&rk)[NCH], const u32x4 (&rv)[NCH]) {
#pragma unroll
    for (int i = 0; i < NCH; ++i) *(u32x4*)(sK + krow * LDK + kpart + i * 8) = rk[i];
#pragma unroll
    for (int i = 0; i < NCH; ++i) {
      const int id = tid + 512 * i, d = id >> 3, cc = id & 7;
      *(u32x4*)(sV + d * 72 + cc * 8) = rv[i];
    }
  };
  auto compute_tile = [&](int u) {
    if (u < sbq || u > sbq + 8) return;
    f32x4 s[2][4];
#pragma unroll
    for (int kb = 0; kb < 4; ++kb) {
      s[0][kb] = f32x4{0.f, 0.f, 0.f, 0.f};
      s[1][kb] = f32x4{0.f, 0.f, 0.f, 0.f};
#pragma unroll
      for (int ks = 0; ks < KS; ++ks) {
        const bf16x8 kf = *(const bf16x8*)(sK + (kb * 16 + l15) * LDK + ks * 32 + g * 8);
        s[0][kb] = __builtin_amdgcn_mfma_f32_16x16x32_bf16(kf, qf[0][ks], s[0][kb], 0, 0, 0);
        s[1][kb] = __builtin_amdgcn_mfma_f32_16x16x32_bf16(kf, qf[1][ks], s[1][kb], 0, 0, 0);
      }
    }
    bf16x8 pf[2][2];
#pragma unroll
    for (int qb = 0; qb < 2; ++qb) {
      if ((8 + sbq - u) * 64 - 63 >= 256) {
#pragma unroll
        for (int kb = 0; kb < 4; ++kb)
#pragma unroll
          for (int i = 0; i < 4; ++i) s[qb][kb][i] += bias_far;
      } else {
        const int dbase = (8 + sbq - u) * 64 + (wh * 32 + qb * 16 + l15) - g * 4 + 256;
#pragma unroll
        for (int kb = 0; kb < 4; ++kb)
#pragma unroll
          for (int i = 0; i < 4; ++i) s[qb][kb][i] += sBias[min(dbase - (kb * 16 + i), 512)];
      }
      float mx = -1e30f;
#pragma unroll
      for (int kb = 0; kb < 4; ++kb)
#pragma unroll
        for (int i = 0; i < 4; ++i) mx = fmaxf(mx, s[qb][kb][i]);
      mx = fmaxf(mx, __shfl_xor(mx, 16));
      mx = fmaxf(mx, __shfl_xor(mx, 32));
      const float mn = fmaxf(m[qb], mx);
      const float alpha = __builtin_amdgcn_exp2f(m[qb] - mn);
      m[qb] = mn;
      lsum[qb] *= alpha;
#pragma unroll
      for (int db = 0; db < DB; ++db) { o[qb][db][0] *= alpha; o[qb][db][1] *= alpha; o[qb][db][2] *= alpha; o[qb][db][3] *= alpha; }
#pragma unroll
      for (int k2 = 0; k2 < 2; ++k2) {
        float pv[8];
#pragma unroll
        for (int i = 0; i < 4; ++i) {
          pv[i] = __builtin_amdgcn_exp2f(s[qb][2 * k2][i] - mn);
          pv[4 + i] = __builtin_amdgcn_exp2f(s[qb][2 * k2 + 1][i] - mn);
        }
#pragma unroll
        for (int e = 0; e < 8; ++e) lsum[qb] += pv[e];
        pf[qb][k2] = __builtin_bit_cast(bf16x8, pack8(pv));
      }
    }
#pragma unroll
    for (int db = 0; db < DB; ++db) {
#pragma unroll
      for (int k2 = 0; k2 < 2; ++k2) {
        const u16* vp = sV + (db * 16 + l15) * 72 + k2 * 32 + g * 4;
        const uint2 lo = *(const uint2*)vp, hi = *(const uint2*)(vp + 16);
        uint4 vv; vv.x = lo.x; vv.y = lo.y; vv.z = hi.x; vv.w = hi.y;
        const bf16x8 vf = __builtin_bit_cast(bf16x8, vv);
        o[0][db] = __builtin_amdgcn_mfma_f32_16x16x32_bf16(vf, pf[0][k2], o[0][db], 0, 0, 0);
        o[1][db] = __builtin_amdgcn_mfma_f32_16x16x32_bf16(vf, pf[1][k2], o[1][db], 0, 0, 0);
      }
    }
  };
  load_tile(u0, rkA, rvA);
  if (u0 + 1 < U1) load_tile(u0 + 1, rkB, rvB);
  for (int u = u0; u < U1; u += 2) {
    __syncthreads();
    store_tile(rkA, rvA);
    __syncthreads();
    if (u + 2 < U1) load_tile(u + 2, rkA, rvA);
    compute_tile(u);
    if (u + 1 < U1) {
      __syncthreads();
      store_tile(rkB, rvB);
      __syncthreads();
      if (u + 3 < U1) load_tile(u + 3, rkB, rvB);
      compute_tile(u + 1);
    }
  }
#pragma unroll
  for (int qb = 0; qb < 2; ++qb) {
    float ls = lsum[qb];
    ls += __shfl_xor(ls, 16);
    ls += __shfl_xor(ls, 32);
    const float inv = 1.f / ls;
    const int r = w * 32 + qb * 16 + l15;
    const size_t ro = (size_t)r * 1024 + g * 4;
    uint2 gall[DB];
#pragma unroll
    for (int db = 0; db < DB; ++db) gall[db] = *(const uint2*)(Gate + ro + db * 16);
#pragma unroll
    for (int db = 0; db < DB; ++db) {
      const uint2 gv = gall[db];
      uint2 ov;
      ov.x = pack2(o[qb][db][0] * inv * __uint_as_float(gv.x << 16), o[qb][db][1] * inv * __uint_as_float(gv.x & 0xffff0000u));
      ov.y = pack2(o[qb][db][2] * inv * __uint_as_float(gv.y << 16), o[qb][db][3] * inv * __uint_as_float(gv.y & 0xffff0000u));
      *(uint2*)(Out + ((size_t)((okb >> 6) + (db >> 2)) * TOK + orow0 + r) * 64 + (db & 3) * 16 + g * 4) = ov;
    }
  }
}

DI void rnn_local_item(const Params& p, int bl, int c0, int n, const bf16x8 (&bR)[2][4], const bf16x8 (&bI)[2][4], unsigned char* smem) {
  const int tid = get_tid(), sbk = tid >> 8, tl = tid & 255, lane = tid & 63, w = tl >> 6, l15 = lane & 15, g = lane >> 4;
  unsigned char* sm = smem + sbk * 67584;
  float* sxc = (float*)sm;
  float* sa = (float*)(sm + 33792);
  u16* sxcb = (u16*)(sm + 33792);
  const int c = c0 + sbk;
  const int ch0 = n * 128;
  const size_t tok0 = (size_t)bl * 4096 + c * 64;
  __syncthreads();
  {
    const int c8 = (tl & 15) * 8, t4 = (tl >> 4) * 4;
    const u16* src = p.xr() + tok0 * 1024 + ch0 + c8;
    uint4 xr_[7];
#pragma unroll
    for (int j = 0; j < 7; ++j) {
      const int t = t4 - 3 + j;
      if (c * 64 + t >= 0) xr_[j] = *(const uint4*)(src + (ptrdiff_t)t * 1024);
      else xr_[j] = uint4{0u, 0u, 0u, 0u};
    }
    float wv[4][8], cbv[8];
#pragma unroll
    for (int k = 0; k < 4; ++k) {
      const float4 w0 = *(const float4*)(p.conv_w + k * 1024 + ch0 + c8), w1 = *(const float4*)(p.conv_w + k * 1024 + ch0 + c8 + 4);
      wv[k][0] = w0.x; wv[k][1] = w0.y; wv[k][2] = w0.z; wv[k][3] = w0.w; wv[k][4] = w1.x; wv[k][5] = w1.y; wv[k][6] = w1.z; wv[k][7] = w1.w;
    }
    {
      const float4 b0 = *(const float4*)(p.conv_b + ch0 + c8), b1 = *(const float4*)(p.conv_b + ch0 + c8 + 4);
      cbv[0] = b0.x; cbv[1] = b0.y; cbv[2] = b0.z; cbv[3] = b0.w; cbv[4] = b1.x; cbv[5] = b1.y; cbv[6] = b1.z; cbv[7] = b1.w;
    }
    float xf[7][8];
#pragma unroll
    for (int j = 0; j < 7; ++j) unpack8(xr_[j], xf[j]);
#pragma unroll
    for (int tt = 0; tt < 4; ++tt) {
      float xc[8];
#pragma unroll
      for (int e = 0; e < 8; ++e)
        xc[e] = wv[0][e] * xf[tt][e] + wv[1][e] * xf[tt + 1][e] + wv[2][e] * xf[tt + 2][e] + wv[3][e] * xf[tt + 3][e] + cbv[e];
      float* d = sxc + (t4 + tt) * 132 + c8;
      *(float4*)d = float4{xc[0], xc[1], xc[2], xc[3]};
      *(float4*)(d + 4) = float4{xc[4], xc[5], xc[6], xc[7]};
      *(uint4*)(sxcb + (t4 + tt) * 136 + c8) = pack8(xc);
    }
  }
  __syncthreads();
  f32x4 accR[4][2], accI[4][2];
#pragma unroll
  for (int tb = 0; tb < 4; ++tb)
#pragma unroll
    for (int jb = 0; jb < 2; ++jb) { accR[tb][jb] = f32x4{0.f, 0.f, 0.f, 0.f}; accI[tb][jb] = f32x4{0.f, 0.f, 0.f, 0.f}; }
  {
#pragma unroll
    for (int tb = 0; tb < 4; ++tb)
#pragma unroll
      for (int ks = 0; ks < 4; ++ks) {
        const bf16x8 af = *(const bf16x8*)(sxcb + (tb * 16 + l15) * 136 + ks * 32 + g * 8);
#pragma unroll
        for (int jb = 0; jb < 2; ++jb) {
          accR[tb][jb] = __builtin_amdgcn_mfma_f32_16x16x32_bf16(af, bR[jb][ks], accR[tb][jb], 0, 0, 0);
          accI[tb][jb] = __builtin_amdgcn_mfma_f32_16x16x32_bf16(af, bI[jb][ks], accI[tb][jb], 0, 0, 0);
        }
      }
  }
  __syncthreads();
#pragma unroll
  for (int jb = 0; jb < 2; ++jb) {
    const int ch = 32 * w + jb * 16 + l15;
    const float ba = p.lru_ba[ch0 + ch], bx = p.lru_bx[ch0 + ch];
    const float sp = log1pf(expf(-p.lru_lambda[ch0 + ch]));
#pragma unroll
    for (int tb = 0; tb < 4; ++tb)
#pragma unroll
      for (int r = 0; r < 4; ++r) {
        const int t = tb * 16 + g * 4 + r;
        const float rg = sigm(accR[tb][jb][r] + ba), ig = sigm(accI[tb][jb][r] + bx);
        const float la = -8.f * rg * sp;
        const float a = __expf(la);
        const float mult = __builtin_amdgcn_sqrtf(fmaxf(1.f - __expf(2.f * la), 0.f));
        const float xc = sxc[t * 132 + ch];
        sa[t * 132 + ch] = a;
        sxc[t * 132 + ch] = mult * (ig * xc);
      }
  }
  __syncthreads();
  {
    const int ch = tl & 127, half = tl >> 7, tb = half * 32;
    float hh = 0.f, A = 1.f;
#pragma unroll 8
    for (int t = tb; t < tb + 32; ++t) {
      const float a = sa[t * 132 + ch];
      hh = a * hh + sxc[t * 132 + ch];
      A *= a;
      sxc[t * 132 + ch] = hh;
      sa[t * 132 + ch] = A;
    }
    __syncthreads();
  }
  {
    const int c8 = (tl & 15) * 8, r0 = tl >> 4;
    float cH[8], cA[8];
    {
      const float4 h0 = *(const float4*)(sxc + 31 * 132 + c8), h1 = *(const float4*)(sxc + 31 * 132 + c8 + 4);
      const float4 a0 = *(const float4*)(sa + 31 * 132 + c8), a1 = *(const float4*)(sa + 31 * 132 + c8 + 4);
      cH[0] = h0.x; cH[1] = h0.y; cH[2] = h0.z; cH[3] = h0.w; cH[4] = h1.x; cH[5] = h1.y; cH[6] = h1.z; cH[7] = h1.w;
      cA[0] = a0.x; cA[1] = a0.y; cA[2] = a0.z; cA[3] = a0.w; cA[4] = a1.x; cA[5] = a1.y; cA[6] = a1.z; cA[7] = a1.w;
    }
#pragma unroll
    for (int i = 0; i < 4; ++i) {
      const int row = r0 + 16 * i;
      const float4 h0 = *(const float4*)(sxc + row * 132 + c8), h1 = *(const float4*)(sxc + row * 132 + c8 + 4);
      const float4 a0 = *(const float4*)(sa + row * 132 + c8), a1 = *(const float4*)(sa + row * 132 + c8 + 4);
      float hv[8] = {h0.x, h0.y, h0.z, h0.w, h1.x, h1.y, h1.z, h1.w};
      float av[8] = {a0.x, a0.y, a0.z, a0.w, a1.x, a1.y, a1.z, a1.w};
      if (i >= 2) {
#pragma unroll
        for (int e = 0; e < 8; ++e) { hv[e] += av[e] * cH[e]; av[e] *= cA[e]; }
      }
      const size_t o = (tok0 + row) * 1024 + ch0 + c8;
      *(uint4*)(p.hloc() + o) = pack8(hv);
      *(uint4*)(p.cuma() + o) = pack8(av);
      if (row == 63) {
        float* da = p.chA() + ((size_t)bl * 64 + c) * 1024 + ch0 + c8;
        float* dh = p.chH() + ((size_t)bl * 64 + c) * 1024 + ch0 + c8;
        *(float4*)da = float4{av[0], av[1], av[2], av[3]}; *(float4*)(da + 4) = float4{av[4], av[5], av[6], av[7]};
        *(float4*)dh = float4{hv[0], hv[1], hv[2], hv[3]}; *(float4*)(dh + 4) = float4{hv[4], hv[5], hv[6], hv[7]};
      }
    }
  }
}

DI void step_mix(const Params& p, int pass, unsigned char* smem) {
  constexpr int NB = GB * 16 * 8, NM = GB * 32 * 4, NR = GB * 32 * 8;
  const bool rnn_first = ((blockIdx.x >> 3) & 1) != 0;
#pragma unroll 1
  for (int part = 0; part < 2; ++part) {
  if ((part == 0) != rnn_first) {
  for (int it = blockIdx.x; it < NB + NM; it += gridDim.x) {
    if (it < NM) {
      const int hh = it & 3, tt = (it >> 2) & 31, bl = it >> 7;
      const int bgl = pass * GB + bl;
      const size_t tok = (size_t)bl * 4096 + tt * 128;
      attn_core<256, false>(p.qm() + tok * 1024 + hh * 256, p.memk() + (size_t)bgl * 256 * 1024 + hh * 256,
                            p.memvt() + (size_t)(bgl * 4 + hh) * 256 * 256, 256, 0, 4, nullptr, p.mem_q_norm_g,
                            p.mem_g(), tok, hh * 256, p.gms() + tok * 1024 + hh * 256, smem);
    } else if (it < NM + NB) {
      const int idx = it - NM;
      const int hh = idx & 7, cq = (idx >> 3) & 15, bl = idx >> 7;
      const int c0 = 4 * ((cq + 4 * bl) & 15);
      const size_t tok = (size_t)bl * 4096 + c0 * 64;
      const int u0 = c0 >= 8 ? 0 : 8 - c0;
      const u16* K0 = p.kn() + ((ptrdiff_t)bl * 4096 + (ptrdiff_t)(c0 - 8) * 64) * 1024 + hh * 128;
      const u16* V0 = p.vt() + (size_t)(bl * 8 + hh) * 128 * 4096 + (ptrdiff_t)(c0 - 8) * 64;
      band_core(p.qn() + tok * 1024 + hh * 128, K0, V0, u0, p.rel_bias + hh * 513, p.att_g(), tok, hh * 128,
                p.gas() + tok * 1024 + hh * 128, smem);
    }
  }
  } else {
  int it = NB + NM + blockIdx.x;
  if (it < NB + NM + NR) {
    const int n = (it - NM - NB) & 7;
    const int tid = get_tid(), lane = tid & 63, w = (tid & 255) >> 6, l15 = lane & 15, g = lane >> 4;
    bf16x8 bR[2][4], bI[2][4];
#pragma unroll
    for (int jb = 0; jb < 2; ++jb)
#pragma unroll
      for (int ks = 0; ks < 4; ++ks) {
        const size_t off = (size_t)n * 16384 + (size_t)(32 * w + jb * 16 + l15) * 128 + ks * 32 + g * 8;
        bR[jb][ks] = *(const bf16x8*)(p.wt_a() + off);
        bI[jb][ks] = *(const bf16x8*)(p.wt_x() + off);
      }
    for (; it < NB + NM + NR; it += gridDim.x) {
      const int idx = it - NM - NB;
      const int cp = (idx >> 3) & 31, bl = idx >> 8;
      rnn_local_item(p, bl, 2 * cp, n, bR, bI, smem);
    }
  }
  }
  }
}

DI void step_rnnfin(const Params& p, unsigned char* smem) {
  float* sP = (float*)smem;
  const int tid = get_tid(), c8 = (tid & 127) * 8, q = tid >> 7;
  for (int it = blockIdx.x; it < GB * 64; it += gridDim.x) {
    const int c = it & 63, bl = it >> 6;
    float Aq[8], Hq[8];
#pragma unroll
    for (int e = 0; e < 8; ++e) { Aq[e] = 1.f; Hq[e] = 0.f; }
    {
      const float* pa = p.chA() + ((size_t)bl * 64) * 1024 + c8;
      const float* ph = p.chH() + ((size_t)bl * 64) * 1024 + c8;
#pragma unroll 4
      for (int j = 0; j < 16; ++j) {
        const int k = q * 16 + j;
        const int kk = k < c ? k : 0;
        float4 a0 = *(const float4*)(pa + (size_t)kk * 1024), a1 = *(const float4*)(pa + (size_t)kk * 1024 + 4);
        float4 h0 = *(const float4*)(ph + (size_t)kk * 1024), h1 = *(const float4*)(ph + (size_t)kk * 1024 + 4);
        if (k >= c) { a0 = float4{1.f, 1.f, 1.f, 1.f}; a1 = a0; h0 = float4{0.f, 0.f, 0.f, 0.f}; h1 = h0; }
        Hq[0] = Hq[0] * a0.x + h0.x; Hq[1] = Hq[1] * a0.y + h0.y; Hq[2] = Hq[2] * a0.z + h0.z; Hq[3] = Hq[3] * a0.w + h0.w;
        Hq[4] = Hq[4] * a1.x + h1.x; Hq[5] = Hq[5] * a1.y + h1.y; Hq[6] = Hq[6] * a1.z + h1.z; Hq[7] = Hq[7] * a1.w + h1.w;
        Aq[0] *= a0.x; Aq[1] *= a0.y; Aq[2] *= a0.z; Aq[3] *= a0.w; Aq[4] *= a1.x; Aq[5] *= a1.y; Aq[6] *= a1.z; Aq[7] *= a1.w;
      }
    }
    __syncthreads();
    {
      float* dA = sP + (q * 2 + 0) * 1024 + c8;
      float* dH = sP + (q * 2 + 1) * 1024 + c8;
      *(float4*)dA = float4{Aq[0], Aq[1], Aq[2], Aq[3]}; *(float4*)(dA + 4) = float4{Aq[4], Aq[5], Aq[6], Aq[7]};
      *(float4*)dH = float4{Hq[0], Hq[1], Hq[2], Hq[3]}; *(float4*)(dH + 4) = float4{Hq[4], Hq[5], Hq[6], Hq[7]};
    }
    __syncthreads();
    float cr[8];
#pragma unroll
    for (int e = 0; e < 8; ++e) cr[e] = 0.f;
#pragma unroll
    for (int qq = 0; qq < 4; ++qq) {
      const float* sa_ = sP + (qq * 2 + 0) * 1024 + c8;
      const float* sh_ = sP + (qq * 2 + 1) * 1024 + c8;
      const float4 a0 = *(const float4*)sa_, a1 = *(const float4*)(sa_ + 4), h0 = *(const float4*)sh_, h1 = *(const float4*)(sh_ + 4);
      cr[0] = cr[0] * a0.x + h0.x; cr[1] = cr[1] * a0.y + h0.y; cr[2] = cr[2] * a0.z + h0.z; cr[3] = cr[3] * a0.w + h0.w;
      cr[4] = cr[4] * a1.x + h1.x; cr[5] = cr[5] * a1.y + h1.y; cr[6] = cr[6] * a1.z + h1.z; cr[7] = cr[7] * a1.w + h1.w;
    }
    const size_t tok = (size_t)bl * 4096 + c * 64 + q * 16;
    u16* dst = p.rnn_g() + ((size_t)(c8 >> 6) * TOK + tok) * 64 + (c8 & 63);
#pragma unroll 1
    for (int t0 = 0; t0 < 16; t0 += 8) {
      uint4 rh[8], rc[8], rg[8];
#pragma unroll
      for (int t = 0; t < 8; ++t) {
        const size_t o = (tok + t0 + t) * 1024 + c8;
        rh[t] = *(const uint4*)(p.hloc() + o);
        rc[t] = *(const uint4*)(p.cuma() + o);
        rg[t] = *(const uint4*)(p.grs() + o);
      }
#pragma unroll
      for (int t = 0; t < 8; ++t) {
        float hl[8], cu[8], gr[8], ov[8];
        unpack8(rh[t], hl);
        unpack8(rc[t], cu);
        unpack8(rg[t], gr);
#pragma unroll
        for (int e = 0; e < 8; ++e) ov[e] = (hl[e] + cu[e] * cr[e]) * gr[e];
        *(uint4*)(dst + (size_t)(t0 + t) * 64) = pack8(ov);
      }
    }
  }
}

DI void step_proj(const Params& p, unsigned char* smem) {
  constexpr int MT = TOK / 256;
  u16* ytmp = p.ytmp();
  for (int t = blockIdx.x; t < MT * 4; t += gridDim.x) {
    const int mt = t % MT, nt = t / MT;
    const int wave = get_tid() >> 6, wm = wave >> 1, wn = wave & 1;
#pragma unroll 1
    for (int b = 0; b < 3; ++b) {
      const u16* A = (b == 0 ? p.rnn_g() : b == 1 ? p.att_g() : p.mem_g()) + (size_t)mt * 256 * 64;
      const u16* W = (b == 0 ? p.wt_prnn() : b == 1 ? p.wt_patt() : p.wt_pmem()) + (size_t)nt * 256 * 64;
      f32x16 acc[2][4];
      zero_acc(acc);
      gemm_kloop(A, (size_t)TOK * 64, W, (size_t)1024 * 64, 1024, acc, smem);
      uint4 gpre[8], ypre[8];
      const int lane_ = get_tid() & 63, rsub_ = lane_ >> 3, chunk_ = lane_ & 7;
      wave_epilogue_pre(acc, smem, [&](int mi) {
        const size_t rowbase = (size_t)mt * 256 + wm * 64 + mi * 32;
        const u16* gs = p.gsig() + rowbase * 3072 + b * 1024 + nt * 256 + wn * 128;
        const u16* yt = ytmp + ((size_t)(t * 8 + wave) * 2 + mi) * 4096 + lane_ * 8;
#pragma unroll
        for (int i = 0; i < 4; ++i)
#pragma unroll
          for (int hf = 0; hf < 2; ++hf) {
            gpre[i * 2 + hf] = *(const uint4*)(gs + (size_t)(i * 8 + rsub_) * 3072 + hf * 64 + chunk_ * 8);
            if (b != 0) ypre[i * 2 + hf] = *(const uint4*)(yt + (i * 2 + hf) * 512);
          }
      }, [&](int mi, const float* sW) {
        const size_t rowbase = (size_t)mt * 256 + wm * 64 + mi * 32;
        const int cb = nt * 256 + wn * 128;
        const u16* gs = p.gsig() + rowbase * 3072 + b * 1024 + cb;
        u16* yt = ytmp + ((size_t)(t * 8 + wave) * 2 + mi) * 4096 + (get_tid() & 63) * 8;
        u16* yo = p.y();
        slab_rows(sW, [&](int row, int c, const float* v, int i_) {
          float gv[8], o[8];
          unpack8(gpre[i_ * 2 + (c >> 6)], gv);
          u16* yp = yt + (i_ * 2 + (c >> 6)) * 512;
          if (b == 0) {
#pragma unroll
            for (int e = 0; e < 8; ++e) o[e] = v[e] * gv[e];
          } else {
            float yv_[8];
            unpack8(ypre[i_ * 2 + (c >> 6)], yv_);
#pragma unroll
            for (int e = 0; e < 8; ++e) o[e] = yv_[e] + v[e] * gv[e];
          }
          if (b < 2) {
            *(uint4*)yp = pack8(o);
          } else {
            *(uint4*)(yo + ((size_t)((cb + c) >> 6) * TOK + rowbase + row) * 64 + ((cb + c) & 63)) = pack8(o);
          }
        });
      });
    }
  }
}

DI void step_out(const Params& p, int pass, unsigned char* smem) {
  constexpr int MT = TOK / 256;
  for (int t = blockIdx.x; t < MT * 4; t += gridDim.x) {
    const int mt = t % MT, nt = t / MT;
    f32x16 acc[2][4];
    zero_acc(acc);
    gemm_kloop(p.y() + (size_t)mt * 256 * 64, (size_t)TOK * 64, p.wt_out() + (size_t)nt * 256 * 64, (size_t)1024 * 64, 1024, acc, smem);
    const int wave = get_tid() >> 6, wm = wave >> 1, wn = wave & 1;
    float4 xpre[8][2];
    const int lane_ = get_tid() & 63, rsub_ = lane_ >> 3, chunk_ = lane_ & 7;
    wave_epilogue_pre(acc, smem, [&](int mi) {
      const float* xs = p.x + ((size_t)pass * TOK + (size_t)mt * 256 + wm * 64 + mi * 32) * 1024 + nt * 256 + wn * 128;
#pragma unroll
      for (int i = 0; i < 4; ++i)
#pragma unroll
        for (int hf = 0; hf < 2; ++hf) {
          const float* s_ = xs + (size_t)(i * 8 + rsub_) * 1024 + hf * 64 + chunk_ * 8;
          xpre[i * 2 + hf][0] = *(const float4*)s_;
          xpre[i * 2 + hf][1] = *(const float4*)(s_ + 4);
        }
    }, [&](int mi, const float* sW) {
      const size_t gbase = ((size_t)pass * TOK + (size_t)mt * 256 + wm * 64 + mi * 32) * 1024 + nt * 256 + wn * 128;
      float* dst = p.out + gbase;
      slab_rows(sW, [&](int row, int c, const float* v, int i_) {
        const float4 x0 = xpre[i_ * 2 + (c >> 6)][0], x1 = xpre[i_ * 2 + (c >> 6)][1];
        float4 o0, o1;
        o0.x = x0.x + v[0]; o0.y = x0.y + v[1]; o0.z = x0.z + v[2]; o0.w = x0.w + v[3];
        o1.x = x1.x + v[4]; o1.y = x1.y + v[5]; o1.z = x1.z + v[6]; o1.w = x1.w + v[7];
        *(float4*)(dst + (size_t)row * 1024 + c) = o0;
        *(float4*)(dst + (size_t)row * 1024 + c + 4) = o1;
      });
    });
  }
}

DI void run_phase(const Params& p, int pass, int ph, bool first, unsigned char* smem) {
  if (ph == 0) step_gemm1(p, pass, first, smem);
  else if (ph == 1) step_mix(p, pass, smem);
  else if (ph == 2) step_rnnfin(p, smem);
  else if (ph == 3) step_proj(p, smem);
  else step_out(p, pass, smem);
}

__global__ void __launch_bounds__(512) mega_kernel(Params p_in) {
  __shared__ __attribute__((aligned(16))) unsigned char smem[SMEM_BYTES];
  cg::grid_group grid = cg::this_grid();
  const Params& p = p_in;
  unsigned* bar = (unsigned*)(p.ws + OFF_bar);
  unsigned nbar = 0;
  __shared__ unsigned s_xb[4];
  const unsigned xcc = (unsigned)__builtin_amdgcn_s_getreg((3 << 11) | 20) & 7u;
  if (__builtin_amdgcn_workitem_id_x() == 0) { s_xb[0] = 0u; s_xb[1] = 0u; (void)xb_add(bar + XB_XCNT(xcc), 1u); }
  __syncthreads();
  for (int step = p.step_lo; step < p.step_hi; ++step) {
    if (step == 0) step_prep(p, smem);
    else if (step == 1) step_memkv(p, smem);
    else {
      const int pass = (step - 2) / 5, ph = (step - 2) % 5;
#ifdef DUP_PH
      if (ph == DUP_PH) { run_phase(p, pass, ph, true, smem); ++nbar; xcd_barrier(bar, xcc, s_xb); run_phase(p, pass, ph, false, smem); }
      else
#endif
      run_phase(p, pass, ph, true, smem);
    }
    if (step + 1 < p.step_hi) {
      if (p.step_hi < 0) grid.sync();
      if (step >= 2 && (step - 2) % 5 == 4) {   }
      else { ++nbar; xcd_barrier(bar, xcc, s_xb); }
    }
  }
}

extern "C" void kernel_launch(void* const* d_in, const int* in_sizes, int n_in, void* d_out, int out_size, void* d_ws,
                              size_t ws_size, hipStream_t stream) {
  static int grid_blocks = 0;
  if (!grid_blocks) {
    int dev = 0, cus = 0, per_cu = 0;
    (void)hipGetDevice(&dev);
    (void)hipDeviceGetAttribute(&cus, hipDeviceAttributeMultiprocessorCount, dev);
    (void)hipOccupancyMaxActiveBlocksPerMultiprocessor(&per_cu, mega_kernel, 512, 0);
    if (per_cu > 1) per_cu = 1;
    if (per_cu < 1) per_cu = 1;
    grid_blocks = (cus * per_cu) & ~7;
  }
  Params p{};
  const float* const* in = (const float* const*)d_in;
  p.x = in[0]; p.mem = in[1]; p.norm_g = in[2]; p.mem_norm_g = in[3]; p.w_in = in[4]; p.b_merge = in[5]; p.conv_w = in[6];
  p.conv_b = in[7]; p.lru_wa = in[8]; p.lru_ba = in[9]; p.lru_wx = in[10]; p.lru_bx = in[11]; p.lru_lambda = in[12];
  p.q_norm_g = in[13]; p.k_norm_g = in[14]; p.rel_bias = in[15]; p.w_mem_kv = in[16]; p.mem_q_norm_g = in[17];
  p.mem_k_norm_g = in[18]; p.w_proj_rnn = in[19]; p.w_proj_att = in[20]; p.w_proj_mem = in[21]; p.w_out = in[22];
  p.out = (float*)d_out;
  p.ws = (unsigned char*)d_ws;
  if (WS_NEED > ws_size) { fprintf(stderr, "workspace too small: need %llu have %zu\n", WS_NEED, ws_size); return; }
  p.step_lo = 0; p.step_hi = 2 + 5 * NPASS;
  (void)hipMemsetAsync((unsigned char*)d_ws + OFF_bar, 0, 4096, stream);
  void* args[] = {&p};
  hipError_t e = hipLaunchCooperativeKernel((void*)mega_kernel, dim3(grid_blocks), dim3(512), args, 0, stream);
  if (e != hipSuccess) fprintf(stderr, "cooperative launch failed: %s (grid %d)\n", hipGetErrorString(e), grid_blocks);
}
```

```cpp
#include <hip/hip_runtime.h>
#include <hip/hip_cooperative_groups.h>
#include <cstdio>
#include <cstddef>
namespace cg = cooperative_groups;

#define DI __device__ __forceinline__
typedef unsigned short u16;
using bf16x8 = __attribute__((ext_vector_type(8))) short;
using f32x4  = __attribute__((ext_vector_type(4))) float;
using f32x16 = __attribute__((ext_vector_type(16))) float;
using u32x4  = __attribute__((ext_vector_type(4))) unsigned;

constexpr int SEQ = 4096;
constexpr int GB = 4;
constexpr int NPASS = 4;
constexpr int TOK = GB * SEQ;
constexpr int SMEM_BYTES = 147456;
constexpr int T_TR = 2816 + 1024 + 512 + 64;
constexpr int T_ROWS = 8192 + 512;
constexpr float EPS = 1e-6f;

constexpr unsigned long long ACT = (unsigned long long)TOK * 1024 * 2;
constexpr unsigned long long OFF_wt_in = 0ull;
constexpr unsigned long long OFF_wt_prnn = OFF_wt_in + ((11264ull*1024*2 + 255ull) & ~255ull);
constexpr unsigned long long OFF_wt_patt = OFF_wt_prnn + ((1024ull*1024*2 + 255ull) & ~255ull);
constexpr unsigned long long OFF_wt_pmem = OFF_wt_patt + ((1024ull*1024*2 + 255ull) & ~255ull);
constexpr unsigned long long OFF_wt_out = OFF_wt_pmem + ((1024ull*1024*2 + 255ull) & ~255ull);
constexpr unsigned long long OFF_wt_memkv = OFF_wt_out + ((1024ull*1024*2 + 255ull) & ~255ull);
constexpr unsigned long long OFF_wt_a = OFF_wt_memkv + ((2048ull*1024*2 + 255ull) & ~255ull);
constexpr unsigned long long OFF_wt_x = OFF_wt_a + ((8ull*128*128*2 + 255ull) & ~255ull);
constexpr unsigned long long OFF_h = OFF_wt_x + ((8ull*128*128*2 + 255ull) & ~255ull);
constexpr unsigned long long OFF_mem_n = OFF_h + ((65536ull*1024*2 + 255ull) & ~255ull);
constexpr unsigned long long OFF_memk = OFF_mem_n + ((4096ull*1024*2 + 255ull) & ~255ull);
constexpr unsigned long long OFF_memvt = OFF_memk + ((4096ull*1024*2 + 255ull) & ~255ull);
constexpr unsigned long long OFF_xr = OFF_memvt + ((4096ull*1024*2 + 255ull) & ~255ull);
constexpr unsigned long long OFF_grs = OFF_xr + ((ACT + 255ull) & ~255ull);
constexpr unsigned long long OFF_qn = OFF_grs + ((ACT + 255ull) & ~255ull);
constexpr unsigned long long OFF_kn = OFF_qn + ((ACT + 255ull) & ~255ull);
constexpr unsigned long long OFF_vt = OFF_kn + ((ACT + 255ull) & ~255ull);
constexpr unsigned long long OFF_gas = OFF_vt + ((ACT + 255ull) & ~255ull);
constexpr unsigned long long OFF_qm = OFF_gas + ((ACT + 255ull) & ~255ull);
constexpr unsigned long long OFF_gms = OFF_qm + ((ACT + 255ull) & ~255ull);
constexpr unsigned long long OFF_gsig = OFF_gms + ((ACT + 255ull) & ~255ull);
constexpr unsigned long long OFF_hloc = OFF_gsig + ((ACT*3 + 255ull) & ~255ull);
constexpr unsigned long long OFF_cuma = OFF_hloc + ((ACT*2 + 255ull) & ~255ull);
constexpr unsigned long long OFF_chA = OFF_cuma + ((ACT*2 + 255ull) & ~255ull);
constexpr unsigned long long OFF_chH = OFF_chA + (((unsigned long long)GB*64*1024*4 + 255ull) & ~255ull);
constexpr unsigned long long OFF_rnn_g = OFF_chH + (((unsigned long long)GB*64*1024*4 + 255ull) & ~255ull);
constexpr unsigned long long OFF_att_g = OFF_rnn_g + ((ACT + 255ull) & ~255ull);
constexpr unsigned long long OFF_mem_g = OFF_att_g + ((ACT + 255ull) & ~255ull);
constexpr unsigned long long OFF_y = OFF_mem_g + ((ACT + 255ull) & ~255ull);
constexpr unsigned long long OFF_bar = OFF_y + ((ACT + 255ull) & ~255ull);
constexpr unsigned long long WS_NEED = OFF_bar + 4096ull;
DI unsigned char* oq(unsigned char* w) { asm volatile("" : "+s"(w)); return w; }
struct Params {
  const float *x, *mem, *norm_g, *mem_norm_g, *w_in, *b_merge, *conv_w, *conv_b, *lru_wa, *lru_ba, *lru_wx, *lru_bx,
      *lru_lambda, *q_norm_g, *k_norm_g, *rel_bias, *w_mem_kv, *mem_q_norm_g, *mem_k_norm_g, *w_proj_rnn, *w_proj_att,
      *w_proj_mem, *w_out;
  float* out;
  unsigned char* ws;
  int step_lo, step_hi;
  DI u16* wt_in() const { return (u16*)(ws + OFF_wt_in); }
  DI u16* wt_prnn() const { return (u16*)(ws + OFF_wt_prnn); }
  DI u16* wt_patt() const { return (u16*)(ws + OFF_wt_patt); }
  DI u16* wt_pmem() const { return (u16*)(ws + OFF_wt_pmem); }
  DI u16* wt_out() const { return (u16*)(ws + OFF_wt_out); }
  DI u16* wt_memkv() const { return (u16*)(ws + OFF_wt_memkv); }
  DI u16* wt_a() const { return (u16*)(ws + OFF_wt_a); }
  DI u16* wt_x() const { return (u16*)(ws + OFF_wt_x); }
  DI u16* h() const { return (u16*)(ws + OFF_h); }
  DI u16* mem_n() const { return (u16*)(ws + OFF_mem_n); }
  DI u16* memk() const { return (u16*)(ws + OFF_memk); }
  DI u16* memvt() const { return (u16*)(ws + OFF_memvt); }
  DI u16* xr() const { return (u16*)(ws + OFF_xr); }
  DI u16* grs() const { return (u16*)(ws + OFF_grs); }
  DI u16* qn() const { return (u16*)(ws + OFF_qn); }
  DI u16* kn() const { return (u16*)(ws + OFF_kn); }
  DI u16* vt() const { return (u16*)(ws + OFF_vt); }
  DI u16* gas() const { return (u16*)(ws + OFF_gas); }
  DI u16* qm() const { return (u16*)(ws + OFF_qm); }
  DI u16* gms() const { return (u16*)(ws + OFF_gms); }
  DI u16* gsig() const { return (u16*)(ws + OFF_gsig); }
  DI u16* hloc() const { return (u16*)(ws + OFF_hloc); }
  DI u16* ytmp() const { return (u16*)(ws + OFF_hloc); }
  DI u16* cuma() const { return (u16*)(ws + OFF_cuma); }
  DI float* chA() const { return (float*)(ws + OFF_chA); }
  DI float* chH() const { return (float*)(ws + OFF_chH); }
  DI u16* rnn_g() const { return (u16*)(ws + OFF_rnn_g); }
  DI u16* att_g() const { return (u16*)(ws + OFF_att_g); }
  DI u16* mem_g() const { return (u16*)(ws + OFF_mem_g); }
  DI u16* y() const { return (u16*)(ws + OFF_y); }
};

#define XB_XCNT(j) (32 * (1 + (j)))
#define XB_XSUB(j) (32 * (9 + (j)))
#define XB_XGEN(j) (32 * (17 + (j)))
#define XB_TOP (32 * 25)
#define XB_TOPGEN (32 * 26)
DI unsigned xb_ld(unsigned* p) { return __hip_atomic_load(p, __ATOMIC_RELAXED, __HIP_MEMORY_SCOPE_AGENT); }
DI unsigned xb_add(unsigned* p, unsigned v) { return __hip_atomic_fetch_add(p, v, __ATOMIC_RELAXED, __HIP_MEMORY_SCOPE_AGENT); }
DI void xcd_barrier(unsigned* bar, unsigned xcc, volatile unsigned* st) {
  asm volatile("s_waitcnt vmcnt(0)" ::: "memory");
  __syncthreads();
  if (__builtin_amdgcn_workitem_id_x() == 0) {
    unsigned nloc = st[0], nx = st[1];
    if (nloc == 0u) {
      const unsigned G = gridDim.x;
      unsigned sp = 0;
      for (;;) {
        unsigned sum = 0, cnt = 0, mine = 0;
        for (unsigned j = 0; j < 8; ++j) { const unsigned c = xb_ld(bar + XB_XCNT(j)); sum += c; cnt += c > 0u ? 1u : 0u; mine = j == xcc ? c : mine; }
        nloc = mine; nx = cnt;
        if (sum == G) break;
        __builtin_amdgcn_s_sleep(1);
        if (++sp > (1u << 22)) break;
      }
      if (nloc == 0u) nloc = 1u;
      if (nx == 0u) nx = 1u;
      st[0] = nloc; st[1] = nx;
    }
    const unsigned old = xb_add(bar + XB_XSUB(xcc), 1u);
    const unsigned gen = old / nloc;
    if (old + 1u == (gen + 1u) * nloc) {
      __builtin_amdgcn_fence(__ATOMIC_RELEASE, "agent");
      asm volatile("s_waitcnt vmcnt(0)" ::: "memory");
      const unsigned og = xb_add(bar + XB_TOP, 1u);
      const unsigned tg = og / nx;
      if (og + 1u == (tg + 1u) * nx) (void)xb_add(bar + XB_TOPGEN, 1u);
      else { unsigned sp = 0; while (xb_ld(bar + XB_TOPGEN) == tg) { __builtin_amdgcn_s_sleep(1); if (++sp > (1u << 24)) break; } }
      __builtin_amdgcn_fence(__ATOMIC_ACQUIRE, "agent");
      (void)xb_add(bar + XB_XGEN(xcc), 1u);
      asm volatile("s_waitcnt vmcnt(0)" ::: "memory");
    } else {
      unsigned sp = 0;
      while (xb_ld(bar + XB_XGEN(xcc)) == gen) { __builtin_amdgcn_s_sleep(1); if (++sp > (1u << 24)) break; }
      __builtin_amdgcn_fence(__ATOMIC_ACQUIRE, "agent");
      asm volatile("s_waitcnt vmcnt(0)" ::: "memory");
    }
  }
  __syncthreads();
}
DI int get_tid() { int t = __builtin_amdgcn_workitem_id_x(); asm volatile("" : "+v"(t)); return t; }
typedef float f32x2_t __attribute__((ext_vector_type(2)));
typedef __bf16 bf16x2_t __attribute__((ext_vector_type(2)));
DI unsigned pack2(float a, float b) { f32x2_t v = {a, b}; return __builtin_bit_cast(unsigned, __builtin_convertvector(v, bf16x2_t)); }
DI u16 f2bf(float x) { return (u16)(pack2(x, x) & 0xffffu); }
DI float bf2f(u16 b) { return __uint_as_float(((unsigned)b) << 16); }
DI float sigm(float v) { return __builtin_amdgcn_rcpf(1.f + __builtin_amdgcn_exp2f(-1.4426950408889634f * v)); }
DI float silu(float v) { return v * sigm(v); }
DI uint4 pack8(const float* v) { uint4 r; r.x = pack2(v[0], v[1]); r.y = pack2(v[2], v[3]); r.z = pack2(v[4], v[5]); r.w = pack2(v[6], v[7]); return r; }
DI void unpack8(uint4 r, float* v) {
  v[0] = __uint_as_float(r.x << 16); v[1] = __uint_as_float(r.x & 0xffff0000u);
  v[2] = __uint_as_float(r.y << 16); v[3] = __uint_as_float(r.y & 0xffff0000u);
  v[4] = __uint_as_float(r.z << 16); v[5] = __uint_as_float(r.z & 0xffff0000u);
  v[6] = __uint_as_float(r.w << 16); v[7] = __uint_as_float(r.w & 0xffff0000u);
}

template <bool PANEL>
DI void transpose_tile(const float* __restrict__ src, int R, int C, u16* __restrict__ dst, int tr, int tc, float* tile) {
  const int tid = get_tid();
  __syncthreads();
#pragma unroll
  for (int i = 0; i < 2; ++i) {
    const int r = (tid >> 4) + 32 * i, c4 = (tid & 15) * 4;
    const float4 v = *(const float4*)(src + (size_t)(tr * 64 + r) * C + tc * 64 + c4);
    tile[r * 65 + c4 + 0] = v.x; tile[r * 65 + c4 + 1] = v.y; tile[r * 65 + c4 + 2] = v.z; tile[r * 65 + c4 + 3] = v.w;
  }
  __syncthreads();
  {
    const int c = tid >> 3, r8 = (tid & 7) * 8;
    float v[8];
#pragma unroll
    for (int j = 0; j < 8; ++j) v[j] = tile[(r8 + j) * 65 + c];
    if (PANEL) *(uint4*)(dst + ((size_t)tr * C + tc * 64 + c) * 64 + r8) = pack8(v);
    else *(uint4*)(dst + (size_t)(tc * 64 + c) * R + tr * 64 + r8) = pack8(v);
  }
}

DI void rms_row(const float* __restrict__ src, const float* __restrict__ g, u16* __restrict__ dst, size_t ROWS, size_t r) {
  const int lane = get_tid() & 63;
  float4 v[4];
  float ss = 0.f;
#pragma unroll
  for (int i = 0; i < 4; ++i) {
    v[i] = *(const float4*)(src + i * 256 + lane * 4);
    ss += v[i].x * v[i].x + v[i].y * v[i].y + v[i].z * v[i].z + v[i].w * v[i].w;
  }
#pragma unroll
  for (int o = 32; o >= 1; o >>= 1) ss += __shfl_xor(ss, o);
  const float rstd = rsqrtf(ss * (1.f / 1024.f) + EPS);
#pragma unroll
  for (int i = 0; i < 4; ++i) {
    const float4 gg = *(const float4*)(g + i * 256 + lane * 4);
    uint2 o;
    o.x = pack2(v[i].x * rstd * gg.x, v[i].y * rstd * gg.y);
    o.y = pack2(v[i].z * rstd * gg.z, v[i].w * rstd * gg.w);
    *(uint2*)(dst + ((size_t)(i * 4 + (lane >> 4)) * ROWS + r) * 64 + (lane & 15) * 4) = o;
  }
}

DI void step_prep(const Params& p, unsigned char* smem) {
  float* tile = (float*)smem;
  for (int it = blockIdx.x; it < T_TR + T_ROWS; it += gridDim.x) {
    if (it < T_TR) {
      int j = it;
      if (j < 2816) { transpose_tile<true>(p.w_in, 1024, 11264, p.wt_in(), j % 16, j / 16, tile); continue; }
      j -= 2816;
      if (j < 1024) {
        const int k = j >> 8, jj = j & 255;
        const float* s = k == 0 ? p.w_proj_rnn : k == 1 ? p.w_proj_att : k == 2 ? p.w_proj_mem : p.w_out;
        u16* d = k == 0 ? p.wt_prnn() : k == 1 ? p.wt_patt() : k == 2 ? p.wt_pmem() : p.wt_out();
        transpose_tile<true>(s, 1024, 1024, d, jj % 16, jj / 16, tile);
        continue;
      }
      j -= 1024;
      if (j < 512) { transpose_tile<true>(p.w_mem_kv, 1024, 2048, p.wt_memkv(), j % 16, j / 16, tile); continue; }
      j -= 512;
      {
        const int mat = j >> 5, jj = j & 31, n = jj >> 2, tr = (jj >> 1) & 1, tc = jj & 1;
        transpose_tile<false>((mat ? p.lru_wx : p.lru_wa) + n * 16384, 128, 128, (mat ? p.wt_x() : p.wt_a()) + n * 16384, tr, tc, tile);
      }
    } else {
      const int r = (it - T_TR) * 8 + (get_tid() >> 6);
      if (r < 65536) rms_row(p.x + (size_t)r * 1024, p.norm_g, p.h(), 65536, r);
      else { const int m = r - 65536; rms_row(p.mem + (size_t)m * 1024, p.mem_norm_g, p.mem_n(), 4096, m); }
    }
  }
}

DI void zero_acc(f32x16 (&acc)[2][4]) {
#pragma unroll
  for (int a = 0; a < 2; ++a)
#pragma unroll
    for (int b = 0; b < 4; ++b)
#pragma unroll
      for (int r = 0; r < 16; ++r) acc[a][b][r] = 0.f;
}

DI void gemm_kloop(const u16* __restrict__ A, size_t aks, const u16* __restrict__ Bt, size_t bks, int K, f32x16 (&acc)[2][4],
                   unsigned char* smem) {
  u16* sA = (u16*)smem;
  const int tid = get_tid(), lane = tid & 63, wave = tid >> 6, wm = wave >> 1, wn = wave & 1;
  const int lr = tid >> 3, lc = (tid & 7) * 8;
  const u16* ga = A + (size_t)lr * 64 + lc;
  const u16* gb = Bt + (size_t)lr * 64 + lc;
  constexpr size_t sa64 = 4096, sb64 = 4096;
  u32x4 ra0 = *(const u32x4*)(ga), ra1 = *(const u32x4*)(ga + sa64), ra2 = *(const u32x4*)(ga + 2 * sa64), ra3 = *(const u32x4*)(ga + 3 * sa64);
  u32x4 rb0 = *(const u32x4*)(gb), rb1 = *(const u32x4*)(gb + sb64), rb2 = *(const u32x4*)(gb + 2 * sb64), rb3 = *(const u32x4*)(gb + 3 * sb64);
  const int nk = K >> 6;
  const int pa_off = (wm * 64 + (lane & 31)) * 72 + (lane >> 5) * 8;
  const int pb_off = 18432 + (wn * 128 + (lane & 31)) * 72 + (lane >> 5) * 8;
  const int wa_off = lr * 72 + lc;
  const int wb_off = 18432 + lr * 72 + lc;
  __syncthreads();
  {
    u16* d = sA + wa_off;
    *(u32x4*)(d) = ra0; *(u32x4*)(d + 64 * 72) = ra1; *(u32x4*)(d + 128 * 72) = ra2; *(u32x4*)(d + 192 * 72) = ra3;
    d = sA + wb_off;
    *(u32x4*)(d) = rb0; *(u32x4*)(d + 64 * 72) = rb1; *(u32x4*)(d + 128 * 72) = rb2; *(u32x4*)(d + 192 * 72) = rb3;
  }
  if (nk > 1) {
    ga += aks; gb += bks;
    ra0 = *(const u32x4*)(ga); ra1 = *(const u32x4*)(ga + sa64); ra2 = *(const u32x4*)(ga + 2 * sa64); ra3 = *(const u32x4*)(ga + 3 * sa64);
    rb0 = *(const u32x4*)(gb); rb1 = *(const u32x4*)(gb + sb64); rb2 = *(const u32x4*)(gb + 2 * sb64); rb3 = *(const u32x4*)(gb + 3 * sb64);
  }
  __syncthreads();
  for (int kt = 0; kt < nk; ++kt) {
    const int cur = (kt & 1) * 36864, nxt = 36864 - cur;
    const bool wr = kt + 1 < nk, ld = kt + 2 < nk;
    if (ld) { ga += aks; gb += bks; }
    const u16* pa = sA + cur + pa_off;
    const u16* pb = sA + cur + pb_off;
    u16* da = sA + nxt + wa_off;
    u16* db = sA + nxt + wb_off;
#pragma unroll
    for (int s = 0; s < 4; ++s) {
      if (wr) {
        if (s == 0) { *(u32x4*)(da) = ra0; *(u32x4*)(da + 64 * 72) = ra1; }
        if (s == 1) { *(u32x4*)(da + 128 * 72) = ra2; *(u32x4*)(da + 192 * 72) = ra3; }
        if (s == 2) { *(u32x4*)(db) = rb0; *(u32x4*)(db + 64 * 72) = rb1; }
        if (s == 3) { *(u32x4*)(db + 128 * 72) = rb2; *(u32x4*)(db + 192 * 72) = rb3; }
      }
      if (ld) {
        if (s == 0) { ra0 = *(const u32x4*)(ga); ra1 = *(const u32x4*)(ga + sa64); }
        if (s == 1) { ra2 = *(const u32x4*)(ga + 2 * sa64); ra3 = *(const u32x4*)(ga + 3 * sa64); }
        if (s == 2) { rb0 = *(const u32x4*)(gb); rb1 = *(const u32x4*)(gb + sb64); }
        if (s == 3) { rb2 = *(const u32x4*)(gb + 2 * sb64); rb3 = *(const u32x4*)(gb + 3 * sb64); }
      }
      const bf16x8 a0 = *(const bf16x8*)(pa + s * 16);
      const bf16x8 a1 = *(const bf16x8*)(pa + 32 * 72 + s * 16);
      const bf16x8 b0 = *(const bf16x8*)(pb + s * 16);
      const bf16x8 b1 = *(const bf16x8*)(pb + 32 * 72 + s * 16);
      const bf16x8 b2 = *(const bf16x8*)(pb + 64 * 72 + s * 16);
      const bf16x8 b3 = *(const bf16x8*)(pb + 96 * 72 + s * 16);
      acc[0][0] = __builtin_amdgcn_mfma_f32_32x32x16_bf16(a0, b0, acc[0][0], 0, 0, 0);
      acc[0][1] = __builtin_amdgcn_mfma_f32_32x32x16_bf16(a0, b1, acc[0][1], 0, 0, 0);
      acc[0][2] = __builtin_amdgcn_mfma_f32_32x32x16_bf16(a0, b2, acc[0][2], 0, 0, 0);
      acc[0][3] = __builtin_amdgcn_mfma_f32_32x32x16_bf16(a0, b3, acc[0][3], 0, 0, 0);
      acc[1][0] = __builtin_amdgcn_mfma_f32_32x32x16_bf16(a1, b0, acc[1][0], 0, 0, 0);
      acc[1][1] = __builtin_amdgcn_mfma_f32_32x32x16_bf16(a1, b1, acc[1][1], 0, 0, 0);
      acc[1][2] = __builtin_amdgcn_mfma_f32_32x32x16_bf16(a1, b2, acc[1][2], 0, 0, 0);
      acc[1][3] = __builtin_amdgcn_mfma_f32_32x32x16_bf16(a1, b3, acc[1][3], 0, 0, 0);
      __builtin_amdgcn_sched_barrier(0);
    }
    __syncthreads();
  }
}

template <typename F>
DI void wave_epilogue(const f32x16 (&acc)[2][4], unsigned char* smem, F f) {
  const int tid = get_tid(), lane = tid & 63, wave = tid >> 6;
  float* sW = (float*)smem + wave * (32 * 132);
#pragma unroll
  for (int mi = 0; mi < 2; ++mi) {
#pragma unroll
    for (int ni = 0; ni < 4; ++ni)
#pragma unroll
      for (int r = 0; r < 16; ++r) {
        const int row = (r & 3) + 8 * (r >> 2) + 4 * (lane >> 5);
        sW[row * 132 + ni * 32 + (lane & 31)] = acc[mi][ni][r];
      }
    __builtin_amdgcn_fence(__ATOMIC_RELEASE, "wavefront");
    __builtin_amdgcn_fence(__ATOMIC_ACQUIRE, "wavefront");
    f(mi, sW);
    __builtin_amdgcn_fence(__ATOMIC_RELEASE, "wavefront");
    __builtin_amdgcn_fence(__ATOMIC_ACQUIRE, "wavefront");
  }
}

template <typename P, typename F>
DI void wave_epilogue_pre(const f32x16 (&acc)[2][4], unsigned char* smem, P pre, F f) {
  const int tid = get_tid(), lane = tid & 63, wave = tid >> 6;
  float* sW = (float*)smem + wave * (32 * 132);
#pragma unroll
  for (int mi = 0; mi < 2; ++mi) {
    pre(mi);
#pragma unroll
    for (int ni = 0; ni < 4; ++ni)
#pragma unroll
      for (int r = 0; r < 16; ++r) {
        const int row = (r & 3) + 8 * (r >> 2) + 4 * (lane >> 5);
        sW[row * 132 + ni * 32 + (lane & 31)] = acc[mi][ni][r];
      }
    __builtin_amdgcn_fence(__ATOMIC_RELEASE, "wavefront");
    __builtin_amdgcn_fence(__ATOMIC_ACQUIRE, "wavefront");
    f(mi, sW);
    __builtin_amdgcn_fence(__ATOMIC_RELEASE, "wavefront");
    __builtin_amdgcn_fence(__ATOMIC_ACQUIRE, "wavefront");
  }
}

template <typename F>
DI void slab_rows(const float* sW, F f) {
  const int lane = get_tid() & 63, rsub = lane >> 3, chunk = lane & 7;
#pragma unroll
  for (int i = 0; i < 4; ++i)
#pragma unroll
    for (int hf = 0; hf < 2; ++hf) {
      const int row = i * 8 + rsub, c = hf * 64 + chunk * 8;
      float v[8];
      const float4 a = *(const float4*)(sW + row * 132 + c), b = *(const float4*)(sW + row * 132 + c + 4);
      v[0] = a.x; v[1] = a.y; v[2] = a.z; v[3] = a.w; v[4] = b.x; v[5] = b.y; v[6] = b.z; v[7] = b.w;
      f(row, c, v, i);
    }
}

DI void slab_store_transposed(const float* sW, u16* __restrict__ dst, size_t ldd) {
  const int lane = get_tid() & 63;
#pragma unroll
  for (int dd = 0; dd < 2; ++dd)
#pragma unroll
    for (int j = 0; j < 4; ++j) {
      const int d = lane + 64 * dd;
      float v[8];
#pragma unroll
      for (int e = 0; e < 8; ++e) v[e] = sW[(j * 8 + e) * 132 + d];
      *(uint4*)(dst + (size_t)d * ldd + j * 8) = pack8(v);
    }
}

DI void step_memkv(const Params& p, unsigned char* smem) {
  for (int t = blockIdx.x; t < 16 * 8; t += gridDim.x) {
    const int mt = t % 16, nt = t / 16;
    f32x16 acc[2][4];
    zero_acc(acc);
    gemm_kloop(p.mem_n() + (size_t)mt * 256 * 64, (size_t)4096 * 64, p.wt_memkv() + (size_t)nt * 256 * 64, (size_t)2048 * 64, 1024, acc, smem);
    const int wave = get_tid() >> 6, wm = wave >> 1, wn = wave & 1;
    wave_epilogue(acc, smem, [&](int mi, const float* sW) {
      const int r0 = wm * 64 + mi * 32;
      if (nt < 4) {
        u16* dst = p.memk() + ((size_t)mt * 256 + r0) * 1024 + nt * 256 + wn * 128;
        slab_rows(sW, [&](int row, int c, const float* v, int i_) { *(uint4*)(dst + (size_t)row * 1024 + c) = pack8(v); });
      } else {
        const int hh = nt - 4;
        slab_store_transposed(sW, p.memvt() + ((size_t)(mt * 4 + hh) * 256 + wn * 128) * 256 + r0, 256);
      }
    });
  }
}

DI void memk_norm_row(const Params& p, int row) {
  const int lane = get_tid() & 63;
  u16* ptr = p.memk() + (size_t)row * 1024 + lane * 16;
  float v[16];
  unpack8(*(const uint4*)ptr, v);
  unpack8(*(const uint4*)(ptr + 8), v + 8);
  float ss = 0.f;
#pragma unroll
  for (int e = 0; e < 16; ++e) ss += v[e] * v[e];
#pragma unroll
  for (int o = 1; o <= 8; o <<= 1) ss += __shfl_xor(ss, o);
  const float sc = rsqrtf(ss * (1.f / 256.f) + EPS);
  const float* g = p.mem_k_norm_g + (lane & 15) * 16;
#pragma unroll
  for (int e = 0; e < 16; ++e) v[e] *= sc * g[e];
  *(uint4*)ptr = pack8(v);
  *(uint4*)(ptr + 8) = pack8(v + 8);
}

DI void step_gemm1(const Params& p, int pass, bool first, unsigned char* smem) {
  if (pass == 0 && first) {
    for (int it = blockIdx.x; it < 512; it += gridDim.x) memk_norm_row(p, it * 8 + (get_tid() >> 6));
  }
  const u16* A = p.h() + (size_t)pass * TOK * 64;
  constexpr int MT = TOK / 256;
  for (int t = blockIdx.x; t < MT * 44; t += gridDim.x) {
    const int mt = t % MT, nt = t / MT;
    f32x16 acc[2][4];
    zero_acc(acc);
    gemm_kloop(A + (size_t)mt * 256 * 64, (size_t)65536 * 64, p.wt_in() + (size_t)nt * 256 * 64, (size_t)11264 * 64, 1024, acc, smem);
    const int wave = get_tid() >> 6, wm = wave >> 1, wn = wave & 1;
    const int seg = nt >> 2, cb = (nt & 3) * 256 + wn * 128;
    wave_epilogue(acc, smem, [&](int mi, const float* sW) {
      const size_t rowbase = (size_t)mt * 256 + wm * 64 + mi * 32;
      if (seg == 0 || seg == 6) {
        u16* dst = (seg == 0 ? p.xr() : p.qm()) + rowbase * 1024 + cb;
        slab_rows(sW, [&](int row, int c, const float* v, int i_) { *(uint4*)(dst + (size_t)row * 1024 + c) = pack8(v); });
      } else if (seg == 1 || seg == 5 || seg == 7) {
        u16* dst = (seg == 1 ? p.grs() : seg == 5 ? p.gas() : p.gms()) + rowbase * 1024 + cb;
        slab_rows(sW, [&](int row, int c, const float* v, int i_) {
          float o[8];
#pragma unroll
          for (int e = 0; e < 8; ++e) o[e] = silu(v[e]);
          *(uint4*)(dst + (size_t)row * 1024 + c) = pack8(o);
        });
      } else if (seg == 2 || seg == 3) {
        float ss[4] = {0.f, 0.f, 0.f, 0.f};
        slab_rows(sW, [&](int row, int c, const float* v, int i_) {
#pragma unroll
          for (int e = 0; e < 8; ++e) ss[i_] += v[e] * v[e];
        });
        float sc[4];
#pragma unroll
        for (int q_ = 0; q_ < 4; ++q_) {
          float t_ = ss[q_];
          t_ += __shfl_xor(t_, 1); t_ += __shfl_xor(t_, 2); t_ += __shfl_xor(t_, 4);
          sc[q_] = rsqrtf(t_ * (1.f / 128.f) + EPS) * (seg == 2 ? 0.08838834764831845f * 1.4426950408889634f : 1.f);
        }
        const float* g = seg == 2 ? p.q_norm_g : p.k_norm_g;
        float4 gq_[2][2];
        { const int ch_ = (get_tid() & 7) * 8; gq_[0][0] = *(const float4*)(g + ch_); gq_[0][1] = *(const float4*)(g + ch_ + 4); gq_[1][0] = *(const float4*)(g + 64 + ch_); gq_[1][1] = *(const float4*)(g + 64 + ch_ + 4); }
        u16* dst = (seg == 2 ? p.qn() : p.kn()) + rowbase * 1024 + cb;
        slab_rows(sW, [&](int row, int c, const float* v, int i_) {
          float o[8];
          const float4 g0 = gq_[c >> 6][0], g1 = gq_[c >> 6][1];
          const float s_ = sc[i_];
          o[0] = v[0] * s_ * g0.x; o[1] = v[1] * s_ * g0.y; o[2] = v[2] * s_ * g0.z; o[3] = v[3] * s_ * g0.w;
          o[4] = v[4] * s_ * g1.x; o[5] = v[5] * s_ * g1.y; o[6] = v[6] * s_ * g1.z; o[7] = v[7] * s_ * g1.w;
          *(uint4*)(dst + (size_t)row * 1024 + c) = pack8(o);
        });
      } else if (seg == 4) {
        const int bl = mt >> 4, s0 = (mt & 15) * 256 + wm * 64 + mi * 32, hh = cb >> 7;
        slab_store_transposed(sW, p.vt() + (size_t)(bl * 8 + hh) * 128 * 4096 + s0, 4096);
      } else {
        const int gc = (nt - 32) * 256 + wn * 128;
        const float* bm = p.b_merge + gc;
        float4 bq_[2][2];
        { const int ch_ = (get_tid() & 7) * 8; bq_[0][0] = *(const float4*)(bm + ch_); bq_[0][1] = *(const float4*)(bm + ch_ + 4); bq_[1][0] = *(const float4*)(bm + 64 + ch_); bq_[1][1] = *(const float4*)(bm + 64 + ch_ + 4); }
        u16* dst = p.gsig() + rowbase * 3072 + gc;
        slab_rows(sW, [&](int row, int c, const float* v, int i_) {
          float o[8];
          const float4 b0 = bq_[c >> 6][0], b1 = bq_[c >> 6][1];
          o[0] = sigm(v[0] + b0.x); o[1] = sigm(v[1] + b0.y); o[2] = sigm(v[2] + b0.z); o[3] = sigm(v[3] + b0.w);
          o[4] = sigm(v[4] + b1.x); o[5] = sigm(v[5] + b1.y); o[6] = sigm(v[6] + b1.z); o[7] = sigm(v[7] + b1.w);
          *(uint4*)(dst + (size_t)row * 3072 + c) = pack8(o);
        });
      }
    });
  }
}

template <int HD, bool BAND>
DI void attn_core(const u16* __restrict__ Q, const u16* __restrict__ K, const u16* __restrict__ Vt, int ldv, int u0, int u1,
                  const float* __restrict__ bias_row, const float* __restrict__ qg,
                  u16* __restrict__ Out, size_t orow0, int okb, const u16* __restrict__ Gate, unsigned char* smem) {
  constexpr int KS = HD / 32, DB = HD / 16, LDK = HD + 8, NCH = HD / 64;
  u16* sK = (u16*)smem;
  u16* sV = (u16*)(smem + 64 * LDK * 2);
  float* sBias = (float*)(smem + 64 * LDK * 2 + HD * 72 * 2);
  const int tid = get_tid(), lane = tid & 63, w = tid >> 6, l15 = lane & 15, g = lane >> 4, sb = w >> 2, wq = w & 3;
  __syncthreads();
  if (BAND) { for (int i = tid; i < 513; i += 512) sBias[i] = bias_row[i] * 1.4426950408889634f; }
  const float bias_far = BAND ? bias_row[512] * 1.4426950408889634f : 0.f;
  bf16x8 qf[KS];
  {
    const u16* qrow = Q + (size_t)(w * 16 + l15) * 1024 + g * 8;
#pragma unroll
    for (int ks = 0; ks < KS; ++ks) qf[ks] = *(const bf16x8*)(qrow + ks * 32);
    if (!BAND) {
      float ss = 0.f;
#pragma unroll
      for (int ks = 0; ks < KS; ++ks) {
        float v[8];
        unpack8(__builtin_bit_cast(uint4, qf[ks]), v);
#pragma unroll
        for (int e = 0; e < 8; ++e) ss += v[e] * v[e];
      }
      ss += __shfl_xor(ss, 16);
      ss += __shfl_xor(ss, 32);
      const float sc = rsqrtf(ss * (1.f / HD) + EPS) * (0.0625f * 1.4426950408889634f);
#pragma unroll
      for (int ks = 0; ks < KS; ++ks) {
        float v[8];
        unpack8(__builtin_bit_cast(uint4, qf[ks]), v);
        const float4 g0 = *(const float4*)(qg + ks * 32 + g * 8), g1 = *(const float4*)(qg + ks * 32 + g * 8 + 4);
        v[0] *= sc * g0.x; v[1] *= sc * g0.y; v[2] *= sc * g0.z; v[3] *= sc * g0.w;
        v[4] *= sc * g1.x; v[5] *= sc * g1.y; v[6] *= sc * g1.z; v[7] *= sc * g1.w;
        qf[ks] = __builtin_bit_cast(bf16x8, pack8(v));
      }
    }
  }
  f32x4 o[DB];
#pragma unroll
  for (int db = 0; db < DB; ++db) o[db] = f32x4{0.f, 0.f, 0.f, 0.f};
  float m = -1e30f, lsum = 0.f;

  const int krow = tid >> 3, kpart = (tid & 7) * (HD / 8);
  u32x4 rkA[NCH], rvA[NCH], rkB[HD == 128 ? NCH : 1], rvB[HD == 128 ? NCH : 1];
  auto load_tile = [&](int u, auto& rk, auto& rv) {
    const u16* ksrc = K + ((size_t)u * 64 + krow) * 1024 + kpart;
#pragma unroll
    for (int i = 0; i < NCH; ++i) rk[i] = *(const u32x4*)(ksrc + i * 8);
#pragma unroll
    for (int i = 0; i < NCH; ++i) {
      const int id = tid + 512 * i, d = id >> 3, cc = id & 7;
      rv[i] = *(const u32x4*)(Vt + (size_t)d * ldv + u * 64 + cc * 8);
    }
  };
  auto store_tile = [&](const auto& rk, const auto& rv) {
#pragma unroll
    for (int i = 0; i < NCH; ++i) *(u32x4*)(sK + krow * LDK + kpart + i * 8) = rk[i];
#pragma unroll
    for (int i = 0; i < NCH; ++i) {
      const int id = tid + 512 * i, d = id >> 3, cc = id & 7;
      *(u32x4*)(sV + d * 72 + cc * 8) = rv[i];
    }
  };
  auto compute_tile = [&](int u) {
    if (BAND && (u < sb || u > sb + 8)) return;
    f32x4 s[4];
#pragma unroll
    for (int kb = 0; kb < 4; ++kb) {
      s[kb] = f32x4{0.f, 0.f, 0.f, 0.f};
#pragma unroll
      for (int ks = 0; ks < KS; ++ks) {
        const bf16x8 kf = *(const bf16x8*)(sK + (kb * 16 + l15) * LDK + ks * 32 + g * 8);
        s[kb] = __builtin_amdgcn_mfma_f32_16x16x32_bf16(kf, qf[ks], s[kb], 0, 0, 0);
      }
      if (HD > 128) __builtin_amdgcn_sched_barrier(0);
    }
    float mx = -1e30f;
    if (BAND) {
      if ((8 + sb - u) * 64 - 63 >= 256) {
#pragma unroll
        for (int kb = 0; kb < 4; ++kb)
#pragma unroll
          for (int i = 0; i < 4; ++i) s[kb][i] += bias_far;
      } else {
        const int dbase = (8 + sb - u) * 64 + (wq * 16 + l15) - g * 4 + 256;
#pragma unroll
        for (int kb = 0; kb < 4; ++kb)
#pragma unroll
          for (int i = 0; i < 4; ++i) s[kb][i] += sBias[min(dbase - (kb * 16 + i), 512)];
      }
    }
#pragma unroll
    for (int kb = 0; kb < 4; ++kb)
#pragma unroll
      for (int i = 0; i < 4; ++i) mx = fmaxf(mx, s[kb][i]);
    mx = fmaxf(mx, __shfl_xor(mx, 16));
    mx = fmaxf(mx, __shfl_xor(mx, 32));
    const float mn = fmaxf(m, mx);
    const float alpha = __builtin_amdgcn_exp2f(m - mn);
    m = mn;
    lsum *= alpha;
#pragma unroll
    for (int db = 0; db < DB; ++db) { o[db][0] *= alpha; o[db][1] *= alpha; o[db][2] *= alpha; o[db][3] *= alpha; }
    bf16x8 pf[2];
#pragma unroll
    for (int k2 = 0; k2 < 2; ++k2) {
      float pv[8];
#pragma unroll
      for (int i = 0; i < 4; ++i) {
        pv[i] = __builtin_amdgcn_exp2f(s[2 * k2][i] - mn);
        pv[4 + i] = __builtin_amdgcn_exp2f(s[2 * k2 + 1][i] - mn);
      }
#pragma unroll
      for (int e = 0; e < 8; ++e) lsum += pv[e];
      pf[k2] = __builtin_bit_cast(bf16x8, pack8(pv));
    }
#pragma unroll
    for (int db = 0; db < DB; ++db) {
#pragma unroll
      for (int k2 = 0; k2 < 2; ++k2) {
        const u16* vp = sV + (db * 16 + l15) * 72 + k2 * 32 + g * 4;
        const uint2 lo = *(const uint2*)vp, hi = *(const uint2*)(vp + 16);
        uint4 vv; vv.x = lo.x; vv.y = lo.y; vv.z = hi.x; vv.w = hi.y;
        o[db] = __builtin_amdgcn_mfma_f32_16x16x32_bf16(__builtin_bit_cast(bf16x8, vv), pf[k2], o[db], 0, 0, 0);
      }
      if (HD > 128 && (db & 3) == 3) __builtin_amdgcn_sched_barrier(0);
    }
  };
  load_tile(u0, rkA, rvA);
  if (HD == 128) {
    if (u0 + 1 < u1) load_tile(u0 + 1, rkB, rvB);
    for (int u = u0; u < u1; u += 2) {
      __syncthreads();
      store_tile(rkA, rvA);
      __syncthreads();
      if (u + 2 < u1) load_tile(u + 2, rkA, rvA);
      compute_tile(u);
      if (u + 1 < u1) {
        __syncthreads();
        store_tile(rkB, rvB);
        __syncthreads();
        if (u + 3 < u1) load_tile(u + 3, rkB, rvB);
        compute_tile(u + 1);
      }
    }
  } else {
    for (int u = u0; u < u1; ++u) {
      __syncthreads();
      store_tile(rkA, rvA);
      __syncthreads();
      if (u + 1 < u1) load_tile(u + 1, rkA, rvA);
      compute_tile(u);
    }
  }
  lsum += __shfl_xor(lsum, 16);
  lsum += __shfl_xor(lsum, 32);
  const float inv = 1.f / lsum;
  {
    const size_t ro = (size_t)(w * 16 + l15) * 1024 + g * 4;
    uint2 gall[DB];
#pragma unroll
    for (int db = 0; db < DB; ++db) gall[db] = *(const uint2*)(Gate + ro + db * 16);
#pragma unroll
    for (int db = 0; db < DB; ++db) {
      const uint2 gv = gall[db];
      uint2 ov;
      ov.x = pack2(o[db][0] * inv * __uint_as_float(gv.x << 16), o[db][1] * inv * __uint_as_float(gv.x & 0xffff0000u));
      ov.y = pack2(o[db][2] * inv * __uint_as_float(gv.y << 16), o[db][3] * inv * __uint_as_float(gv.y & 0xffff0000u));
      *(uint2*)(Out + ((size_t)((okb >> 6) + (db >> 2)) * TOK + orow0 + w * 16 + l15) * 64 + (db & 3) * 16 + g * 4) = ov;
    }
  }
}

DI void band_core(const u16* __restrict__ Q, const u16* __restrict__ K, const u16* __restrict__ Vt, int u0,
                  const float* __restrict__ bias_row, u16* __restrict__ Out, size_t orow0, int okb, const u16* __restrict__ Gate,
                  unsigned char* smem) {
  constexpr int HD = 128, KS = 4, DB = 8, LDK = HD + 8, NCH = 2, U1 = 12;
  u16* sK = (u16*)smem;
  u16* sV = (u16*)(smem + 64 * LDK * 2);
  float* sBias = (float*)(smem + 64 * LDK * 2 + HD * 72 * 2);
  const int tid = get_tid(), lane = tid & 63, w = tid >> 6, l15 = lane & 15, g = lane >> 4, sbq = w >> 1, wh = w & 1;
  __syncthreads();
  for (int i = tid; i < 513; i += 512) sBias[i] = bias_row[i] * 1.4426950408889634f;
  const float bias_far = bias_row[512] * 1.4426950408889634f;
  bf16x8 qf[2][KS];
#pragma unroll
  for (int qb = 0; qb < 2; ++qb) {
    const u16* qrow = Q + (size_t)(w * 32 + qb * 16 + l15) * 1024 + g * 8;
#pragma unroll
    for (int ks = 0; ks < KS; ++ks) qf[qb][ks] = *(const bf16x8*)(qrow + ks * 32);
  }
  f32x4 o[2][DB];
#pragma unroll
  for (int qb = 0; qb < 2; ++qb)
#pragma unroll
    for (int db = 0; db < DB; ++db) o[qb][db] = f32x4{0.f, 0.f, 0.f, 0.f};
  float m[2] = {-1e30f, -1e30f}, lsum[2] = {0.f, 0.f};

  const int krow = tid >> 3, kpart = (tid & 7) * (HD / 8);
  u32x4 rkA[NCH], rvA[NCH], rkB[NCH], rvB[NCH];
  auto load_tile = [&](int u, u32x4 (&rk)[NCH], u32x4 (&rv)[NCH]) {
    const u16* ksrc = K + ((size_t)u * 64 + krow) * 1024 + kpart;
#pragma unroll
    for (int i = 0; i < NCH; ++i) rk[i] = *(const u32x4*)(ksrc + i * 8);
#pragma unroll
    for (int i = 0; i < NCH; ++i) {
      const int id = tid + 512 * i, d = id >> 3, cc = id & 7;
      rv[i] = *(const u32x4*)(Vt + (size_t)d * 4096 + u * 64 + cc * 8);
    }
  };
  auto store_tile = [&](const u32x4 (&rk)[NCH], const u32x4 (&rv)[NCH]) {
#pragma unroll
    for (int i = 0; i < NCH; ++i) *(u32x4*)(sK + krow * LDK + kpart + i * 8) = rk[i];
#pragma unroll
    for (int i = 0; i < NCH; ++i) {
      const int id = tid + 512 * i, d = id >> 3, cc = id & 7;
      *(u32x4*)(sV + d * 72 + cc * 8) = rv[i];
    }
  };
  auto compute_tile = [&](int u) {
    if (u < sbq || u > sbq + 8) return;
    f32x4 s[2][4];
#pragma unroll
    for (int kb = 0; kb < 4; ++kb) {
      s[0][kb] = f32x4{0.f, 0.f, 0.f, 0.f};
      s[1][kb] = f32x4{0.f, 0.f, 0.f, 0.f};
#pragma unroll
      for (int ks = 0; ks < KS; ++ks) {
        const bf16x8 kf = *(const bf16x8*)(sK + (kb * 16 + l15) * LDK + ks * 32 + g * 8);
        s[0][kb] = __builtin_amdgcn_mfma_f32_16x16x32_bf16(kf, qf[0][ks], s[0][kb], 0, 0, 0);
        s[1][kb] = __builtin_amdgcn_mfma_f32_16x16x32_bf16(kf, qf[1][ks], s[1][kb], 0, 0, 0);
      }
    }
    bf16x8 pf[2][2];
#pragma unroll
    for (int qb = 0; qb < 2; ++qb) {
      if ((8 + sbq - u) * 64 - 63 >= 256) {
#pragma unroll
        for (int kb = 0; kb < 4; ++kb)
#pragma unroll
          for (int i = 0; i < 4; ++i) s[qb][kb][i] += bias_far;
      } else {
        const int dbase = (8 + sbq - u) * 64 + (wh * 32 + qb * 16 + l15) - g * 4 + 256;
#pragma unroll
        for (int kb = 0; kb < 4; ++kb)
#pragma unroll
          for (int i = 0; i < 4; ++i) s[qb][kb][i] += sBias[min(dbase - (kb * 16 + i), 512)];
      }
      float mx = -1e30f;
#pragma unroll
      for (int kb = 0; kb < 4; ++kb)
#pragma unroll
        for (int i = 0; i < 4; ++i) mx = fmaxf(mx, s[qb][kb][i]);
      mx = fmaxf(mx, __shfl_xor(mx, 16));
      mx = fmaxf(mx, __shfl_xor(mx, 32));
      const float mn = fmaxf(m[qb], mx);
      const float alpha = __builtin_amdgcn_exp2f(m[qb] - mn);
      m[qb] = mn;
      lsum[qb] *= alpha;
#pragma unroll
      for (int db = 0; db < DB; ++db) { o[qb][db][0] *= alpha; o[qb][db][1] *= alpha; o[qb][db][2] *= alpha; o[qb][db][3] *= alpha; }
#pragma unroll
      for (int k2 = 0; k2 < 2; ++k2) {
        float pv[8];
#pragma unroll
        for (int i = 0; i < 4; ++i) {
          pv[i] = __builtin_amdgcn_exp2f(s[qb][2 * k2][i] - mn);
          pv[4 + i] = __builtin_amdgcn_exp2f(s[qb][2 * k2 + 1][i] - mn);
        }
#pragma unroll
        for (int e = 0; e < 8; ++e) lsum[qb] += pv[e];
        pf[qb][k2] = __builtin_bit_cast(bf16x8, pack8(pv));
      }
    }
#pragma unroll
    for (int db = 0; db < DB; ++db) {
#pragma unroll
      for (int k2 = 0; k2 < 2; ++k2) {
        const u16* vp = sV + (db * 16 + l15) * 72 + k2 * 32 + g * 4;
        const uint2 lo = *(const uint2*)vp, hi = *(const uint2*)(vp + 16);
        uint4 vv; vv.x = lo.x; vv.y = lo.y; vv.z = hi.x; vv.w = hi.y;
        const bf16x8 vf = __builtin_bit_cast(bf16x8, vv);
        o[0][db] = __builtin_amdgcn_mfma_f32_16x16x32_bf16(vf, pf[0][k2], o[0][db], 0, 0, 0);
        o[1][db] = __builtin_amdgcn_mfma_f32_16x16x32_bf16(vf, pf[1][k2], o[1][db], 0, 0, 0);
      }
    }
  };
  load_tile(u0, rkA, rvA);
  if (u0 + 1 < U1) load_tile(u0 + 1, rkB, rvB);
  for (int u = u0; u < U1; u += 2) {
    __syncthreads();
    store_tile(rkA, rvA);
    __syncthreads();
    if (u + 2 < U1) load_tile(u + 2, rkA, rvA);
    compute_tile(u);
    if (u + 1 < U1) {
      __syncthreads();
      store_tile(rkB, rvB);
      __syncthreads();
      if (u + 3 < U1) load_tile(u + 3, rkB, rvB);
      compute_tile(u + 1);
    }
  }
#pragma unroll
  for (int qb = 0; qb < 2; ++qb) {
    float ls = lsum[qb];
    ls += __shfl_xor(ls, 16);
    ls += __shfl_xor(ls, 32);
    const float inv = 1.f / ls;
    const int r = w * 32 + qb * 16 + l15;
    const size_t ro = (size_t)r * 1024 + g * 4;
    uint2 gall[DB];
#pragma unroll
    for (int db = 0; db < DB; ++db) gall[db] = *(const uint2*)(Gate + ro + db * 16);
#pragma unroll
    for (int db = 0; db < DB; ++db) {
      const uint2 gv = gall[db];
      uint2 ov;
      ov.x = pack2(o[qb][db][0] * inv * __uint_as_float(gv.x << 16), o[qb][db][1] * inv * __uint_as_float(gv.x & 0xffff0000u));
      ov.y = pack2(o[qb][db][2] * inv * __uint_as_float(gv.y << 16), o[qb][db][3] * inv * __uint_as_float(gv.y & 0xffff0000u));
      *(uint2*)(Out + ((size_t)((okb >> 6) + (db >> 2)) * TOK + orow0 + r) * 64 + (db & 3) * 16 + g * 4) = ov;
    }
  }
}

DI void rnn_load_rows(const Params& p, int bl, int c0, int n, uint4 (&xr_)[7]) {
  const int tid = get_tid(), sbk = tid >> 8, tl = tid & 255;
  const int c = c0 + sbk, c8 = (tl & 15) * 8, t4 = (tl >> 4) * 4;
  const u16* src = p.xr() + ((size_t)bl * 4096 + c * 64) * 1024 + n * 128 + c8;
#pragma unroll
  for (int j = 0; j < 7; ++j) {
    const int t = t4 - 3 + j;
    if (c * 64 + t >= 0) xr_[j] = *(const uint4*)(src + (ptrdiff_t)t * 1024);
    else xr_[j] = uint4{0u, 0u, 0u, 0u};
  }
}
DI void rnn_local_item(const Params& p, int bl, int c0, int n, const bf16x8 (&bR)[2][4], const bf16x8 (&bI)[2][4], uint4 (&xr_)[7],
                       bool nvalid, int nbl, int nc0, unsigned char* smem) {
  const int tid = get_tid(), sbk = tid >> 8, tl = tid & 255, lane = tid & 63, w = tl >> 6, l15 = lane & 15, g = lane >> 4;
  unsigned char* sm = smem + sbk * 67584;
  float* sxc = (float*)sm;
  float* sa = (float*)(sm + 33792);
  u16* sxcb = (u16*)(sm + 33792);
  const int c = c0 + sbk;
  const int ch0 = n * 128;
  const size_t tok0 = (size_t)bl * 4096 + c * 64;
  __syncthreads();
  {
    const int c8 = (tl & 15) * 8, t4 = (tl >> 4) * 4;
    float wv[4][8], cbv[8];
#pragma unroll
    for (int k = 0; k < 4; ++k) {
      const float4 w0 = *(const float4*)(p.conv_w + k * 1024 + ch0 + c8), w1 = *(const float4*)(p.conv_w + k * 1024 + ch0 + c8 + 4);
      wv[k][0] = w0.x; wv[k][1] = w0.y; wv[k][2] = w0.z; wv[k][3] = w0.w; wv[k][4] = w1.x; wv[k][5] = w1.y; wv[k][6] = w1.z; wv[k][7] = w1.w;
    }
    {
      const float4 b0 = *(const float4*)(p.conv_b + ch0 + c8), b1 = *(const float4*)(p.conv_b + ch0 + c8 + 4);
      cbv[0] = b0.x; cbv[1] = b0.y; cbv[2] = b0.z; cbv[3] = b0.w; cbv[4] = b1.x; cbv[5] = b1.y; cbv[6] = b1.z; cbv[7] = b1.w;
    }
    float xf[7][8];
#pragma unroll
    for (int j = 0; j < 7; ++j) unpack8(xr_[j], xf[j]);
    if (nvalid) rnn_load_rows(p, nbl, nc0, n, xr_);
#pragma unroll
    for (int tt = 0; tt < 4; ++tt) {
      float xc[8];
#pragma unroll
      for (int e = 0; e < 8; ++e)
        xc[e] = wv[0][e] * xf[tt][e] + wv[1][e] * xf[tt + 1][e] + wv[2][e] * xf[tt + 2][e] + wv[3][e] * xf[tt + 3][e] + cbv[e];
      float* d = sxc + (t4 + tt) * 132 + c8;
      *(float4*)d = float4{xc[0], xc[1], xc[2], xc[3]};
      *(float4*)(d + 4) = float4{xc[4], xc[5], xc[6], xc[7]};
      *(uint4*)(sxcb + (t4 + tt) * 136 + c8) = pack8(xc);
    }
  }
  __syncthreads();
  f32x4 accR[4][2], accI[4][2];
#pragma unroll
  for (int tb = 0; tb < 4; ++tb)
#pragma unroll
    for (int jb = 0; jb < 2; ++jb) { accR[tb][jb] = f32x4{0.f, 0.f, 0.f, 0.f}; accI[tb][jb] = f32x4{0.f, 0.f, 0.f, 0.f}; }
  {
#pragma unroll
    for (int tb = 0; tb < 4; ++tb)
#pragma unroll
      for (int ks = 0; ks < 4; ++ks) {
        const bf16x8 af = *(const bf16x8*)(sxcb + (tb * 16 + l15) * 136 + ks * 32 + g * 8);
#pragma unroll
        for (int jb = 0; jb < 2; ++jb) {
          accR[tb][jb] = __builtin_amdgcn_mfma_f32_16x16x32_bf16(af, bR[jb][ks], accR[tb][jb], 0, 0, 0);
          accI[tb][jb] = __builtin_amdgcn_mfma_f32_16x16x32_bf16(af, bI[jb][ks], accI[tb][jb], 0, 0, 0);
        }
      }
  }
  __syncthreads();
#pragma unroll
  for (int jb = 0; jb < 2; ++jb) {
    const int ch = 32 * w + jb * 16 + l15;
    const float ba = p.lru_ba[ch0 + ch], bx = p.lru_bx[ch0 + ch];
    const float sp = log1pf(expf(-p.lru_lambda[ch0 + ch]));
#pragma unroll
    for (int tb = 0; tb < 4; ++tb)
#pragma unroll
      for (int r = 0; r < 4; ++r) {
        const int t = tb * 16 + g * 4 + r;
        const float rg = sigm(accR[tb][jb][r] + ba), ig = sigm(accI[tb][jb][r] + bx);
        const float la = -8.f * rg * sp;
        const float a = __expf(la);
        const float mult = __builtin_amdgcn_sqrtf(fmaxf(1.f - __expf(2.f * la), 0.f));
        const float xc = sxc[t * 132 + ch];
        sa[t * 132 + ch] = a;
        sxc[t * 132 + ch] = mult * (ig * xc);
      }
  }
  __syncthreads();
  {
    const int ch = tl & 127, half = tl >> 7, tb = half * 32;
    float hh = 0.f, A = 1.f;
#pragma unroll 8
    for (int t = tb; t < tb + 32; ++t) {
      const float a = sa[t * 132 + ch];
      hh = a * hh + sxc[t * 132 + ch];
      A *= a;
      sxc[t * 132 + ch] = hh;
      sa[t * 132 + ch] = A;
    }
    __syncthreads();
  }
  {
    const int c8 = (tl & 15) * 8, r0 = tl >> 4;
    float cH[8], cA[8];
    {
      const float4 h0 = *(const float4*)(sxc + 31 * 132 + c8), h1 = *(const float4*)(sxc + 31 * 132 + c8 + 4);
      const float4 a0 = *(const float4*)(sa + 31 * 132 + c8), a1 = *(const float4*)(sa + 31 * 132 + c8 + 4);
      cH[0] = h0.x; cH[1] = h0.y; cH[2] = h0.z; cH[3] = h0.w; cH[4] = h1.x; cH[5] = h1.y; cH[6] = h1.z; cH[7] = h1.w;
      cA[0] = a0.x; cA[1] = a0.y; cA[2] = a0.z; cA[3] = a0.w; cA[4] = a1.x; cA[5] = a1.y; cA[6] = a1.z; cA[7] = a1.w;
    }
#pragma unroll
    for (int i = 0; i < 4; ++i) {
      const int row = r0 + 16 * i;
      const float4 h0 = *(const float4*)(sxc + row * 132 + c8), h1 = *(const float4*)(sxc + row * 132 + c8 + 4);
      const float4 a0 = *(const float4*)(sa + row * 132 + c8), a1 = *(const float4*)(sa + row * 132 + c8 + 4);
      float hv[8] = {h0.x, h0.y, h0.z, h0.w, h1.x, h1.y, h1.z, h1.w};
      float av[8] = {a0.x, a0.y, a0.z, a0.w, a1.x, a1.y, a1.z, a1.w};
      if (i >= 2) {
#pragma unroll
        for (int e = 0; e < 8; ++e) { hv[e] += av[e] * cH[e]; av[e] *= cA[e]; }
      }
      const size_t o = (tok0 + row) * 1024 + ch0 + c8;
      *(uint4*)(p.hloc() + o) = pack8(hv);
      *(uint4*)(p.cuma() + o) = pack8(av);
      if (row == 63) {
        float* da = p.chA() + ((size_t)bl * 64 + c) * 1024 + ch0 + c8;
        float* dh = p.chH() + ((size_t)bl * 64 + c) * 1024 + ch0 + c8;
        *(float4*)da = float4{av[0], av[1], av[2], av[3]}; *(float4*)(da + 4) = float4{av[4], av[5], av[6], av[7]};
        *(float4*)dh = float4{hv[0], hv[1], hv[2], hv[3]}; *(float4*)(dh + 4) = float4{hv[4], hv[5], hv[6], hv[7]};
      }
    }
  }
}

DI void step_mix(const Params& p, int pass, unsigned char* smem) {
  constexpr int NB = GB * 16 * 8, NM = GB * 32 * 4, NR = GB * 32 * 8;
  const bool rnn_first = ((blockIdx.x >> 3) & 1) != 0;
#pragma unroll 1
  for (int part = 0; part < 2; ++part) {
  if ((part == 0) != rnn_first) {
  for (int it = blockIdx.x; it < NB + NM; it += gridDim.x) {
    if (it < NM) {
      const int hh = it & 3, tt = (it >> 2) & 31, bl = it >> 7;
      const int bgl = pass * GB + bl;
      const size_t tok = (size_t)bl * 4096 + tt * 128;
      attn_core<256, false>(p.qm() + tok * 1024 + hh * 256, p.memk() + (size_t)bgl * 256 * 1024 + hh * 256,
                            p.memvt() + (size_t)(bgl * 4 + hh) * 256 * 256, 256, 0, 4, nullptr, p.mem_q_norm_g,
                            p.mem_g(), tok, hh * 256, p.gms() + tok * 1024 + hh * 256, smem);
    } else if (it < NM + NB) {
      const int idx = it - NM;
      const int hh = idx & 7, cq = (idx >> 3) & 15, bl = idx >> 7;
      const int c0 = 4 * ((cq + 4 * bl) & 15);
      const size_t tok = (size_t)bl * 4096 + c0 * 64;
      const int u0 = c0 >= 8 ? 0 : 8 - c0;
      const u16* K0 = p.kn() + ((ptrdiff_t)bl * 4096 + (ptrdiff_t)(c0 - 8) * 64) * 1024 + hh * 128;
      const u16* V0 = p.vt() + (size_t)(bl * 8 + hh) * 128 * 4096 + (ptrdiff_t)(c0 - 8) * 64;
      band_core(p.qn() + tok * 1024 + hh * 128, K0, V0, u0, p.rel_bias + hh * 513, p.att_g(), tok, hh * 128,
                p.gas() + tok * 1024 + hh * 128, smem);
    }
  }
  } else {
  int it = NB + NM + blockIdx.x;
  if (it < NB + NM + NR) {
    const int n = (it - NM - NB) & 7;
    const int tid = get_tid(), lane = tid & 63, w = (tid & 255) >> 6, l15 = lane & 15, g = lane >> 4;
    bf16x8 bR[2][4], bI[2][4];
#pragma unroll
    for (int jb = 0; jb < 2; ++jb)
#pragma unroll
      for (int ks = 0; ks < 4; ++ks) {
        const size_t off = (size_t)n * 16384 + (size_t)(32 * w + jb * 16 + l15) * 128 + ks * 32 + g * 8;
        bR[jb][ks] = *(const bf16x8*)(p.wt_a() + off);
        bI[jb][ks] = *(const bf16x8*)(p.wt_x() + off);
      }
    uint4 xr_[7];
    { const int idx = it - NM - NB; rnn_load_rows(p, idx >> 8, 2 * ((idx >> 3) & 31), n, xr_); }
    for (; it < NB + NM + NR; it += gridDim.x) {
      const int idx = it - NM - NB;
      const int cp = (idx >> 3) & 31, bl = idx >> 8;
      const int it2 = it + gridDim.x, idx2 = it2 - NM - NB;
      rnn_local_item(p, bl, 2 * cp, n, bR, bI, xr_, it2 < NB + NM + NR, idx2 >> 8, 2 * ((idx2 >> 3) & 31), smem);
    }
  }
  }
  }
}

DI void step_rnnfin(const Params& p, unsigned char* smem) {
  float* sP = (float*)smem;
  const int tid = get_tid(), c8 = (tid & 127) * 8, q = tid >> 7;
  for (int it = blockIdx.x; it < GB * 64; it += gridDim.x) {
    const int c = it & 63, bl = it >> 6;
    float Aq[8], Hq[8];
#pragma unroll
    for (int e = 0; e < 8; ++e) { Aq[e] = 1.f; Hq[e] = 0.f; }
    {
      const float* pa = p.chA() + ((size_t)bl * 64) * 1024 + c8;
      const float* ph = p.chH() + ((size_t)bl * 64) * 1024 + c8;
#pragma unroll 4
      for (int j = 0; j < 16; ++j) {
        const int k = q * 16 + j;
        const int kk = k < c ? k : 0;
        float4 a0 = *(const float4*)(pa + (size_t)kk * 1024), a1 = *(const float4*)(pa + (size_t)kk * 1024 + 4);
        float4 h0 = *(const float4*)(ph + (size_t)kk * 1024), h1 = *(const float4*)(ph + (size_t)kk * 1024 + 4);
        if (k >= c) { a0 = float4{1.f, 1.f, 1.f, 1.f}; a1 = a0; h0 = float4{0.f, 0.f, 0.f, 0.f}; h1 = h0; }
        Hq[0] = Hq[0] * a0.x + h0.x; Hq[1] = Hq[1] * a0.y + h0.y; Hq[2] = Hq[2] * a0.z + h0.z; Hq[3] = Hq[3] * a0.w + h0.w;
        Hq[4] = Hq[4] * a1.x + h1.x; Hq[5] = Hq[5] * a1.y + h1.y; Hq[6] = Hq[6] * a1.z + h1.z; Hq[7] = Hq[7] * a1.w + h1.w;
        Aq[0] *= a0.x; Aq[1] *= a0.y; Aq[2] *= a0.z; Aq[3] *= a0.w; Aq[4] *= a1.x; Aq[5] *= a1.y; Aq[6] *= a1.z; Aq[7] *= a1.w;
      }
    }
    __syncthreads();
    {
      float* dA = sP + (q * 2 + 0) * 1024 + c8;
      float* dH = sP + (q * 2 + 1) * 1024 + c8;
      *(float4*)dA = float4{Aq[0], Aq[1], Aq[2], Aq[3]}; *(float4*)(dA + 4) = float4{Aq[4], Aq[5], Aq[6], Aq[7]};
      *(float4*)dH = float4{Hq[0], Hq[1], Hq[2], Hq[3]}; *(float4*)(dH + 4) = float4{Hq[4], Hq[5], Hq[6], Hq[7]};
    }
    __syncthreads();
    float cr[8];
#pragma unroll
    for (int e = 0; e < 8; ++e) cr[e] = 0.f;
#pragma unroll
    for (int qq = 0; qq < 4; ++qq) {
      const float* sa_ = sP + (qq * 2 + 0) * 1024 + c8;
      const float* sh_ = sP + (qq * 2 + 1) * 1024 + c8;
      const float4 a0 = *(const float4*)sa_, a1 = *(const float4*)(sa_ + 4), h0 = *(const float4*)sh_, h1 = *(const float4*)(sh_ + 4);
      cr[0] = cr[0] * a0.x + h0.x; cr[1] = cr[1] * a0.y + h0.y; cr[2] = cr[2] * a0.z + h0.z; cr[3] = cr[3] * a0.w + h0.w;
      cr[4] = cr[4] * a1.x + h1.x; cr[5] = cr[5] * a1.y + h1.y; cr[6] = cr[6] * a1.z + h1.z; cr[7] = cr[7] * a1.w + h1.w;
    }
    const size_t tok = (size_t)bl * 4096 + c * 64 + q * 16;
    u16* dst = p.rnn_g() + ((size_t)(c8 >> 6) * TOK + tok) * 64 + (c8 & 63);
#pragma unroll 1
    for (int t0 = 0; t0 < 16; t0 += 8) {
      uint4 rh[8], rc[8], rg[8];
#pragma unroll
      for (int t = 0; t < 8; ++t) {
        const size_t o = (tok + t0 + t) * 1024 + c8;
        rh[t] = *(const uint4*)(p.hloc() + o);
        rc[t] = *(const uint4*)(p.cuma() + o);
        rg[t] = *(const uint4*)(p.grs() + o);
      }
#pragma unroll
      for (int t = 0; t < 8; ++t) {
        float hl[8], cu[8], gr[8], ov[8];
        unpack8(rh[t], hl);
        unpack8(rc[t], cu);
        unpack8(rg[t], gr);
#pragma unroll
        for (int e = 0; e < 8; ++e) ov[e] = (hl[e] + cu[e] * cr[e]) * gr[e];
        *(uint4*)(dst + (size_t)(t0 + t) * 64) = pack8(ov);
      }
    }
  }
}

DI void step_proj(const Params& p, unsigned char* smem) {
  constexpr int MT = TOK / 256;
  u16* ytmp = p.ytmp();
  for (int t = blockIdx.x; t < MT * 4; t += gridDim.x) {
    const int mt = t % MT, nt = t / MT;
    const int wave = get_tid() >> 6, wm = wave >> 1, wn = wave & 1;
#pragma unroll 1
    for (int b = 0; b < 3; ++b) {
      const u16* A = (b == 0 ? p.rnn_g() : b == 1 ? p.att_g() : p.mem_g()) + (size_t)mt * 256 * 64;
      const u16* W = (b == 0 ? p.wt_prnn() : b == 1 ? p.wt_patt() : p.wt_pmem()) + (size_t)nt * 256 * 64;
      f32x16 acc[2][4];
      zero_acc(acc);
      gemm_kloop(A, (size_t)TOK * 64, W, (size_t)1024 * 64, 1024, acc, smem);
      uint4 gpre[8], ypre[8];
      const int lane_ = get_tid() & 63, rsub_ = lane_ >> 3, chunk_ = lane_ & 7;
      wave_epilogue_pre(acc, smem, [&](int mi) {
        const size_t rowbase = (size_t)mt * 256 + wm * 64 + mi * 32;
        const u16* gs = p.gsig() + rowbase * 3072 + b * 1024 + nt * 256 + wn * 128;
        const u16* yt = ytmp + ((size_t)(t * 8 + wave) * 2 + mi) * 4096 + lane_ * 8;
#pragma unroll
        for (int i = 0; i < 4; ++i)
#pragma unroll
          for (int hf = 0; hf < 2; ++hf) {
            gpre[i * 2 + hf] = *(const uint4*)(gs + (size_t)(i * 8 + rsub_) * 3072 + hf * 64 + chunk_ * 8);
            if (b != 0) ypre[i * 2 + hf] = *(const uint4*)(yt + (i * 2 + hf) * 512);
          }
      }, [&](int mi, const float* sW) {
        const size_t rowbase = (size_t)mt * 256 + wm * 64 + mi * 32;
        const int cb = nt * 256 + wn * 128;
        const u16* gs = p.gsig() + rowbase * 3072 + b * 1024 + cb;
        u16* yt = ytmp + ((size_t)(t * 8 + wave) * 2 + mi) * 4096 + (get_tid() & 63) * 8;
        u16* yo = p.y();
        slab_rows(sW, [&](int row, int c, const float* v, int i_) {
          float gv[8], o[8];
          unpack8(gpre[i_ * 2 + (c >> 6)], gv);
          u16* yp = yt + (i_ * 2 + (c >> 6)) * 512;
          if (b == 0) {
#pragma unroll
            for (int e = 0; e < 8; ++e) o[e] = v[e] * gv[e];
          } else {
            float yv_[8];
            unpack8(ypre[i_ * 2 + (c >> 6)], yv_);
#pragma unroll
            for (int e = 0; e < 8; ++e) o[e] = yv_[e] + v[e] * gv[e];
          }
          if (b < 2) {
            *(uint4*)yp = pack8(o);
          } else {
            *(uint4*)(yo + ((size_t)((cb + c) >> 6) * TOK + rowbase + row) * 64 + ((cb + c) & 63)) = pack8(o);
          }
        });
      });
    }
  }
}

DI void step_out(const Params& p, int pass, unsigned char* smem) {
  constexpr int MT = TOK / 256;
  for (int t = blockIdx.x; t < MT * 4; t += gridDim.x) {
    const int mt = t % MT, nt = t / MT;
    f32x16 acc[2][4];
    zero_acc(acc);
    gemm_kloop(p.y() + (size_t)mt * 256 * 64, (size_t)TOK * 64, p.wt_out() + (size_t)nt * 256 * 64, (size_t)1024 * 64, 1024, acc, smem);
    const int wave = get_tid() >> 6, wm = wave >> 1, wn = wave & 1;
    float4 xpre[8][2];
    const int lane_ = get_tid() & 63, rsub_ = lane_ >> 3, chunk_ = lane_ & 7;
    wave_epilogue_pre(acc, smem, [&](int mi) {
      const float* xs = p.x + ((size_t)pass * TOK + (size_t)mt * 256 + wm * 64 + mi * 32) * 1024 + nt * 256 + wn * 128;
#pragma unroll
      for (int i = 0; i < 4; ++i)
#pragma unroll
        for (int hf = 0; hf < 2; ++hf) {
          const float* s_ = xs + (size_t)(i * 8 + rsub_) * 1024 + hf * 64 + chunk_ * 8;
          xpre[i * 2 + hf][0] = *(const float4*)s_;
          xpre[i * 2 + hf][1] = *(const float4*)(s_ + 4);
        }
    }, [&](int mi, const float* sW) {
      const size_t gbase = ((size_t)pass * TOK + (size_t)mt * 256 + wm * 64 + mi * 32) * 1024 + nt * 256 + wn * 128;
      float* dst = p.out + gbase;
      slab_rows(sW, [&](int row, int c, const float* v, int i_) {
        const float4 x0 = xpre[i_ * 2 + (c >> 6)][0], x1 = xpre[i_ * 2 + (c >> 6)][1];
        float4 o0, o1;
        o0.x = x0.x + v[0]; o0.y = x0.y + v[1]; o0.z = x0.z + v[2]; o0.w = x0.w + v[3];
        o1.x = x1.x + v[4]; o1.y = x1.y + v[5]; o1.z = x1.z + v[6]; o1.w = x1.w + v[7];
        *(float4*)(dst + (size_t)row * 1024 + c) = o0;
        *(float4*)(dst + (size_t)row * 1024 + c + 4) = o1;
      });
    });
  }
}

DI void run_phase(const Params& p, int pass, int ph, bool first, unsigned char* smem) {
  if (ph == 0) step_gemm1(p, pass, first, smem);
  else if (ph == 1) step_mix(p, pass, smem);
  else if (ph == 2) step_rnnfin(p, smem);
  else if (ph == 3) step_proj(p, smem);
  else step_out(p, pass, smem);
}

__global__ void __launch_bounds__(512) mega_kernel(Params p_in) {
  __shared__ __attribute__((aligned(16))) unsigned char smem[SMEM_BYTES];
  cg::grid_group grid = cg::this_grid();
  const Params& p = p_in;
  unsigned* bar = (unsigned*)(p.ws + OFF_bar);
  unsigned nbar = 0;
  __shared__ unsigned s_xb[4];
  const unsigned xcc = (unsigned)__builtin_amdgcn_s_getreg((3 << 11) | 20) & 7u;
  if (__builtin_amdgcn_workitem_id_x() == 0) { s_xb[0] = 0u; s_xb[1] = 0u; (void)xb_add(bar + XB_XCNT(xcc), 1u); }
  __syncthreads();
  for (int step = p.step_lo; step < p.step_hi; ++step) {
    if (step == 0) step_prep(p, smem);
    else if (step == 1) step_memkv(p, smem);
    else {
      const int pass = (step - 2) / 5, ph = (step - 2) % 5;
#ifdef DUP_PH
      if (ph == DUP_PH) { run_phase(p, pass, ph, true, smem); ++nbar; xcd_barrier(bar, xcc, s_xb); run_phase(p, pass, ph, false, smem); }
      else
#endif
      run_phase(p, pass, ph, true, smem);
    }
    if (step + 1 < p.step_hi) {
      if (p.step_hi < 0) grid.sync();
      if (step >= 2 && (step - 2) % 5 == 4) {   }
      else { ++nbar; xcd_barrier(bar, xcc, s_xb); }
    }
  }
}

extern "C" void kernel_launch(void* const* d_in, const int* in_sizes, int n_in, void* d_out, int out_size, void* d_ws,
                              size_t ws_size, hipStream_t stream) {
  static int grid_blocks = 0;
  if (!grid_blocks) {
    int dev = 0, cus = 0, per_cu = 0;
    (void)hipGetDevice(&dev);
    (void)hipDeviceGetAttribute(&cus, hipDeviceAttributeMultiprocessorCount, dev);
    (void)hipOccupancyMaxActiveBlocksPerMultiprocessor(&per_cu, mega_kernel, 512, 0);
    if (per_cu > 1) per_cu = 1;
    if (per_cu < 1) per_cu = 1;
    grid_blocks = (cus * per_cu) & ~7;
  }
  Params p{};
  const float* const* in = (const float* const*)d_in;
  p.x = in[0]; p.mem = in[1]; p.norm_g = in[2]; p.mem_norm_g = in[3]; p.w_in = in[4]; p.b_merge = in[5]; p.conv_w = in[6];
  p.conv_b = in[7]; p.lru_wa = in[8]; p.lru_ba = in[9]; p.lru_wx = in[10]; p.lru_bx = in[11]; p.lru_lambda = in[12];
  p.q_norm_g = in[13]; p.k_norm_g = in[14]; p.rel_bias = in[15]; p.w_mem_kv = in[16]; p.mem_q_norm_g = in[17];
  p.mem_k_norm_g = in[18]; p.w_proj_rnn = in[19]; p.w_proj_att = in[20]; p.w_proj_mem = in[21]; p.w_out = in[22];
  p.out = (float*)d_out;
  p.ws = (unsigned char*)d_ws;
  if (WS_NEED > ws_size) { fprintf(stderr, "workspace too small: need %llu have %zu\n", WS_NEED, ws_size); return; }
  p.step_lo = 0; p.step_hi = 2 + 5 * NPASS;
  (void)hipMemsetAsync((unsigned char*)d_ws + OFF_bar, 0, 4096, stream);
  void* args[] = {&p};
  hipError_t e = hipLaunchCooperativeKernel((void*)mega_kernel, dim3(grid_blocks), dim3(512), args, 0, stream);
  if (e != hipSuccess) fprintf(stderr, "cooperative launch failed: %s (grid %d)\n", hipGetErrorString(e), grid_blocks);
}
```
